# Optimizing an MI355X kernel written in HIP

```python
import math
import jax, jax.numpy as jnp
from jax import lax
import numpy as np

D_MODEL = 1024
BATCH = 32
SEQ = 256
DEPTH = 4
DEC_BATCH = 8
DEC_SEQ = 1024
PAST_LEN = 256

GRID_W = 64
N_EVEN = (DEPTH + 1) // 2
N_ODD = DEPTH // 2
EPS = 1e-6
N_MOD = 9
GLA_HEADS = 4
GLA_DK = 64
GLA_DV = 128
GLA_QK = GLA_HEADS * GLA_DK
GLA_VW = GLA_HEADS * GLA_DV
GLA_GATE_RANK = 16
GLA_GATE_NORM = 16.0
GLA_CHUNK = 64
MLA_HEADS = 8
MLA_NOPE = 64
MLA_ROPE = 32
MLA_V = 64
MLA_QK_DIM = MLA_NOPE + MLA_ROPE
MLA_Q_RANK = 384
MLA_KV_RANK = 256
ROPE_BASE = 10000.0
ROPE_AXIS_PAIRS = MLA_ROPE // 4
ATTN_BLOCK = 128
EVEN_SPLIT = (GLA_QK, GLA_QK, GLA_VW, GLA_VW, GLA_GATE_RANK, GLA_GATE_RANK, MLA_Q_RANK, MLA_KV_RANK, MLA_ROPE)
EVEN_IN_WIDTH = 2 * GLA_QK + 2 * GLA_VW + 2 * GLA_GATE_RANK + MLA_Q_RANK + MLA_KV_RANK + MLA_ROPE
EVEN_OUT_WIDTH = GLA_VW + MLA_HEADS * MLA_V
CMLP_CHUNK = 128
CMLP_GROUPS = 4
CMLP_WIDTH = 2 * D_MODEL
FFN_HIDDEN = 2816

kernel_name = 'hybrid_gla_mla_gmlp_diffusion_step'


def rms_norm(x, g):
    xf = x.astype(jnp.float32)
    y = xf * lax.rsqrt(jnp.mean(xf * xf, axis=-1, keepdims=True) + EPS)
    return (y * g.astype(jnp.float32)).astype(x.dtype)


def split_cols(h, sizes):
    out, o = [], 0
    for s in sizes:
        out.append(h[..., o:o + s])
        o += s
    return out


def to_heads(x, n_heads):
    b, t, w = x.shape
    return x.reshape(b, t, n_heads, w // n_heads).transpose(0, 2, 1, 3)


def from_heads(x):
    b, h, t, d = x.shape
    return x.transpose(0, 2, 1, 3).reshape(b, t, h * d)


def modulation(cond, w_ada, b_ada):
    m = jax.nn.silu(cond) @ w_ada + b_ada
    return jnp.split(m[:, None, :], N_MOD, axis=-1)


def modulate(x, g, shift, scale):
    return rms_norm(x, g) * (1 + scale) + shift


def swiglu(h, w_gate, w_up, w_down):
    return (jax.nn.silu(h @ w_gate) * (h @ w_up)) @ w_down


def axial_rope_tables(n):
    rows = n // GRID_W
    row = jnp.repeat(jnp.arange(rows, dtype=jnp.float32), GRID_W)
    col = jnp.tile(jnp.arange(GRID_W, dtype=jnp.float32), rows)
    inv = ROPE_BASE ** (-jnp.arange(ROPE_AXIS_PAIRS, dtype=jnp.float32) / ROPE_AXIS_PAIRS)
    ang = jnp.concatenate([row[:, None] * inv, col[:, None] * inv], axis=-1)
    return jnp.cos(ang), jnp.sin(ang)


def apply_axial_rope(x, cos, sin):
    cos = cos.astype(x.dtype)
    sin = sin.astype(x.dtype)
    x1, x2 = x[..., 0::2], x[..., 1::2]
    return jnp.stack([x1 * cos - x2 * sin, x1 * sin + x2 * cos], axis=-1).reshape(x.shape)


def rope_tail(x, rope):
    if rope is None:
        return x
    cos, sin = rope
    return jnp.concatenate([x[..., :MLA_NOPE], apply_axial_rope(x[..., MLA_NOPE:], cos, sin)], axis=-1)


def block_attention(q, k, v):
    b, h, n, dh = q.shape
    scale = dh ** -0.5
    qb = q.reshape(b, h, n // ATTN_BLOCK, ATTN_BLOCK, dh).transpose(2, 0, 1, 3, 4)

    def one_block(qi):
        s = jnp.einsum('bhqd,bhkd->bhqk', qi, k).astype(jnp.float32) * scale
        p = jax.nn.softmax(s, axis=-1).astype(v.dtype)
        return jnp.einsum('bhqk,bhkd->bhqd', p, v)

    o = lax.map(one_block, qb)
    return o.transpose(1, 2, 0, 3, 4).reshape(b, h, n, v.shape[-1])


def gla_log_decay(g_low, w2, bias):
    z = (g_low @ w2 + bias).astype(jnp.float32)
    return jax.nn.log_sigmoid(z) / GLA_GATE_NORM


def gla_chunk_scan(q, k, v, log_a, s0):
    b, h, t, dk = q.shape
    dv = v.shape[-1]
    nc = t // GLA_CHUNK

    def to_chunks(x):
        return x.reshape(b, h, nc, GLA_CHUNK, x.shape[-1]).transpose(2, 0, 1, 3, 4)

    lower = jnp.tril(jnp.ones((GLA_CHUNK, GLA_CHUNK), dtype=bool))[:, :, None]

    def step(s, xs):
        qc, kc, vc, lc = xs
        cum = jnp.cumsum(lc, axis=2)
        o_inter = jnp.einsum('bhcd,bhde->bhce', qc * jnp.exp(cum), s)
        diff = jnp.where(lower, cum[:, :, :, None, :] - cum[:, :, None, :, :], -jnp.inf)
        att = jnp.einsum('bhtd,bhsd,bhtsd->bhts', qc, kc, jnp.exp(diff))
        o = o_inter + jnp.einsum('bhts,bhse->bhte', att, vc)
        last = cum[:, :, -1:, :]
        s_new = jnp.exp(last[:, :, 0, :, None]) * s + jnp.einsum('bhcd,bhce->bhde', kc * jnp.exp(last - cum), vc)
        return s_new, o

    s_fin, o = lax.scan(step, s0, (to_chunks(q), to_chunks(k), to_chunks(v), to_chunks(log_a)))
    return o.transpose(1, 2, 0, 3, 4).reshape(b, h, t, dv), s_fin


def gla_bidirectional(q, k, v, la_f, la_b, s0_f, s0_b):
    o_f, s_f = gla_chunk_scan(q, k, v, la_f, s0_f)
    flip = lambda x: jnp.flip(x, axis=2)
    o_b, s_b = gla_chunk_scan(flip(q), flip(k), flip(v), flip(la_b), s0_b)
    return o_f + flip(o_b), s_f, s_b


def mla_queries(cq_raw, qa_g, qb_w, qn_g, rope):
    cq = rms_norm(cq_raw, qa_g)
    q = jnp.einsum('bnr,rhe->bhne', cq, qb_w)
    return rope_tail(rms_norm(q, qn_g), rope)


def mla_keys_values(ckv, krope, kvb_w, kn_g, rope):
    b, m, _ = ckv.shape
    kv = jnp.einsum('bmr,rhe->bhme', ckv, kvb_w)
    k_nope, v = kv[..., :MLA_NOPE], kv[..., MLA_NOPE:]
    k_r = jnp.broadcast_to(krope[:, None], (b, MLA_HEADS, m, MLA_ROPE))
    k = rms_norm(jnp.concatenate([k_nope, k_r], axis=-1), kn_g)
    return rope_tail(k, rope), v


def even_mixer(h, w_in, w_out, gate_w2, gate_b, gla_g, qa_g, qb_w, kva_g, kvb_w, qn_g, kn_g, ctx_cache):
    b, n, _ = h.shape
    f32 = jnp.float32
    q, k, v, og, gl_f, gl_b, cq_raw, ckv_raw, krope = split_cols(h @ w_in, EVEN_SPLIT)
    qh = to_heads(q, GLA_HEADS).astype(f32) * GLA_DK ** -0.5
    kh = to_heads(k, GLA_HEADS).astype(f32)
    vh = to_heads(v, GLA_HEADS).astype(f32)
    la_f = to_heads(gla_log_decay(gl_f, gate_w2[0], gate_b[0]), GLA_HEADS)
    la_b = to_heads(gla_log_decay(gl_b, gate_w2[1], gate_b[1]), GLA_HEADS)
    if ctx_cache is None:
        s0_f = jnp.zeros((b, GLA_HEADS, GLA_DK, GLA_DV), f32)
        s0_b = s0_f
        rope = None
    else:
        ckv_c, krope_c, s_c = ctx_cache
        s0_f = s_c[:, 0].astype(f32)
        s0_b = s_c[:, 1].astype(f32)
        rope = axial_rope_tables(n)
    o, s_f, s_b = gla_bidirectional(qh, kh, vh, la_f, la_b, s0_f, s0_b)
    gla_out = from_heads(rms_norm(o, gla_g)).astype(h.dtype) * jax.nn.silu(og)
    ckv = rms_norm(ckv_raw, kva_g)
    qm = mla_queries(cq_raw, qa_g, qb_w, qn_g, rope)
    km, vm = mla_keys_values(ckv, krope, kvb_w, kn_g, rope)
    if ctx_cache is not None:
        kc, vc = mla_keys_values(ckv_c, krope_c, kvb_w, kn_g, None)
        km = jnp.concatenate([kc, km], axis=2)
        vm = jnp.concatenate([vc, vm], axis=2)
    mla_out = from_heads(block_attention(qm, km, vm))
    out = jnp.concatenate([gla_out, mla_out], axis=-1) @ w_out
    if ctx_cache is None:
        return out, (ckv, krope, jnp.stack([s_f, s_b], axis=1))
    return out, None


def odd_mixer(h, w_in, v_g, w_s, b_s, w_out):
    b, n, _ = h.shape
    uv = jax.nn.gelu(h @ w_in)
    u, v = uv[..., :CMLP_WIDTH], uv[..., CMLP_WIDTH:]
    v = rms_norm(v, v_g)
    vg = v.reshape(b, n // CMLP_CHUNK, CMLP_CHUNK, CMLP_GROUPS, CMLP_WIDTH // CMLP_GROUPS)
    mixed = jnp.einsum('gpq,bcqge->bcpge', w_s, vg) + b_s.T[:, :, None]
    return (u * mixed.reshape(b, n, CMLP_WIDTH)) @ w_out


def setup_inputs(seed: int = 0) -> dict:
    key = jax.random.key(seed)
    ks = iter(jax.random.split(key, 40))

    def nrm(shape, scale=1.0):
        return jax.random.normal(next(ks), shape, jnp.float32) * scale

    D, F = D_MODEL, FFN_HIDDEN
    return {
        'x_prompt': nrm((BATCH, SEQ, D)),
        'x_sample': nrm((DEC_BATCH, DEC_SEQ, D)),
        'c': nrm((DEC_BATCH, D)),
        'c_ctx': nrm((D,)),
        'cache_ckv': nrm((DEC_BATCH, N_EVEN, PAST_LEN, MLA_KV_RANK)),
        'cache_krope': nrm((DEC_BATCH, N_EVEN, PAST_LEN, MLA_ROPE)),
        'state_gla': nrm((DEC_BATCH, N_EVEN, 2, GLA_HEADS, GLA_DK, GLA_DV)),
        'ada_w': nrm((DEPTH, D, N_MOD * D), D ** -0.5),
        'ada_b': nrm((DEPTH, N_MOD * D), 0.01),
        'norm_g': 1.0 + nrm((DEPTH, 3, D), 0.02),
        'ffn1_wg': nrm((DEPTH, D, F), D ** -0.5),
        'ffn1_wu': nrm((DEPTH, D, F), D ** -0.5),
        'ffn1_wd': nrm((DEPTH, F, D), F ** -0.5),
        'ffn2_wg': nrm((DEPTH, D, F), D ** -0.5),
        'ffn2_wu': nrm((DEPTH, D, F), D ** -0.5),
        'ffn2_wd': nrm((DEPTH, F, D), F ** -0.5),
        'even_w_in': nrm((N_EVEN, D, EVEN_IN_WIDTH), D ** -0.5),
        'even_w_out': nrm((N_EVEN, EVEN_OUT_WIDTH, D), EVEN_OUT_WIDTH ** -0.5),
        'gla_gate_w2': nrm((N_EVEN, 2, GLA_GATE_RANK, GLA_QK), GLA_GATE_RANK ** -0.5),
        'gla_gate_b': nrm((N_EVEN, 2, GLA_QK), 0.1),
        'gla_norm_g': 1.0 + nrm((N_EVEN, GLA_DV), 0.02),
        'mla_qa_g': 1.0 + nrm((N_EVEN, MLA_Q_RANK), 0.02),
        'mla_qb_w': nrm((N_EVEN, MLA_Q_RANK, MLA_HEADS, MLA_QK_DIM), MLA_Q_RANK ** -0.5),
        'mla_kva_g': 1.0 + nrm((N_EVEN, MLA_KV_RANK), 0.02),
        'mla_kvb_w': nrm((N_EVEN, MLA_KV_RANK, MLA_HEADS, MLA_NOPE + MLA_V), MLA_KV_RANK ** -0.5),
        'mla_qn_g': 1.0 + nrm((N_EVEN, MLA_QK_DIM), 0.02),
        'mla_kn_g': 1.0 + nrm((N_EVEN, MLA_QK_DIM), 0.02),
        'odd_w_in': nrm((N_ODD, D, 2 * CMLP_WIDTH), D ** -0.5),
        'odd_v_g': 1.0 + nrm((N_ODD, CMLP_WIDTH), 0.02),
        'odd_ws': nrm((N_ODD, CMLP_GROUPS, CMLP_CHUNK, CMLP_CHUNK), CMLP_CHUNK ** -0.5),
        'odd_bs': 1.0 + nrm((N_ODD, CMLP_GROUPS, CMLP_CHUNK), 0.1),
        'odd_w_out': nrm((N_ODD, CMLP_WIDTH, D), CMLP_WIDTH ** -0.5),
    }


def reference(x_prompt, x_sample, c, c_ctx, cache_ckv, cache_krope, state_gla, ada_w, ada_b, norm_g,
              ffn1_wg, ffn1_wu, ffn1_wd, ffn2_wg, ffn2_wu, ffn2_wd, even_w_in, even_w_out,
              gla_gate_w2, gla_gate_b, gla_norm_g, mla_qa_g, mla_qb_w, mla_kva_g, mla_kvb_w,
              mla_qn_g, mla_kn_g, odd_w_in, odd_v_g, odd_ws, odd_bs, odd_w_out):

    def run_trunk(x, cond, ctx_caches):
        new_ckv, new_krope, new_gla = [], [], []
        for i in range(DEPTH):
            sh1, sc1, g1, sh2, sc2, g2, sh3, sc3, g3 = modulation(cond, ada_w[i], ada_b[i])
            x = x + 0.5 * g1 * swiglu(modulate(x, norm_g[i, 0], sh1, sc1), ffn1_wg[i], ffn1_wu[i], ffn1_wd[i])
            hm = modulate(x, norm_g[i, 1], sh2, sc2)
            j = i // 2
            if i % 2 == 0:
                cache_j = None if ctx_caches is None else (ctx_caches[0][:, j], ctx_caches[1][:, j], ctx_caches[2][:, j])
                mix, st = even_mixer(hm, even_w_in[j], even_w_out[j], gla_gate_w2[j], gla_gate_b[j], gla_norm_g[j],
                                     mla_qa_g[j], mla_qb_w[j], mla_kva_g[j], mla_kvb_w[j], mla_qn_g[j], mla_kn_g[j],
                                     cache_j)
                if st is not None:
                    new_ckv.append(st[0])
                    new_krope.append(st[1])
                    new_gla.append(st[2].astype(x.dtype))
            else:
                mix = odd_mixer(hm, odd_w_in[j], odd_v_g[j], odd_ws[j], odd_bs[j], odd_w_out[j])
            x = x + g2 * mix
            x = x + 0.5 * g3 * swiglu(modulate(x, norm_g[i, 2], sh3, sc3), ffn2_wg[i], ffn2_wu[i], ffn2_wd[i])
        return x, new_ckv, new_krope, new_gla

    y_prompt, ckv_list, krope_list, gla_list = run_trunk(x_prompt, c_ctx[None, :], None)
    new_ckv = jnp.stack(ckv_list, axis=1)
    new_krope = jnp.stack(krope_list, axis=1)
    new_gla = jnp.stack(gla_list, axis=1)
    y_sample, _, _, _ = run_trunk(x_sample, c, (cache_ckv, cache_krope, state_gla))
    return (y_prompt, y_sample, new_ckv, new_krope, new_gla)
```

```cpp
#include <hip/hip_runtime.h>
#include <hip/hip_cooperative_groups.h>
#include <cstdio>
namespace cg = cooperative_groups;

#define LAS __attribute__((address_space(3)))
typedef unsigned short bf16_t;
typedef short bf16x8 __attribute__((ext_vector_type(8)));
typedef short bf16x4 __attribute__((ext_vector_type(4)));
typedef float f32x4 __attribute__((ext_vector_type(4)));
typedef float f32x2 __attribute__((ext_vector_type(2)));
typedef unsigned u32x4 __attribute__((ext_vector_type(4)));
typedef unsigned u32x2 __attribute__((ext_vector_type(2)));

constexpr int T_CTX = 8192, T_ALL = 16384, T_KV = 18432;
constexpr int PROJ_LD = 2304;
constexpr float EPS = 1e-6f;


constexpr size_t SZ_WGU = (size_t)4 * 5632 * 1024 * 2, SZ_WD = (size_t)4 * 1024 * 2816 * 2;
constexpr size_t OFF_WGU1 = 0;
constexpr size_t OFF_WD1 = OFF_WGU1 + SZ_WGU;
constexpr size_t OFF_WGU2 = OFF_WD1 + SZ_WD;
constexpr size_t OFF_WD2 = OFF_WGU2 + SZ_WGU;
constexpr size_t OFF_WINE = OFF_WD2 + SZ_WD;
constexpr size_t OFF_WOUTE = OFF_WINE + (size_t)2 * 2304 * 1024 * 2;
constexpr size_t OFF_WQB = OFF_WOUTE + (size_t)2 * 1024 * 1024 * 2;
constexpr size_t OFF_WKVB = OFF_WQB + (size_t)2 * 768 * 384 * 2;
constexpr size_t OFF_WINO = OFF_WKVB + (size_t)2 * 1024 * 256 * 2;
constexpr size_t OFF_WOUTO = OFF_WINO + (size_t)2 * 4096 * 1024 * 2;
constexpr size_t OFF_WS = OFF_WOUTO + (size_t)2 * 1024 * 2048 * 2;
constexpr size_t OFF_MOD = OFF_WS + (size_t)2 * 4 * 128 * 128 * 2;
constexpr size_t OFF_H = OFF_MOD + (size_t)4 * 9 * 9216 * 4;
constexpr size_t OFF_U = OFF_H + (size_t)T_ALL * 1024 * 2;
constexpr size_t OFF_ACT = OFF_U;
constexpr size_t OFF_PROJ = OFF_U;
constexpr size_t OFF_CQN = OFF_PROJ + (size_t)T_ALL * PROJ_LD * 2;
constexpr size_t OFF_CKVN = OFF_CQN + (size_t)T_ALL * 384 * 2;
constexpr size_t OFF_QRAW = OFF_CKVN + (size_t)T_KV * 256 * 2;
constexpr size_t OFF_KVRAW = OFF_QRAW + (size_t)T_ALL * 768 * 2;
constexpr size_t OFF_OF = OFF_KVRAW + (size_t)T_KV * 1024 * 2;
constexpr size_t OFF_OB = OFF_OF + (size_t)T_ALL * 512 * 4;
constexpr size_t OFF_CAT = OFF_OB + (size_t)T_ALL * 512 * 4;
constexpr size_t OFF_UV = OFF_U;
constexpr size_t OFF_GATED = OFF_UV + (size_t)T_ALL * 4096 * 2;
constexpr size_t OFF_SSP = OFF_GATED + (size_t)T_ALL * 2048 * 2;

constexpr size_t OFF_BIAS = (size_t)522 << 20;
constexpr size_t OFF_RSP = (size_t)526 << 20;
constexpr size_t OFF_KN = (size_t)456 << 20;
constexpr size_t OFF_VT = (size_t)484 << 20;
constexpr size_t VT_LAT = (size_t)32 * 8 * 64 * 256;
constexpr size_t OUT_CKV = 16777216, OUT_KROPE = 20971520, OUT_GLA = 21495808;

struct Params {
    const float* in[32];
    float* out;
    unsigned char* ws;
    int ph_begin, ph_end;
};

__device__ __forceinline__ int otid() { int t = threadIdx.x; asm volatile("" : "+v"(t)); return t; }
__device__ __forceinline__ int obid() { int t = blockIdx.x; asm volatile("" : "+s"(t)); return t; }
__device__ __forceinline__ int ogrid() { int t = gridDim.x; asm volatile("" : "+s"(t)); return t; }
__device__ __forceinline__ const float* pin(const Params& p, int i) { asm volatile("" : "+s"(i)); return p.in[i]; }
typedef __bf16 bf16x2_t __attribute__((ext_vector_type(2)));
__device__ __forceinline__ unsigned cvt_pk_bf16(float lo, float hi) { const f32x2 v = {lo, hi}; return __builtin_bit_cast(unsigned, __builtin_convertvector(v, bf16x2_t)); }
__device__ __forceinline__ unsigned pack_bf16_sw(float lo, float hi) {
    unsigned a = __float_as_uint(lo), b = __float_as_uint(hi);
    a += 0x7fffu + ((a >> 16) & 1u); b += 0x7fffu + ((b >> 16) & 1u);
    return (a >> 16) | (b & 0xffff0000u);
}
__device__ __forceinline__ bf16_t f2bf(float f) { return (bf16_t)(cvt_pk_bf16(f, 0.f) & 0xffffu); }
__device__ __forceinline__ float bf2f(bf16_t b) { return __uint_as_float(((unsigned)b) << 16); }
__device__ __forceinline__ float bflo(unsigned w) { return __uint_as_float(w << 16); }
__device__ __forceinline__ float bfhi(unsigned w) { return __uint_as_float(w & 0xffff0000u); }
__device__ __forceinline__ float silu_f(float x) { return x * __builtin_amdgcn_rcpf(1.f + __expf(-x)); }
__device__ __forceinline__ float gelu_tanh_f(float x) { const float u = 1.5957691216f * (x + 0.044715f * x * x * x); return x * __builtin_amdgcn_rcpf(1.f + __expf(-u)); }
__device__ __forceinline__ float wave_sum(float v) {
    v += __shfl_xor(v, 1); v += __shfl_xor(v, 2); v += __shfl_xor(v, 4); v += __shfl_xor(v, 8); v += __shfl_xor(v, 16); v += __shfl_xor(v, 32); return v; }

namespace pg8 {
constexpr int BM = 256, BK = 64, HALF = 128, HTB = HALF * BK * 2, STAGE_BYTES = 8 * HTB, NXCD = 8, WGM = 8;
__device__ __forceinline__ int lds_byte(int r, int c) { const int st = (r >> 4) * 2 + (c >> 5), rr = r & 15, cc = c & 31, ob = rr * 64 + cc * 2; return st * 1024 + (ob ^ (((ob >> 9) & 1) << 5)); }
__device__ __forceinline__ void stage_rc(int b, int& R, int& C) { const int st = b / 1024, sb = b % 1024, swz = sb ^ (((sb >> 9) & 1) << 5); R = (st >> 1) * 16 + swz / 64; C = (st & 1) * 32 + (swz % 64) / 2; }
__device__ __forceinline__ int perm32(int rho) { const int n = rho >> 4, i = rho & 15; return 8 * (i >> 2) + 4 * n + (i & 3); }
struct Unit { int pm, pn; };
struct Gemm { const bf16_t* A; const bf16_t* Bt; int M, N, K; };
struct StaticOrder {
    int nM, nN, nwg, G, c;
    __device__ void init(int M, int N, int G_, int c_) { nM = M / BM; nN = N / BM; nwg = nM * nN; G = G_; c = c_; }
    __device__ bool next(int i, Unit& u) const {
        const long L = (long)i * G + c; if (L >= nwg) return false;
        int wgid = (int)L; { const int q = nwg / NXCD, r = nwg % NXCD, xcd = wgid % NXCD, off = wgid / NXCD; wgid = (xcd < r ? xcd * (q + 1) : r * (q + 1) + (xcd - r) * q) + off; }
        const int nig = WGM * nN, gid = wgid / nig, fm = gid * WGM, gsz = (nM - fm) < WGM ? (nM - fm) : WGM;
        u.pm = fm + ((wgid % nig) % gsz); u.pn = (wgid % nig) / gsz; return true;
    }
};

template <class Epi>
__device__ __forceinline__ void gemm_phase(LAS unsigned char* lds, const Gemm g, const StaticOrder& S, const Epi& E) {
    const int tid = otid(), wid = __builtin_amdgcn_readfirstlane(tid >> 6), lane = tid & 63, wr = wid >> 2, wc = wid & 3, fr = lane & 15, fq = lane >> 4;
    const int K = g.K, nt = K / BK;
    unsigned voffA[2], voffB[2];
#pragma unroll
    for (int i = 0; i < 2; ++i) { int R, C; stage_rc(tid * 16 + i * 8192, R, C); const int Rb = Epi::PERM ? ((R & ~31) + perm32(R & 31)) : R;
        voffA[i] = (unsigned)(R * K + C) * 2u; voffB[i] = (unsigned)(Rb * K + C) * 2u; }
    const size_t kstep = (size_t)(BK * 2);
    const size_t hstep = (size_t)HALF * K * 2;
    const size_t tstep = 2 * hstep;
    const unsigned ldsw = (unsigned)wid * 1024u;
    const int aoff = lds_byte(wr * 64 + fr, fq * 8), boff = lds_byte(wc * 32 + fr, fq * 8);
#define PG8_SA(b, h) (((b) * 2 + (h)) * HTB)
#define PG8_SB(b, h) ((4 + (b) * 2 + (h)) * HTB)
#define PG8_STAGE(bufoff, gbase, voff) do { _Pragma("unroll") for (int _i = 0; _i < 2; ++_i) \
        __builtin_amdgcn_global_load_lds((const unsigned*)((const char*)(gbase) + (voff)[_i]), (LAS unsigned*)(lds + (bufoff) + ldsw + _i * 8192), 16, 0, 0); } while (0)
#define PG8_LDA(dst, b, h) do { _Pragma("unroll") for (int m = 0; m < 4; ++m) _Pragma("unroll") for (int k = 0; k < 2; ++k) dst[m][k] = *(const LAS bf16x8*)(lds + PG8_SA(b, h) + aoff + m * 2048 + k * 1024); } while (0)
#define PG8_LDB(dst, b, h) do { _Pragma("unroll") for (int n = 0; n < 2; ++n) _Pragma("unroll") for (int k = 0; k < 2; ++k) dst[n][k] = *(const LAS bf16x8*)(lds + PG8_SB(b, h) + boff + n * 2048 + k * 1024); } while (0)
#define PG8_MMA(ai, bj, At, Bt) do { __builtin_amdgcn_s_setprio(1); _Pragma("unroll") for (int m = 0; m < 4; ++m) _Pragma("unroll") for (int n = 0; n < 2; ++n) _Pragma("unroll") for (int k = 0; k < 2; ++k) \
        acc[ai][bj][m][n] = __builtin_amdgcn_mfma_f32_16x16x32_bf16(Bt[n][k], At[m][k], acc[ai][bj][m][n], 0, 0, 0); __builtin_amdgcn_s_setprio(0); } while (0)
#define PG8_WAIT_V(n) asm volatile("s_waitcnt vmcnt(" #n ")" ::: "memory")
#define PG8_WAIT_L(n) asm volatile("s_waitcnt lgkmcnt(" #n ")" ::: "memory")
#define PG8_BAR __builtin_amdgcn_s_barrier()
#define PG8_SCHED __builtin_amdgcn_sched_barrier(0)
    Unit cur, nxt; int ui = 0;
    if (!S.next(0, cur)) return;
    f32x4 acc[2][2][4][2];
#pragma unroll
    for (int a = 0; a < 2; ++a)
#pragma unroll
        for (int b = 0; b < 2; ++b)
#pragma unroll
            for (int m = 0; m < 4; ++m)
#pragma unroll
                for (int n = 0; n < 2; ++n) acc[a][b][m][n] = (f32x4){0.f, 0.f, 0.f, 0.f};
    bf16x8 At[4][2], B0[2][2], B1[2][2];
    const char* cA = (const char*)g.A + (size_t)cur.pm * tstep; const char* cB = (const char*)g.Bt + (size_t)cur.pn * tstep;
    PG8_STAGE(PG8_SB(0, 0), cB, voffB); PG8_STAGE(PG8_SA(0, 0), cA, voffA); PG8_STAGE(PG8_SB(0, 1), cB + hstep, voffB); PG8_STAGE(PG8_SA(0, 1), cA + hstep, voffA);
    if (wr == 1) PG8_BAR;
    PG8_WAIT_V(4); PG8_BAR;
    PG8_STAGE(PG8_SB(1, 0), cB + kstep, voffB); PG8_STAGE(PG8_SA(1, 0), cA + kstep, voffA); PG8_STAGE(PG8_SB(1, 1), cB + hstep + kstep, voffB);
    PG8_WAIT_V(6); PG8_BAR;
    for (;;) {
        const bool has_next = S.next(ui + 1, nxt);
        const char* nA = has_next ? (const char*)g.A + (size_t)nxt.pm * tstep : cA; const char* nB = has_next ? (const char*)g.Bt + (size_t)nxt.pn * tstep : cB;
        for (int t = 0; t < nt; t += 2) {
            const bool last = (t == nt - 2);
            const char* a1 = cA + (size_t)(t + 1) * kstep;
            const char* a2 = last ? nA : cA + (size_t)(t + 2) * kstep; const char* b2 = last ? nB : cB + (size_t)(t + 2) * kstep;
            const char* a3 = a2 + kstep; const char* b3 = b2 + kstep;
            PG8_LDB(B0, 0, 0); PG8_SCHED; PG8_LDA(At, 0, 0); PG8_STAGE(PG8_SA(1, 1), a1 + hstep, voffA);
            PG8_WAIT_L(8); PG8_BAR; PG8_WAIT_L(0); PG8_MMA(0, 0, At, B0); PG8_BAR; PG8_SCHED;
            PG8_LDB(B1, 0, 1); PG8_STAGE(PG8_SB(0, 0), b2, voffB);
            PG8_BAR; PG8_WAIT_L(0); PG8_MMA(0, 1, At, B1); PG8_BAR;
            PG8_LDA(At, 0, 1); PG8_STAGE(PG8_SA(0, 0), a2, voffA);
            PG8_BAR; PG8_WAIT_L(0); PG8_MMA(1, 0, At, B0); PG8_BAR; PG8_SCHED;
            PG8_STAGE(PG8_SB(0, 1), b2 + hstep, voffB);
            PG8_WAIT_V(6); PG8_BAR; PG8_MMA(1, 1, At, B1); PG8_BAR;
            PG8_LDB(B0, 1, 0); PG8_SCHED; PG8_LDA(At, 1, 0); PG8_STAGE(PG8_SA(0, 1), a2 + hstep, voffA);
            PG8_WAIT_L(8); PG8_BAR; PG8_WAIT_L(0); PG8_MMA(0, 0, At, B0); PG8_BAR; PG8_SCHED;
            PG8_LDB(B1, 1, 1); PG8_STAGE(PG8_SB(1, 0), b3, voffB);
            PG8_BAR; PG8_WAIT_L(0); PG8_MMA(0, 1, At, B1); PG8_BAR;
            PG8_LDA(At, 1, 1); PG8_STAGE(PG8_SA(1, 0), a3, voffA);
            PG8_BAR; PG8_WAIT_L(0); PG8_MMA(1, 0, At, B0); PG8_BAR; PG8_SCHED;
            PG8_STAGE(PG8_SB(1, 1), b3 + hstep, voffB);
            PG8_WAIT_V(6); PG8_BAR; PG8_MMA(1, 1, At, B1); PG8_BAR;
        }
        E(acc, cur, wr, wc, fr, fq);
        if (!has_next) break;
#pragma unroll
        for (int a = 0; a < 2; ++a)
#pragma unroll
            for (int b = 0; b < 2; ++b)
#pragma unroll
                for (int m = 0; m < 4; ++m)
#pragma unroll
                    for (int n = 0; n < 2; ++n) acc[a][b][m][n] = (f32x4){0.f, 0.f, 0.f, 0.f};
        cur = nxt; cA = nA; cB = nB; ++ui;
    }
    PG8_WAIT_V(0);
    if (wr == 0) PG8_BAR;
    PG8_BAR;
#undef PG8_SA
#undef PG8_SB
#undef PG8_STAGE
#undef PG8_LDA
#undef PG8_LDB
#undef PG8_MMA
#undef PG8_WAIT_V
#undef PG8_WAIT_L
#undef PG8_BAR
#undef PG8_SCHED
}
}
using pg8::Unit;


struct Rstd8 { float v[2][4]; };
__device__ __forceinline__ Rstd8 load_rstd8(const float* rsp, int row0, int fq) {
    f32x4 pv[2][4]; Rstd8 r;
#pragma unroll
    for (int ai = 0; ai < 2; ++ai)
#pragma unroll
        for (int m = 0; m < 4; ++m) pv[ai][m] = *(const f32x4*)(rsp + (size_t)(row0 + ai * 128 + m * 16) * 16 + fq * 4);
#pragma unroll
    for (int ai = 0; ai < 2; ++ai)
#pragma unroll
        for (int m = 0; m < 4; ++m) {
            float t = pv[ai][m][0] + pv[ai][m][1] + pv[ai][m][2] + pv[ai][m][3];
            t += __shfl_xor(t, 16); t += __shfl_xor(t, 32);
            r.v[ai][m] = rsqrtf(t * (1.f / 1024.f) + EPS);
        }
    return r;
}
struct EpiSwiGLU {
    static constexpr bool PERM = true;
    bf16_t* O; const float* rsp; const float* bias;
    __device__ __forceinline__ void operator()(const f32x4 (&acc)[2][2][4][2], const Unit& u, int wr, int wc, int fr, int fq) const {
        const int cond = u.pm < 32 ? 0 : 1 + ((u.pm - 32) >> 2);
        const int row0 = u.pm * 256 + wr * 64 + fr, col0 = u.pn * 128 + wc * 32 + 8 * fq;
        const Rstd8 R = load_rstd8(rsp, row0, fq);
        const float* bp = bias + (size_t)cond * 5632 + u.pn * 256 + wc * 32 + 8 * fq;
        const f32x4 bg0 = *(const f32x4*)bp, bg1 = *(const f32x4*)(bp + 4), bu0 = *(const f32x4*)(bp + 128), bu1 = *(const f32x4*)(bp + 132);
#pragma unroll
        for (int ai = 0; ai < 2; ++ai)
#pragma unroll
            for (int m = 0; m < 4; ++m) {
                bf16_t* rowp = O + (size_t)(row0 + ai * 128 + m * 16) * 2816 + col0;
                const float rs = R.v[ai][m];
                f32x4 v0, v1;
#pragma unroll
                for (int j = 0; j < 4; ++j) {
                    v0[j] = silu_f(acc[ai][0][m][0][j] * rs + bg0[j]) * (acc[ai][1][m][0][j] * rs + bu0[j]);
                    v1[j] = silu_f(acc[ai][0][m][1][j] * rs + bg1[j]) * (acc[ai][1][m][1][j] * rs + bu1[j]);
                }
                u32x4 w; w.x = cvt_pk_bf16(v0[0], v0[1]); w.y = cvt_pk_bf16(v0[2], v0[3]); w.z = cvt_pk_bf16(v1[0], v1[1]); w.w = cvt_pk_bf16(v1[2], v1[3]);
                *(u32x4*)rowp = w;
            }
    }
};
struct EpiResid {
    static constexpr bool PERM = false;
    const Params& p; int l; int kind;
    __device__ __forceinline__ void operator()(const f32x4 (&acc)[2][2][4][2], const Unit& u, int wr, int wc, int fr, int fq) const {
        float* X = p.out; const float* mod = (const float*)(p.ws + OFF_MOD);
        const int gidx = kind == 2 ? 2 : (kind == 11 ? 8 : 5);
        const float coef = (kind == 2 || kind == 11) ? 0.5f : 1.0f;
        const float* gate = mod + (size_t)l * 9 * 9216 + gidx * 1024;
        const bool nn = !(kind == 11 && l == 3);
        const int nl = kind == 11 ? (l < 3 ? l + 1 : l) : l, ns = kind == 2 ? 1 : (kind == 11 ? 0 : 2);
        const float* ng = pin(p, 9) + (size_t)(nl * 3 + ns) * 1024;
        const float* msc = mod + (size_t)nl * 9 * 9216 + (size_t)(3 * ns + 1) * 1024;
        bf16_t* H = (bf16_t*)(p.ws + OFF_H); float* rsp = (float*)(p.ws + OFF_RSP);
        const int cond = u.pm < 32 ? 0 : 1 + ((u.pm - 32) >> 2);
        const float* gp = gate + (size_t)cond * 9216;
        const int row0 = u.pm * 256 + wr * 64 + fr, col0 = u.pn * 256 + wc * 32 + 4 * fq;
        f32x4 gv[2][2], gs[2][2];
#pragma unroll
        for (int bj = 0; bj < 2; ++bj)
#pragma unroll
            for (int n = 0; n < 2; ++n) {
                gv[bj][n] = *(const f32x4*)(gp + col0 + bj * 128 + n * 16) * coef;
                gs[bj][n] = (f32x4){0.f, 0.f, 0.f, 0.f};
                if (nn) gs[bj][n] = *(const f32x4*)(ng + col0 + bj * 128 + n * 16) * (*(const f32x4*)(msc + (size_t)cond * 9216 + col0 + bj * 128 + n * 16) + 1.f);
            }
#pragma unroll
        for (int ai = 0; ai < 2; ++ai)
#pragma unroll
            for (int mp = 0; mp < 2; ++mp) {
                f32x4 xv[2][2][2];
#pragma unroll
                for (int mi = 0; mi < 2; ++mi)
#pragma unroll
                    for (int bj = 0; bj < 2; ++bj)
#pragma unroll
                        for (int n = 0; n < 2; ++n) xv[mi][bj][n] = *(const f32x4*)(X + (size_t)(row0 + ai * 128 + (mp * 2 + mi) * 16) * 1024 + col0 + bj * 128 + n * 16);
#pragma unroll
                for (int mi = 0; mi < 2; ++mi) {
                    const int m = mp * 2 + mi;
                    const int row = row0 + ai * 128 + m * 16;
                    float* rowp = X + (size_t)row * 1024 + col0;
                    float ss = 0.f;
#pragma unroll
                    for (int bj = 0; bj < 2; ++bj)
#pragma unroll
                        for (int n = 0; n < 2; ++n) {
                            const f32x4 xn = xv[mi][bj][n] + gv[bj][n] * acc[ai][bj][m][n];
                            *(f32x4*)(rowp + bj * 128 + n * 16) = xn;
                            if (nn) {
                                ss += xn[0] * xn[0] + xn[1] * xn[1] + xn[2] * xn[2] + xn[3] * xn[3];
                                const f32x4 hv = xn * gs[bj][n];
                                u32x2 w; w.x = cvt_pk_bf16(hv[0], hv[1]); w.y = cvt_pk_bf16(hv[2], hv[3]);
                                *(u32x2*)(H + (size_t)row * 1024 + col0 + bj * 128 + n * 16) = w;
                            }
                        }
                    if (nn) { ss += __shfl_xor(ss, 16); ss += __shfl_xor(ss, 32); if (fq == 0) rsp[(size_t)row * 16 + u.pn * 4 + wc] = ss; }
                }
            }
    }
};
struct EpiBf16 {
    static constexpr bool PERM = true;
    bf16_t* O; int ldc; const float* rsp; const float* bias;
    __device__ __forceinline__ void operator()(const f32x4 (&acc)[2][2][4][2], const Unit& u, int wr, int wc, int fr, int fq) const {
        const int row0 = u.pm * 256 + wr * 64 + fr, col0 = u.pn * 256 + wc * 32 + 8 * fq;
        const bool nn = rsp != nullptr;
        f32x4 b0[2], b1[2]; Rstd8 R;
#pragma unroll
        for (int bj = 0; bj < 2; ++bj) { b0[bj] = (f32x4){0.f, 0.f, 0.f, 0.f}; b1[bj] = b0[bj]; }
#pragma unroll
        for (int ai = 0; ai < 2; ++ai)
#pragma unroll
            for (int m = 0; m < 4; ++m) R.v[ai][m] = 1.f;
        if (nn) {
            const int cond = u.pm < 32 ? 0 : 1 + ((u.pm - 32) >> 2);
            R = load_rstd8(rsp, row0, fq);
#pragma unroll
            for (int bj = 0; bj < 2; ++bj) { const float* bp = bias + (size_t)cond * 5632 + col0 + bj * 128; b0[bj] = *(const f32x4*)bp; b1[bj] = *(const f32x4*)(bp + 4); }
        }
#pragma unroll
        for (int ai = 0; ai < 2; ++ai)
#pragma unroll
            for (int m = 0; m < 4; ++m) {
                bf16_t* rowp = O + (size_t)(row0 + ai * 128 + m * 16) * ldc + col0;
                const float rs = R.v[ai][m];
#pragma unroll
                for (int bj = 0; bj < 2; ++bj) {
                    const f32x4 v0 = acc[ai][bj][m][0] * rs + b0[bj], v1 = acc[ai][bj][m][1] * rs + b1[bj];
                    u32x4 w; w.x = cvt_pk_bf16(v0[0], v0[1]); w.y = cvt_pk_bf16(v0[2], v0[3]); w.z = cvt_pk_bf16(v1[0], v1[1]); w.w = cvt_pk_bf16(v1[2], v1[3]);
                    *(u32x4*)(rowp + bj * 128) = w;
                }
            }
    }
};
struct EpiGeluUV {
    static constexpr bool PERM = true;
    bf16_t* O; float* ssp; const float* rsp; const float* bias;
    __device__ __forceinline__ void operator()(const f32x4 (&acc)[2][2][4][2], const Unit& u, int wr, int wc, int fr, int fq) const {
        const int cond = u.pm < 32 ? 0 : 1 + ((u.pm - 32) >> 2);
        const int row0 = u.pm * 256 + wr * 64 + fr, col0 = u.pn * 256 + wc * 32 + 8 * fq;
        const Rstd8 R = load_rstd8(rsp, row0, fq);
        f32x4 b0[2], b1[2];
#pragma unroll
        for (int bj = 0; bj < 2; ++bj) { const float* bp = bias + (size_t)cond * 5632 + col0 + bj * 128; b0[bj] = *(const f32x4*)bp; b1[bj] = *(const f32x4*)(bp + 4); }
#pragma unroll
        for (int ai = 0; ai < 2; ++ai)
#pragma unroll
            for (int m = 0; m < 4; ++m) {
                const int row = row0 + ai * 128 + m * 16;
                bf16_t* rowp = O + (size_t)row * 4096 + col0;
                const float rs = R.v[ai][m];
                float ss = 0.f;
#pragma unroll
                for (int bj = 0; bj < 2; ++bj) {
                    f32x4 v0, v1;
#pragma unroll
                    for (int j = 0; j < 4; ++j) { v0[j] = gelu_tanh_f(acc[ai][bj][m][0][j] * rs + b0[bj][j]); v1[j] = gelu_tanh_f(acc[ai][bj][m][1][j] * rs + b1[bj][j]); ss += v0[j] * v0[j] + v1[j] * v1[j]; }
                    u32x4 w; w.x = cvt_pk_bf16(v0[0], v0[1]); w.y = cvt_pk_bf16(v0[2], v0[3]); w.z = cvt_pk_bf16(v1[0], v1[1]); w.w = cvt_pk_bf16(v1[2], v1[3]);
                    *(u32x4*)(rowp + bj * 128) = w;
                }
                if (u.pn >= 8) { ss += __shfl_xor(ss, 16); ss += __shfl_xor(ss, 32); if (fq == 0) ssp[(size_t)row * 32 + (u.pn - 8) * 4 + wc] = ss; }
            }
    }
};

struct TJob { int src; int batch, K, N; unsigned long long dst; int rows_pb, blk, blk_stride, off; };
__device__ const TJob g_jobs[12] = {
    {10, 4, 1024, 2816, OFF_WGU1, 5632, 128, 256, 0},
    {11, 4, 1024, 2816, OFF_WGU1, 5632, 128, 256, 128},
    {12, 4, 2816, 1024, OFF_WD1, 1024, 1024, 1024, 0},
    {13, 4, 1024, 2816, OFF_WGU2, 5632, 128, 256, 0},
    {14, 4, 1024, 2816, OFF_WGU2, 5632, 128, 256, 128},
    {15, 4, 2816, 1024, OFF_WD2, 1024, 1024, 1024, 0},
    {16, 2, 1024, 2240, OFF_WINE, 2304, 4096, 4096, 0},
    {17, 2, 1024, 1024, OFF_WOUTE, 1024, 1024, 1024, 0},
    {22, 2, 384, 768, OFF_WQB, 768, 1024, 1024, 0},
    {24, 2, 256, 1024, OFF_WKVB, 1024, 1024, 1024, 0},
    {27, 2, 1024, 4096, OFF_WINO, 4096, 4096, 4096, 0},
    {31, 2, 2048, 1024, OFF_WOUTO, 1024, 1024, 1024, 0}};
__device__ __forceinline__ TJob get_job(int j) { return g_jobs[j]; }
constexpr int NJOBS = 12;
__device__ __forceinline__ int job_tiles(const TJob& J) { return J.batch * (J.K / 128) * ((J.N + 127) / 128); }

__device__ __forceinline__ void tt_load(const Params& p, const TJob& J, int t, int tid, f32x4 (&va)[4], f32x4 (&vb)[4]) {
    const int nk = J.K / 128, nn = (J.N + 127) / 128;
    const int bt = t / (nk * nn), rem = t % (nk * nn), kt = rem / nn, ntile = rem % nn;
    const float* src = pin(p, J.src) + (size_t)bt * J.K * J.N + (size_t)(kt * 128) * J.N + ntile * 128;
    const int c4 = tid & 31, r0 = tid >> 5;
    const bool colok = (ntile * 128 + c4 * 4) < J.N;
#pragma unroll
    for (int i = 0; i < 4; ++i) {
        const int k = 2 * (r0 + 16 * i);
        if (colok) { va[i] = *(const f32x4*)(src + (size_t)k * J.N + c4 * 4); vb[i] = *(const f32x4*)(src + (size_t)(k + 1) * J.N + c4 * 4); }
        else { va[i] = (f32x4){0.f, 0.f, 0.f, 0.f}; vb[i] = va[i]; }
    }
}
__device__ __forceinline__ void tt_process(const Params& p, LAS unsigned char* lds, const TJob& J, int t, int tid, const f32x4 (&va)[4], const f32x4 (&vb)[4]) {
    const int nk = J.K / 128, nn = (J.N + 127) / 128;
    const int bt = t / (nk * nn), rem = t % (nk * nn), kt = rem / nn, ntile = rem % nn;
    LAS unsigned* sT = (LAS unsigned*)lds;
    const int c4 = tid & 31, r0 = tid >> 5;
#pragma unroll
    for (int i = 0; i < 4; ++i) {
        const int k2 = r0 + 16 * i;
#pragma unroll
        for (int e = 0; e < 4; ++e) sT[(c4 * 4 + e) * 65 + k2] = cvt_pk_bf16(va[i][e], vb[i][e]);
    }
    __syncthreads();
    bf16_t* dstb = (bf16_t*)(p.ws + J.dst) + (size_t)bt * J.rows_pb * J.K + kt * 128;
    const int k8 = tid & 15, nr = tid >> 4;
#pragma unroll
    for (int i = 0; i < 4; ++i) {
        const int nl = nr + 32 * i, n = ntile * 128 + nl;
        if (n < J.N) {
            u32x4 w; w.x = sT[nl * 65 + k8 * 4]; w.y = sT[nl * 65 + k8 * 4 + 1]; w.z = sT[nl * 65 + k8 * 4 + 2]; w.w = sT[nl * 65 + k8 * 4 + 3];
            const int drow = (n / J.blk) * J.blk_stride + (n % J.blk) + J.off;
            *(u32x4*)(dstb + (size_t)drow * J.K + k8 * 8) = w;
        }
    }
    __syncthreads();
}
__device__ __forceinline__ void transpose_job(const Params& p, LAS unsigned char* lds, const TJob& J, int t0, int nt, int G) {
    const int tid = otid();
    for (int t = t0; t < nt; t += 4 * G) {
        f32x4 va[4][4], vb[4][4];
#pragma unroll
        for (int q = 0; q < 4; ++q) if (t + q * G < nt) tt_load(p, J, t + q * G, tid, va[q], vb[q]);
#pragma unroll
        for (int q = 0; q < 4; ++q) if (t + q * G < nt) tt_process(p, lds, J, t + q * G, tid, va[q], vb[q]);
    }
}

__device__ __forceinline__ void mod_tile(const Params& p, LAS unsigned char* lds, int t) {
    const int tid = otid();
    const int l = t / 72, n0 = (t % 72) * 128;
    LAS float* sC = (LAS float*)lds;
    LAS float* sR = (LAS float*)(lds + 36864);
    { const float* cctx = pin(p, 3); const float* cc = pin(p, 2);
      for (int i = tid; i < 9 * 1024; i += 512) { const int c = i >> 10, k = i & 1023; const float v = c == 0 ? cctx[k] : cc[(c - 1) * 1024 + k]; sC[i] = silu_f(v); } }
    __syncthreads();
    const int cgp = tid & 31, ks = tid >> 5;
    const float* w = pin(p, 7) + (size_t)l * 1024 * 9216 + (size_t)(ks * 64) * 9216 + n0 + cgp * 4;
    f32x4 acc[9];
#pragma unroll
    for (int c = 0; c < 9; ++c) acc[c] = (f32x4){0.f, 0.f, 0.f, 0.f};
    for (int k0 = 0; k0 < 64; k0 += 8) {
        f32x4 wv[8];
#pragma unroll
        for (int i = 0; i < 8; ++i) wv[i] = *(const f32x4*)(w + (size_t)(k0 + i) * 9216);
#pragma unroll
        for (int i = 0; i < 8; ++i)
#pragma unroll
            for (int c = 0; c < 9; ++c) acc[c] += wv[i] * sC[c * 1024 + ks * 64 + k0 + i];
    }
#pragma unroll
    for (int c = 0; c < 9; ++c) *(LAS f32x4*)(sR + (ks * 9 + c) * 128 + cgp * 4) = acc[c];
    __syncthreads();
    float* mod = (float*)(p.ws + OFF_MOD);
    const float* adab = pin(p, 8);
    for (int i = tid; i < 9 * 128; i += 512) {
        const int c = i >> 7, col = i & 127;
        float s = adab[l * 9216 + n0 + col];
#pragma unroll
        for (int k = 0; k < 16; ++k) s += sR[(k * 9 + c) * 128 + col];
        mod[((size_t)l * 9 + c) * 9216 + n0 + col] = s;
    }
    __syncthreads();
}

__device__ __forceinline__ void prologue_phase(const Params& p, LAS unsigned char* lds) {
    const int tid = otid(), G = ogrid(), bid = obid();
    for (int t = bid; t < 288; t += G) mod_tile(p, lds, t);
    {
        const float* s = pin(p, 29); bf16_t* d = (bf16_t*)(p.ws + OFF_WS);
        for (int i = bid * 512 + tid; i < 2 * 4 * 128 * 128 / 2; i += G * 512) ((unsigned*)d)[i] = cvt_pk_bf16(s[2 * i], s[2 * i + 1]);
    }
    int base = 0;
    for (int j = 0; j < NJOBS; ++j) {
        const TJob J = get_job(j); const int nt = job_tiles(J);
        transpose_job(p, lds, J, (bid + G - (base % G)) % G, nt, G);
        base += nt;
    }
}


__device__ __forceinline__ void bias_items(const Params& p, LAS unsigned char* lds, int first, int last, int stride) {
    const int tid = otid(), wid = tid >> 6, lane = tid & 63;
    const float* mod = (const float*)(p.ws + OFF_MOD);
    LAS float* sC = (LAS float*)lds;
    LAS float* sP = (LAS float*)(lds + 36864);
    float* biasb = (float*)(p.ws + OFF_BIAS);
    for (int item = first; item < last; item += stride) {
        int u = 0, c0 = item;
#pragma unroll 1
        for (;;) { const int s3 = u % 3, lo = u / 3; const int nch = (s3 == 1) ? ((lo & 1) ? 32 : 18) : 44; if (c0 < nch) break; c0 -= nch; ++u; }
        const int l = u / 3, s3 = u % 3, j = l >> 1;
        const bf16_t* Bt = (s3 == 0) ? (const bf16_t*)(p.ws + OFF_WGU1) + (size_t)l * 5632 * 1024
                         : (s3 == 2) ? (const bf16_t*)(p.ws + OFF_WGU2) + (size_t)l * 5632 * 1024
                         : (l & 1)   ? (const bf16_t*)(p.ws + OFF_WINO) + (size_t)j * 4096 * 1024
                                     : (const bf16_t*)(p.ws + OFF_WINE) + (size_t)j * 2304 * 1024;
        __syncthreads();
        {
            float tmp[18];
#pragma unroll
            for (int i = 0; i < 18; ++i) { const int idx = tid + 512 * i, c = idx >> 10, k = idx & 1023; tmp[i] = mod[((size_t)l * 9 + c) * 9216 + (size_t)(3 * s3) * 1024 + k]; }
#pragma unroll
            for (int i = 0; i < 18; ++i) sC[tid + 512 * i] = tmp[i];
        }
        __syncthreads();
        const int rw = (wid & 1) * 64 + lane, ks = wid >> 1;
        const bf16_t* wrow = Bt + (size_t)(c0 * 128 + rw) * 1024 + ks * 256;
        float acc[9];
#pragma unroll
        for (int c = 0; c < 9; ++c) acc[c] = 0.f;
#pragma unroll 4
        for (int kk = 0; kk < 256; kk += 8) {
            const u32x4 ww = *(const u32x4*)(wrow + kk);
            float wv[8];
#pragma unroll
            for (int e = 0; e < 4; ++e) { wv[2 * e] = bflo(ww[e]); wv[2 * e + 1] = bfhi(ww[e]); }
#pragma unroll
            for (int c = 0; c < 9; ++c) {
                const f32x4 s0 = *(const LAS f32x4*)(sC + c * 1024 + ks * 256 + kk), s1 = *(const LAS f32x4*)(sC + c * 1024 + ks * 256 + kk + 4);
                acc[c] += wv[0] * s0[0] + wv[1] * s0[1] + wv[2] * s0[2] + wv[3] * s0[3] + wv[4] * s1[0] + wv[5] * s1[1] + wv[6] * s1[2] + wv[7] * s1[3];
            }
        }
#pragma unroll
        for (int c = 0; c < 9; ++c) sP[(ks * 9 + c) * 128 + rw] = acc[c];
        __syncthreads();
        for (int idx = tid; idx < 9 * 128; idx += 512) {
            const int c = idx >> 7, r = idx & 127;
            const float t = sP[(0 * 9 + c) * 128 + r] + sP[(1 * 9 + c) * 128 + r] + sP[(2 * 9 + c) * 128 + r] + sP[(3 * 9 + c) * 128 + r];
            biasb[((size_t)u * 9 + c) * 5632 + c0 * 128 + r] = t;
        }
    }
    __syncthreads();
}


__device__ __forceinline__ void prologue_b(const Params& p, LAS unsigned char* lds) {
    const int tid = otid(), wid = tid >> 6, lane = tid & 63, bid = obid(), G = ogrid();
    const float* mod = (const float*)(p.ws + OFF_MOD);
    {
        const float* g = pin(p, 9); const float* x0 = pin(p, 0); const float* x1 = pin(p, 1);
        bf16_t* h = (bf16_t*)(p.ws + OFF_H); float* rsp = (float*)(p.ws + OFF_RSP);
        for (int row = bid * 8 + wid; row < T_ALL; row += G * 8) {
            const int cond = row < T_CTX ? 0 : 1 + ((row - T_CTX) >> 10);
            const float* src = row < T_CTX ? x0 + (size_t)row * 1024 : x1 + (size_t)(row - T_CTX) * 1024;
            const float* mp = mod + (size_t)cond * 9216 + 1024;
            f32x4 v[4]; float ss = 0.f;
#pragma unroll
            for (int i = 0; i < 4; ++i) { v[i] = *(const f32x4*)(src + i * 256 + lane * 4); ss += v[i][0] * v[i][0] + v[i][1] * v[i][1] + v[i][2] * v[i][2] + v[i][3] * v[i][3]; }
            ss = wave_sum(ss);
#pragma unroll
            for (int i = 0; i < 4; ++i) {
                const int col = i * 256 + lane * 4;
                const f32x4 gs = *(const f32x4*)(g + col) * (*(const f32x4*)(mp + col) + 1.f);
                const f32x4 hv = v[i] * gs;
                u32x2 w; w.x = cvt_pk_bf16(hv[0], hv[1]); w.y = cvt_pk_bf16(hv[2], hv[3]);
                *(u32x2*)(h + (size_t)row * 1024 + col) = w;
                *(f32x4*)(p.out + (size_t)row * 1024 + col) = v[i];
            }
            if (lane < 16) rsp[(size_t)row * 16 + lane] = lane == 0 ? ss : 0.f;
        }
    }
    bias_items(p, lds, bid, 44, G);
}

__device__ __forceinline__ f32x4 mfma16(bf16x8 a, bf16x8 b, f32x4 c) { return __builtin_amdgcn_mfma_f32_16x16x32_bf16(a, b, c, 0, 0, 0); }

__device__ __forceinline__ void gla_unit(const Params& p, LAS unsigned char* lds, int j, int unit) {
    const int tid = otid(), wid = tid >> 6, lane = tid & 63, fr = lane & 15, fq = lane >> 4;
    int b, h, dir, Tn, row0; bool lat;
    if (unit < 64) { lat = true; b = unit >> 3; h = (unit >> 1) & 3; dir = unit & 1; Tn = 1024; row0 = T_CTX + b * 1024; }
    else { const int u2 = unit - 64; lat = false; b = u2 >> 3; h = (u2 >> 1) & 3; dir = u2 & 1; Tn = 256; row0 = b * 256; }
    const bf16_t* proj = (const bf16_t*)(p.ws + OFF_PROJ);
    float* obuf = (float*)(p.ws + (dir ? OFF_OB : OFF_OF));
    LAS bf16_t* sQ = (LAS bf16_t*)lds;
    LAS bf16_t* sK = (LAS bf16_t*)(lds + 9216);
    LAS bf16_t* sKT = (LAS bf16_t*)(lds + 18432);
    LAS bf16_t* sVT = (LAS bf16_t*)(lds + 27648);
    LAS bf16_t* sAtt = (LAS bf16_t*)(lds + 46080);
    LAS bf16_t* sST = (LAS bf16_t*)(lds + 55296);
    LAS float* sCum = (LAS float*)(lds + 73728);
    LAS float* sGl = (LAS float*)(lds + 90112);
    LAS float* sSeg = (LAS float*)(lds + 94208);
    LAS float* sLast = (LAS float*)(lds + 96256);
    const int d_ = tid & 63, seg = tid >> 6;
    float w2r[16];
    const float* w2p = pin(p, 18); const float* stp = pin(p, 6);
#pragma unroll
    for (int r = 0; r < 16; ++r) w2r[r] = w2p[(size_t)((j * 2 + dir) * 16 + r) * 256 + h * 64 + d_];
    const float bz = pin(p, 19)[(j * 2 + dir) * 256 + h * 64 + d_];
    f32x4 Sacc[4];
    const size_t sbase_in = ((((size_t)b * 2 + j) * 2 + dir) * 4 + h) * 64 * 128;
#pragma unroll
    for (int dt = 0; dt < 4; ++dt) {
#pragma unroll
        for (int reg = 0; reg < 4; ++reg) Sacc[dt][reg] = lat ? stp[sbase_in + (size_t)(dt * 16 + fq * 4 + reg) * 128 + wid * 16 + fr] : 0.f;
        u32x2 w; w.x = cvt_pk_bf16(Sacc[dt][0], Sacc[dt][1]); w.y = cvt_pk_bf16(Sacc[dt][2], Sacc[dt][3]);
        *(LAS u32x2*)(sST + (wid * 16 + fr) * 72 + dt * 16 + fq * 4) = w;
    }
    const int nch = Tn / 64;
    const int sig = tid >> 3, part = tid & 7;
    u32x4 pq, pk; bf16x8 pv0, pv1; unsigned pgl;
#define GLA_LOAD(C) do { const int tokl_ = dir ? (Tn - 1 - ((C) * 64 + sig)) : ((C) * 64 + sig); const bf16_t* pr_ = proj + (size_t)(row0 + tokl_) * PROJ_LD; \
        pq = *(const u32x4*)(pr_ + h * 64 + part * 8); pk = *(const u32x4*)(pr_ + 256 + h * 64 + part * 8); \
        pv0 = *(const bf16x8*)(pr_ + 512 + h * 128 + part * 16); pv1 = *(const bf16x8*)(pr_ + 512 + h * 128 + part * 16 + 8); \
        pgl = *(const unsigned*)(pr_ + 1536 + dir * 16 + part * 2); } while (0)
    GLA_LOAD(0);
    for (int c = 0; c < nch; ++c) {
        const u32x4 qv = pq, kv = pk; const bf16x8 v0 = pv0, v1 = pv1; const unsigned glw = pgl;
        if (c + 1 < nch) GLA_LOAD(c + 1);
        sGl[sig * 16 + part * 2] = bflo(glw); sGl[sig * 16 + part * 2 + 1] = bfhi(glw);
        __syncthreads();
        float cumv[8]; float run = 0.f;
#pragma unroll
        for (int i = 0; i < 8; ++i) {
            const int tau = seg * 8 + i; float z = bz;
#pragma unroll
            for (int r = 0; r < 16; ++r) z += sGl[tau * 16 + r] * w2r[r];
            const float la = (fminf(z, 0.f) - __logf(1.f + __expf(-fabsf(z)))) * (1.f / 16.f);
            run += la; cumv[i] = run;
        }
        sSeg[seg * 64 + d_] = run;
        __syncthreads();
        float pre = 0.f;
#pragma unroll
        for (int s = 0; s < 7; ++s) pre += (s < seg) ? sSeg[s * 64 + d_] : 0.f;
#pragma unroll
        for (int i = 0; i < 8; ++i) sCum[(seg * 8 + i) * 64 + d_] = cumv[i] + pre;
        if (seg == 7) sLast[d_] = __expf(cumv[7] + pre);
        __syncthreads();
        {
            float qf[8], kt[8], kh[8];
#pragma unroll
            for (int e2 = 0; e2 < 4; ++e2) {
                const unsigned qw = qv[e2], kw = kv[e2];
#pragma unroll
                for (int hh = 0; hh < 2; ++hh) {
                    const int e = e2 * 2 + hh, d = part * 8 + e;
                    const float cm = sCum[sig * 64 + d], lc = sCum[63 * 64 + d];
                    const float q_ = hh ? bfhi(qw) : bflo(qw), k_ = hh ? bfhi(kw) : bflo(kw);
                    qf[e] = q_ * 0.125f * __expf(cm); kt[e] = k_ * __expf(-cm); kh[e] = k_ * __expf(lc - cm);
                }
            }
            u32x4 wq, wk;
            wq.x = cvt_pk_bf16(qf[0], qf[1]); wq.y = cvt_pk_bf16(qf[2], qf[3]); wq.z = cvt_pk_bf16(qf[4], qf[5]); wq.w = cvt_pk_bf16(qf[6], qf[7]);
            wk.x = cvt_pk_bf16(kt[0], kt[1]); wk.y = cvt_pk_bf16(kt[2], kt[3]); wk.z = cvt_pk_bf16(kt[4], kt[5]); wk.w = cvt_pk_bf16(kt[6], kt[7]);
            *(LAS u32x4*)(sQ + sig * 72 + part * 8) = wq;
            *(LAS u32x4*)(sK + sig * 72 + part * 8) = wk;
#pragma unroll
            for (int e = 0; e < 8; ++e) sKT[(part * 8 + e) * 72 + (sig ^ (part << 3))] = f2bf(kh[e]);
#pragma unroll
            for (int e = 0; e < 8; ++e) { sVT[(part * 16 + e) * 72 + (sig ^ (part << 3))] = (bf16_t)v0[e]; sVT[(part * 16 + 8 + e) * 72 + (sig ^ (part << 3))] = (bf16_t)v1[e]; }
        }
        __syncthreads();
        {
            const int taut = wid >> 1;
#pragma unroll
            for (int s2 = 0; s2 < 2; ++s2) {
                const int sigt = (wid & 1) * 2 + s2;
                f32x4 a4 = (f32x4){0.f, 0.f, 0.f, 0.f};
#pragma unroll
                for (int kk = 0; kk < 2; ++kk) {
                    const bf16x8 a = *(const LAS bf16x8*)(sK + (sigt * 16 + fr) * 72 + kk * 32 + fq * 8);
                    const bf16x8 bq = *(const LAS bf16x8*)(sQ + (taut * 16 + fr) * 72 + kk * 32 + fq * 8);
                    a4 = mfma16(a, bq, a4);
                }
#pragma unroll
                for (int reg = 0; reg < 4; ++reg) a4[reg] = ((sigt * 16 + fq * 4 + reg) <= (taut * 16 + fr)) ? a4[reg] : 0.f;
                u32x2 w; w.x = cvt_pk_bf16(a4[0], a4[1]); w.y = cvt_pk_bf16(a4[2], a4[3]);
                *(LAS u32x2*)(sAtt + (taut * 16 + fr) * 72 + sigt * 16 + fq * 4) = w;
            }
        }
        __syncthreads();
#pragma unroll
        for (int taut = 0; taut < 4; ++taut) {
            f32x4 o4 = (f32x4){0.f, 0.f, 0.f, 0.f};
#pragma unroll
            for (int kk = 0; kk < 2; ++kk) {
                const bf16x8 a = *(const LAS bf16x8*)(sQ + (taut * 16 + fr) * 72 + kk * 32 + fq * 8);
                const u32x4 bbu = *(const LAS u32x4*)(sST + (wid * 16 + fr) * 72 + kk * 32 + fq * 8);
                o4 = mfma16(a, __builtin_bit_cast(bf16x8, bbu), o4);
            }
#pragma unroll
            for (int kk = 0; kk < 2; ++kk) {
                const bf16x8 a = *(const LAS bf16x8*)(sAtt + (taut * 16 + fr) * 72 + kk * 32 + fq * 8);
                const bf16x8 bb = *(const LAS bf16x8*)(sVT + (wid * 16 + fr) * 72 + (((kk * 4 + fq) ^ wid) << 3));
                o4 = mfma16(a, bb, o4);
            }
#pragma unroll
            for (int reg = 0; reg < 4; ++reg) {
                const int tau = taut * 16 + fq * 4 + reg;
                const int tk = dir ? (Tn - 1 - (c * 64 + tau)) : (c * 64 + tau);
                obuf[(size_t)(row0 + tk) * 512 + h * 128 + wid * 16 + fr] = o4[reg];
            }
        }
        __syncthreads();
#pragma unroll
        for (int dt = 0; dt < 4; ++dt) {
#pragma unroll
            for (int reg = 0; reg < 4; ++reg) Sacc[dt][reg] *= sLast[dt * 16 + fq * 4 + reg];
#pragma unroll
            for (int kk = 0; kk < 2; ++kk) {
                const bf16x8 a = *(const LAS bf16x8*)(sKT + (dt * 16 + fr) * 72 + (((kk * 4 + fq) ^ (dt * 2 + (fr >> 3))) << 3));
                const bf16x8 bb = *(const LAS bf16x8*)(sVT + (wid * 16 + fr) * 72 + (((kk * 4 + fq) ^ wid) << 3));
                Sacc[dt] = mfma16(a, bb, Sacc[dt]);
            }
            u32x2 w; w.x = cvt_pk_bf16(Sacc[dt][0], Sacc[dt][1]); w.y = cvt_pk_bf16(Sacc[dt][2], Sacc[dt][3]);
            *(LAS u32x2*)(sST + (wid * 16 + fr) * 72 + dt * 16 + fq * 4) = w;
        }
        __syncthreads();
    }
    if (!lat) {
        float* og = p.out + OUT_GLA + ((((size_t)b * 2 + j) * 2 + dir) * 4 + h) * 64 * 128;
#pragma unroll
        for (int dt = 0; dt < 4; ++dt)
#pragma unroll
            for (int reg = 0; reg < 4; ++reg) og[(size_t)(dt * 16 + fq * 4 + reg) * 128 + wid * 16 + fr] = Sacc[dt][reg];
    }
}

__device__ __forceinline__ void mla_prep_tile(const Params& p, int j, int t) {
    const int tid = otid(), wid = tid >> 6, lane = tid & 63;
    const bf16_t* proj = (const bf16_t*)(p.ws + OFF_PROJ);
    bf16_t* cqn = (bf16_t*)(p.ws + OFF_CQN); bf16_t* ckvn = (bf16_t*)(p.ws + OFF_CKVN);
    const float* qag = pin(p, 21); const float* kvag = pin(p, 23); const float* cckv = pin(p, 4);
    for (int i = 0; i < 8; ++i) {
        const int r = t * 64 + wid * 8 + i;
        if (r < T_ALL) {
            const bf16_t* pr = proj + (size_t)r * PROJ_LD;
            float cq[6]; float ss = 0.f;
#pragma unroll
            for (int k = 0; k < 3; ++k) { const unsigned w = *(const unsigned*)(pr + 1568 + k * 128 + lane * 2); cq[2 * k] = bflo(w); cq[2 * k + 1] = bfhi(w); ss += cq[2 * k] * cq[2 * k] + cq[2 * k + 1] * cq[2 * k + 1]; }
            ss = wave_sum(ss);
            const float rq = rsqrtf(ss * (1.f / 384.f) + EPS);
#pragma unroll
            for (int k = 0; k < 3; ++k) { const int col = k * 128 + lane * 2; const float g0 = qag[j * 384 + col], g1 = qag[j * 384 + col + 1];
                *(unsigned*)(cqn + (size_t)r * 384 + col) = cvt_pk_bf16(cq[2 * k] * rq * g0, cq[2 * k + 1] * rq * g1); }
            const u32x2 kw = *(const u32x2*)(pr + 1952 + lane * 4);
            float kv[4] = {bflo(kw.x), bfhi(kw.x), bflo(kw.y), bfhi(kw.y)};
            float s2 = kv[0] * kv[0] + kv[1] * kv[1] + kv[2] * kv[2] + kv[3] * kv[3];
            s2 = wave_sum(s2);
            const float rk = rsqrtf(s2 * (1.f / 256.f) + EPS);
            const f32x4 gk = *(const f32x4*)(kvag + j * 256 + lane * 4);
            f32x4 y;
#pragma unroll
            for (int e = 0; e < 4; ++e) y[e] = kv[e] * rk * gk[e];
            u32x2 w; w.x = cvt_pk_bf16(y[0], y[1]); w.y = cvt_pk_bf16(y[2], y[3]);
            *(u32x2*)(ckvn + (size_t)r * 256 + lane * 4) = w;
            if (r < T_CTX) {
                const int bb = r >> 8, tt = r & 255;
                *(f32x4*)(p.out + OUT_CKV + (((size_t)bb * 2 + j) * 256 + tt) * 256 + lane * 4) = y;
                if (lane < 32) p.out[OUT_KROPE + (((size_t)bb * 2 + j) * 256 + tt) * 32 + lane] = bf2f(pr[2208 + lane]);
            }
        } else {
            const int rc = r - T_ALL, bb = rc >> 8, m = rc & 255;
            const f32x4 v = *(const f32x4*)(cckv + (((size_t)bb * 2 + j) * 256 + m) * 256 + lane * 4);
            u32x2 w; w.x = cvt_pk_bf16(v[0], v[1]); w.y = cvt_pk_bf16(v[2], v[3]);
            *(u32x2*)(ckvn + (size_t)r * 256 + lane * 4) = w;
        }
    }
}

__device__ __forceinline__ void even2_phase(const Params& p, LAS unsigned char* lds, int j) {
    const int bid = obid(), G = ogrid();
    if (G >= 128) {
        if (bid < 64) { gla_unit(p, lds, j, bid); __syncthreads(); }
        else { for (int it = 64 + (bid - 64); it < 608; it += (G - 64)) { if (it < 320) { gla_unit(p, lds, j, it); __syncthreads(); } else mla_prep_tile(p, j, it - 320); } }
    } else {
        for (int it = bid; it < 608; it += G) { if (it < 320) { gla_unit(p, lds, j, it); __syncthreads(); } else mla_prep_tile(p, j, it - 320); }
    }
}


__device__ __forceinline__ float rope_inv(int i) { return __builtin_amdgcn_exp2f(-(float)(i & 7) * 1.6609640474f); }


__device__ __forceinline__ void kprep_tile(const Params& p, LAS unsigned char* lds, int j, int tile) {
    const int tid = otid();
    const int rt = tile >> 3, h = tile & 7, row0 = rt * 64;
    const bf16_t* proj = (const bf16_t*)(p.ws + OFF_PROJ); const bf16_t* kvraw = (const bf16_t*)(p.ws + OFF_KVRAW);
    bf16_t* KN = (bf16_t*)(p.ws + OFF_KN); bf16_t* VT = (bf16_t*)(p.ws + OFF_VT);
    LAS bf16_t* sVT = (LAS bf16_t*)lds;
    const float* kg = pin(p, 26) + j * 96; const float* ckr = pin(p, 5);
    const int key = tid >> 3, part = tid & 7, row = row0 + key;
    float kr[4]; bool rope = false; int pos = 0;
    if (row < T_ALL) { const u32x2 w = *(const u32x2*)(proj + (size_t)row * PROJ_LD + 2208 + part * 4); kr[0] = bflo(w.x); kr[1] = bfhi(w.x); kr[2] = bflo(w.y); kr[3] = bfhi(w.y);
        if (row >= T_CTX) { rope = true; pos = (row - T_CTX) & 1023; } }
    else { const int rc = row - T_ALL, bb = rc >> 8, m = rc & 255; const f32x4 w = *(const f32x4*)(ckr + (((size_t)bb * 2 + j) * 256 + m) * 32 + part * 4); kr[0] = w[0]; kr[1] = w[1]; kr[2] = w[2]; kr[3] = w[3]; }
    const bf16_t* kp = kvraw + (size_t)row * 1024 + h * 128;
    const u32x4 kn = *(const u32x4*)(kp + part * 8); const bf16x8 vv = *(const bf16x8*)(kp + 64 + part * 8);
    float kf[8];
#pragma unroll
    for (int e = 0; e < 4; ++e) { kf[2 * e] = bflo(kn[e]); kf[2 * e + 1] = bfhi(kn[e]); }
    float ss = kr[0] * kr[0] + kr[1] * kr[1] + kr[2] * kr[2] + kr[3] * kr[3];
#pragma unroll
    for (int e = 0; e < 8; ++e) ss += kf[e] * kf[e];
    ss += __shfl_xor(ss, 1); ss += __shfl_xor(ss, 2); ss += __shfl_xor(ss, 4);
    const float rstd = rsqrtf(ss * (1.f / 96.f) + EPS);
#pragma unroll
    for (int e = 0; e < 8; ++e) kf[e] *= rstd * kg[part * 8 + e];
#pragma unroll
    for (int e = 0; e < 4; ++e) kr[e] *= rstd * kg[64 + part * 4 + e];
    if (rope) {
        const float prow = (float)(pos >> 6), pcol = (float)(pos & 63);
#pragma unroll
        for (int pr = 0; pr < 2; ++pr) {
            const int i = part * 2 + pr;
            const float ang = (i < 8 ? prow : pcol) * rope_inv(i);
            const float rev = ang * 0.15915494309f;
            const float cs = __builtin_amdgcn_cosf(rev), sn = __builtin_amdgcn_sinf(rev);
            const float x1 = kr[2 * pr], x2 = kr[2 * pr + 1];
            kr[2 * pr] = x1 * cs - x2 * sn; kr[2 * pr + 1] = x1 * sn + x2 * cs;
        }
    }
    bf16_t* kd = KN + ((size_t)row * 8 + h) * 96;
    u32x4 w; w.x = cvt_pk_bf16(kf[0], kf[1]); w.y = cvt_pk_bf16(kf[2], kf[3]); w.z = cvt_pk_bf16(kf[4], kf[5]); w.w = cvt_pk_bf16(kf[6], kf[7]);
    *(u32x4*)(kd + part * 8) = w;
    u32x2 w2; w2.x = cvt_pk_bf16(kr[0], kr[1]); w2.y = cvt_pk_bf16(kr[2], kr[3]);
    *(u32x2*)(kd + 64 + part * 4) = w2;
#pragma unroll
    for (int e = 0; e < 8; ++e) sVT[(part * 8 + e) * 72 + key] = (bf16_t)vv[e];
    __syncthreads();
    {
        size_t base; int nk, k0;
        if (row0 < T_CTX) { base = (size_t)((row0 >> 8) * 8 + h) * 64 * 256; nk = 256; k0 = row0 & 255; }
        else if (row0 < T_ALL) { base = VT_LAT + (size_t)(((row0 - T_CTX) >> 10) * 8 + h) * 64 * 1280; nk = 1280; k0 = 256 + ((row0 - T_CTX) & 1023); }
        else { base = VT_LAT + (size_t)(((row0 - T_ALL) >> 8) * 8 + h) * 64 * 1280; nk = 1280; k0 = (row0 - T_ALL) & 255; }
        const int dv = tid >> 3, c8 = tid & 7;
        *(u32x4*)(VT + base + (size_t)dv * nk + k0 + c8 * 8) = *(const LAS u32x4*)(sVT + dv * 72 + c8 * 8);
    }
    __syncthreads();
}

__device__ __forceinline__ void attn_tile(const Params& p, LAS unsigned char* lds, int j, int tile) {
    const int tid = otid(), wid = tid >> 6, lane = tid & 63, fr = lane & 15, fq = lane >> 4;
    bool lat; int b, h, qb, nkb, qrow0;
    if (tile < 512) { lat = true; b = tile >> 6; h = (tile >> 3) & 7; qb = tile & 7; nkb = 20; qrow0 = T_CTX + b * 1024 + qb * 128; }
    else { const int t2 = tile - 512; lat = false; b = t2 >> 4; h = (t2 >> 1) & 7; qb = t2 & 1; nkb = 4; qrow0 = b * 256 + qb * 128; }
    const bf16_t* proj = (const bf16_t*)(p.ws + OFF_PROJ);
    const bf16_t* qraw = (const bf16_t*)(p.ws + OFF_QRAW);
    const bf16_t* kvraw = (const bf16_t*)(p.ws + OFF_KVRAW);
    bf16_t* cat = (bf16_t*)(p.ws + OFF_CAT);
    LAS bf16_t* sQ = (LAS bf16_t*)lds;
    LAS bf16_t* sK = (LAS bf16_t*)(lds + 26624);
    LAS bf16_t* sVT = (LAS bf16_t*)(lds + 39936);
    {
        const int q = tid >> 2, part = tid & 3;
        const bf16_t* qp = qraw + (size_t)(qrow0 + q) * 768 + h * 96;
        const u32x4 n0 = *(const u32x4*)(qp + part * 16), n1 = *(const u32x4*)(qp + part * 16 + 8), rp = *(const u32x4*)(qp + 64 + part * 8);
        float f[24];
#pragma unroll
        for (int e = 0; e < 4; ++e) { f[2 * e] = bflo(n0[e]); f[2 * e + 1] = bfhi(n0[e]); f[8 + 2 * e] = bflo(n1[e]); f[8 + 2 * e + 1] = bfhi(n1[e]); f[16 + 2 * e] = bflo(rp[e]); f[16 + 2 * e + 1] = bfhi(rp[e]); }
        float ss = 0.f;
#pragma unroll
        for (int e = 0; e < 24; ++e) ss += f[e] * f[e];
        ss += __shfl_xor(ss, 1); ss += __shfl_xor(ss, 2);
        const float rstd = rsqrtf(ss * (1.f / 96.f) + EPS);
        const float* g = pin(p, 25) + j * 96;
#pragma unroll
        for (int e = 0; e < 16; ++e) f[e] *= rstd * g[part * 16 + e];
#pragma unroll
        for (int e = 0; e < 8; ++e) f[16 + e] *= rstd * g[64 + part * 8 + e];
        if (lat) {
            const int pos = qb * 128 + q; const float prow = (float)(pos >> 6), pcol = (float)(pos & 63);
#pragma unroll
            for (int pr = 0; pr < 4; ++pr) {
                const int i = part * 4 + pr;
                const float ang = (i < 8 ? prow : pcol) * rope_inv(i);
                const float rev = ang * 0.15915494309f;
                const float cs = __builtin_amdgcn_cosf(rev), sn = __builtin_amdgcn_sinf(rev);
                const float x1 = f[16 + 2 * pr], x2 = f[16 + 2 * pr + 1];
                f[16 + 2 * pr] = x1 * cs - x2 * sn; f[16 + 2 * pr + 1] = x1 * sn + x2 * cs;
            }
        }
        const float sc = 0.10206207262f * 1.44269504089f;
        u32x4 w0, w1, w2;
#pragma unroll
        for (int e = 0; e < 4; ++e) { w0[e] = cvt_pk_bf16(f[2 * e] * sc, f[2 * e + 1] * sc); w1[e] = cvt_pk_bf16(f[8 + 2 * e] * sc, f[8 + 2 * e + 1] * sc); w2[e] = cvt_pk_bf16(f[16 + 2 * e] * sc, f[16 + 2 * e + 1] * sc); }
        *(LAS u32x4*)(sQ + q * 104 + part * 16) = w0; *(LAS u32x4*)(sQ + q * 104 + part * 16 + 8) = w1; *(LAS u32x4*)(sQ + q * 104 + 64 + part * 8) = w2;
    }
    __syncthreads();
    bf16x8 bQ[3];
#pragma unroll
    for (int kk = 0; kk < 3; ++kk) bQ[kk] = *(const LAS bf16x8*)(sQ + (wid * 16 + fr) * 104 + kk * 32 + fq * 8);
    float m_run = -1e30f, l_run = 0.f;
    f32x4 oacc[4];
#pragma unroll
    for (int dt = 0; dt < 4; ++dt) oacc[dt] = (f32x4){0.f, 0.f, 0.f, 0.f};
    const float* kg = pin(p, 26) + j * 96; const float* ckr = pin(p, 5);
    const bf16_t* KN = (const bf16_t*)(p.ws + OFF_KN);
    const bf16_t* VTg = (const bf16_t*)(p.ws + OFF_VT) + (lat ? VT_LAT + (size_t)(b * 8 + h) * 64 * 1280 : (size_t)(b * 8 + h) * 64 * 256);
    const int NK = lat ? 1280 : 256;
    u32x4 pf_k0, pf_k1, pf_v;
    const int kc0 = tid, kc1 = tid + 512;
    const int key0_ = kc0 / 12, pc0_ = kc0 % 12, key1_ = kc1 / 12, pc1_ = kc1 % 12;
#define ATT_ROW(KB, KEY) (!lat ? (b * 256 + (KB) * 64 + (KEY)) : ((KB) < 4 ? (T_ALL + b * 256 + (KB) * 64 + (KEY)) : (T_CTX + b * 1024 + ((KB) - 4) * 64 + (KEY))))
#define ATT_LOAD(KB) do { \
        pf_k0 = *(const u32x4*)(KN + ((size_t)ATT_ROW(KB, key0_) * 8 + h) * 96 + pc0_ * 8); \
        if (tid < 256) pf_k1 = *(const u32x4*)(KN + ((size_t)ATT_ROW(KB, key1_) * 8 + h) * 96 + pc1_ * 8); \
        pf_v = *(const u32x4*)(VTg + (size_t)(tid >> 3) * NK + (KB) * 64 + (tid & 7) * 8); } while (0)
    pf_k1 = (u32x4){0u, 0u, 0u, 0u};
    ATT_LOAD(0);
    for (int kb = 0; kb < nkb; ++kb) {
        *(LAS u32x4*)(sK + key0_ * 104 + pc0_ * 8) = pf_k0;
        if (tid < 256) *(LAS u32x4*)(sK + key1_ * 104 + pc1_ * 8) = pf_k1;
        *(LAS u32x4*)(sVT + (tid >> 3) * 72 + (tid & 7) * 8) = pf_v;
        __syncthreads();
        if (kb + 1 < nkb) ATT_LOAD(kb + 1);
        {
            f32x4 s[4];
#pragma unroll
            for (int g4 = 0; g4 < 4; ++g4) {
                s[g4] = (f32x4){0.f, 0.f, 0.f, 0.f};
#pragma unroll
                for (int kk = 0; kk < 3; ++kk) { const bf16x8 a = *(const LAS bf16x8*)(sK + (g4 * 16 + fr) * 104 + kk * 32 + fq * 8); s[g4] = mfma16(a, bQ[kk], s[g4]); }
            }
            float mx = s[0][0];
#pragma unroll
            for (int g4 = 0; g4 < 4; ++g4)
#pragma unroll
                for (int reg = 0; reg < 4; ++reg) mx = fmaxf(mx, s[g4][reg]);
            mx = fmaxf(mx, __shfl_xor(mx, 16)); mx = fmaxf(mx, __shfl_xor(mx, 32));
            const float m_new = fmaxf(m_run, mx);
            const float alpha = __builtin_amdgcn_exp2f(m_run - m_new);
            m_run = m_new;
            float ls = 0.f;
#pragma unroll
            for (int g4 = 0; g4 < 4; ++g4)
#pragma unroll
                for (int reg = 0; reg < 4; ++reg) { s[g4][reg] = __builtin_amdgcn_exp2f(s[g4][reg] - m_new); ls += s[g4][reg]; }
            l_run = l_run * alpha + ls;
#pragma unroll
            for (int dt = 0; dt < 4; ++dt) oacc[dt] *= alpha;
#pragma unroll
            for (int ks = 0; ks < 2; ++ks) {
                u32x4 pw; pw.x = cvt_pk_bf16(s[2 * ks][0], s[2 * ks][1]); pw.y = cvt_pk_bf16(s[2 * ks][2], s[2 * ks][3]); pw.z = cvt_pk_bf16(s[2 * ks + 1][0], s[2 * ks + 1][1]); pw.w = cvt_pk_bf16(s[2 * ks + 1][2], s[2 * ks + 1][3]);
                const bf16x8 bP = __builtin_bit_cast(bf16x8, pw);
#pragma unroll
                for (int dt = 0; dt < 4; ++dt) {
                    const u32x2 lo = *(const LAS u32x2*)(sVT + (dt * 16 + fr) * 72 + ks * 32 + fq * 4);
                    const u32x2 hi = *(const LAS u32x2*)(sVT + (dt * 16 + fr) * 72 + ks * 32 + 16 + fq * 4);
                    u32x4 av; av.x = lo.x; av.y = lo.y; av.z = hi.x; av.w = hi.y;
                    oacc[dt] = mfma16(__builtin_bit_cast(bf16x8, av), bP, oacc[dt]);
                }
            }
        }
        __syncthreads();
    }
    l_run += __shfl_xor(l_run, 16); l_run += __shfl_xor(l_run, 32);
    const float inv = 1.f / l_run;
    bf16_t* op = cat + (size_t)(qrow0 + wid * 16 + fr) * 1024 + 512 + h * 64;
#pragma unroll
    for (int dt = 0; dt < 4; ++dt) { u32x2 w; w.x = cvt_pk_bf16(oacc[dt][0] * inv, oacc[dt][1] * inv); w.y = cvt_pk_bf16(oacc[dt][2] * inv, oacc[dt][3] * inv); *(u32x2*)(op + dt * 16 + fq * 4) = w; }
}

__device__ __forceinline__ void gla_finish_rows(const Params& p, int j) {
    const int tid = otid(), wid = tid >> 6, lane = tid & 63;
    const float* of = (const float*)(p.ws + OFF_OF); const float* ob = (const float*)(p.ws + OFF_OB);
    const bf16_t* proj = (const bf16_t*)(p.ws + OFF_PROJ); bf16_t* cat = (bf16_t*)(p.ws + OFF_CAT);
    const int e0 = (lane & 15) * 8;
    const float* glag = pin(p, 20);
    for (int row = obid() * 8 + wid; row < T_ALL; row += ogrid() * 8) {
        const float* a = of + (size_t)row * 512 + lane * 8; const float* bb = ob + (size_t)row * 512 + lane * 8;
        f32x4 x0 = *(const f32x4*)a + *(const f32x4*)bb, x1 = *(const f32x4*)(a + 4) + *(const f32x4*)(bb + 4);
        float ss = x0[0] * x0[0] + x0[1] * x0[1] + x0[2] * x0[2] + x0[3] * x0[3] + x1[0] * x1[0] + x1[1] * x1[1] + x1[2] * x1[2] + x1[3] * x1[3];
        ss += __shfl_xor(ss, 1); ss += __shfl_xor(ss, 2); ss += __shfl_xor(ss, 4); ss += __shfl_xor(ss, 8);
        const float rstd = rsqrtf(ss * (1.f / 128.f) + EPS);
        const f32x4 g0 = *(const f32x4*)(glag + j * 128 + e0), g1 = *(const f32x4*)(glag + j * 128 + e0 + 4);
        const u32x4 ogw = *(const u32x4*)(proj + (size_t)row * PROJ_LD + 1024 + lane * 8);
        float y[8];
#pragma unroll
        for (int e = 0; e < 4; ++e) { y[e] = x0[e] * rstd * g0[e]; y[4 + e] = x1[e] * rstd * g1[e]; }
#pragma unroll
        for (int e = 0; e < 4; ++e) { y[2 * e] *= silu_f(bflo(ogw[e])); y[2 * e + 1] *= silu_f(bfhi(ogw[e])); }
        u32x4 w; w.x = cvt_pk_bf16(y[0], y[1]); w.y = cvt_pk_bf16(y[2], y[3]); w.z = cvt_pk_bf16(y[4], y[5]); w.w = cvt_pk_bf16(y[6], y[7]);
        *(u32x4*)(cat + (size_t)row * 1024 + lane * 8) = w;
    }
}


__device__ __forceinline__ void spatial_tile(const Params& p, LAS unsigned char* lds, int j, int tile) {
    const int tid = otid(), wid = tid >> 6, lane = tid & 63, fr = lane & 15, fq = lane >> 4;
    const int chunk = tile >> 4, slab = tile & 15, g = slab >> 2;
    const bf16_t* uv = (const bf16_t*)(p.ws + OFF_UV); bf16_t* gated = (bf16_t*)(p.ws + OFF_GATED);
    const float* ssp = (const float*)(p.ws + OFF_SSP);
    const bf16_t* Ws = (const bf16_t*)(p.ws + OFF_WS) + (size_t)(j * 4 + g) * 128 * 128;
    LAS bf16_t* sW = (LAS bf16_t*)lds;
    LAS bf16_t* sVT = (LAS bf16_t*)(lds + 34816);
    LAS float* sR = (LAS float*)(lds + 69632);
    if (tid < 128) { const float* s = ssp + (size_t)(chunk * 128 + tid) * 32; float a = 0.f;
#pragma unroll
        for (int i = 0; i < 32; i += 4) { const f32x4 v = *(const f32x4*)(s + i); a += v[0] + v[1] + v[2] + v[3]; }
        sR[tid] = rsqrtf(a * (1.f / 2048.f) + EPS); }
#pragma unroll
    for (int i = 0; i < 4; ++i) { const int idx = tid + 512 * i, row = idx >> 4, c8 = idx & 15; *(LAS u32x4*)(sW + row * 136 + c8 * 8) = *(const u32x4*)(Ws + row * 128 + c8 * 8); }
    __syncthreads();
    const float* vgp = pin(p, 28);
#pragma unroll
    for (int i = 0; i < 4; ++i) {
        const int idx = tid + 512 * i, q = idx >> 4, c8 = idx & 15;
        const u32x4 vv = *(const u32x4*)(uv + (size_t)(chunk * 128 + q) * 4096 + 2048 + slab * 128 + c8 * 8);
        const float rs = sR[q]; const float* vg = vgp + j * 2048 + slab * 128 + c8 * 8;
#pragma unroll
        for (int e = 0; e < 4; ++e) {
            sVT[(c8 * 8 + 2 * e) * 136 + (q ^ (c8 << 3))] = f2bf(bflo(vv[e]) * rs * vg[2 * e]);
            sVT[(c8 * 8 + 2 * e + 1) * 136 + (q ^ (c8 << 3))] = f2bf(bfhi(vv[e]) * rs * vg[2 * e + 1]);
        }
    }
    __syncthreads();
    bf16x8 aV[4];
#pragma unroll
    for (int kk = 0; kk < 4; ++kk) aV[kk] = *(const LAS bf16x8*)(sVT + (wid * 16 + fr) * 136 + (((kk * 4 + fq) ^ (wid * 2 + (fr >> 3))) << 3));
    const float* bs = pin(p, 30) + (size_t)(j * 4 + g) * 128;
#pragma unroll
    for (int pt = 0; pt < 8; ++pt) {
        f32x4 acc = (f32x4){0.f, 0.f, 0.f, 0.f};
#pragma unroll
        for (int kk = 0; kk < 4; ++kk) { const bf16x8 bw = *(const LAS bf16x8*)(sW + (pt * 16 + fr) * 136 + kk * 32 + fq * 8); acc = mfma16(aV[kk], bw, acc); }
        const int prow = pt * 16 + fr; const float bias = bs[prow];
        const size_t row = (size_t)chunk * 128 + prow; const int col = slab * 128 + wid * 16 + fq * 4;
        const u32x2 uw = *(const u32x2*)(uv + row * 4096 + col);
        u32x2 w; w.x = cvt_pk_bf16(bflo(uw.x) * (acc[0] + bias), bfhi(uw.x) * (acc[1] + bias)); w.y = cvt_pk_bf16(bflo(uw.y) * (acc[2] + bias), bfhi(uw.y) * (acc[3] + bias));
        *(u32x2*)(gated + row * 2048 + col) = w;
    }
    __syncthreads();
}

#define XB_TMO      128
#define XB_XCNT(j)  (256  + 64 * (j))
#define XB_XSUB(j)  (1280 + 64 * (j))
#define XB_XGEN(j)  (2304 + 64 * (j))
#define XB_TOP      3328
#define XB_TOPGEN   3392
#define XCD_BAR_WORDS 3456
#define XB_SPIN_CAP (1u << 18)

__device__ __forceinline__ unsigned xb_ld(unsigned* p)              { return __hip_atomic_load(p, __ATOMIC_RELAXED, __HIP_MEMORY_SCOPE_AGENT); }
__device__ __forceinline__ unsigned xb_add(unsigned* p, unsigned v) { return __hip_atomic_fetch_add(p, v, __ATOMIC_RELAXED, __HIP_MEMORY_SCOPE_AGENT); }
__device__ __forceinline__ unsigned xb_xcc_id() { return (unsigned)__builtin_amdgcn_s_getreg((3 << 11) | 20) & 0xFu; }
#define XB_SPIN(cond, bar) do { unsigned _sp = 0; while (cond) { __builtin_amdgcn_s_sleep(1); \
    if ((++_sp & 255u) == 0u) { if (xb_ld(&(bar)[XB_TMO])) break; if (_sp > XB_SPIN_CAP) { atomicAdd(&(bar)[XB_TMO], 1u); break; } } } } while (0)

struct XcdBarrier {
    unsigned* bar; unsigned x;
    volatile LAS unsigned* st;
};

__device__ __forceinline__ XcdBarrier xcd_barrier_post(unsigned* bar, volatile LAS unsigned* st) {
    XcdBarrier b; b.bar = bar; b.x = xb_xcc_id(); b.st = st;
    if (threadIdx.x == 0) (void)xb_add(&bar[XB_XCNT(b.x)], 1u);
    return b;
}
__device__ __forceinline__ void xcd_barrier_complete(unsigned* bar, unsigned x, unsigned& nloc, unsigned& nx) {
    const unsigned G = gridDim.x * gridDim.y * gridDim.z;
    unsigned sum, cnt, mine, sp = 0u;
    for (;;) {
        sum = 0u; cnt = 0u; mine = 0u;
#pragma unroll
        for (unsigned j = 0; j < 16; ++j) { const unsigned c = xb_ld(&bar[XB_XCNT(j)]); sum += c; cnt += (c > 0u) ? 1u : 0u; mine = (j == x) ? c : mine; }
        if (sum == G) break;
        __builtin_amdgcn_s_sleep(1);
        if ((++sp & 255u) == 0u) { if (xb_ld(&bar[XB_TMO])) break; if (sp > XB_SPIN_CAP) { atomicAdd(&bar[XB_TMO], 1u); break; } }
    }
    nloc = mine > 0u ? mine : 1u; nx = cnt > 0u ? cnt : 1u;
}

__device__ __forceinline__ void xcd_barrier(const XcdBarrier& b) {
    asm volatile("s_waitcnt vmcnt(0)" ::: "memory");
    __syncthreads();
    if (threadIdx.x == 0) {
        unsigned* bar = b.bar;
        __builtin_amdgcn_s_waitcnt(0);
        unsigned nloc = b.st[0], nx = b.st[1];
        if (nloc == 0u) { xcd_barrier_complete(bar, b.x, nloc, nx); b.st[0] = nloc; b.st[1] = nx; }
        const unsigned old = xb_add(&bar[XB_XSUB(b.x)], 1u);
        const unsigned gen = old / nloc;
        if (old + 1u == (gen + 1u) * nloc) {
            __builtin_amdgcn_fence(__ATOMIC_RELEASE, "agent");
            asm volatile("s_waitcnt vmcnt(0)" ::: "memory");
            const unsigned og = xb_add(&bar[XB_TOP], 1u);
            const unsigned tg = og / nx;
            if (og + 1u == (tg + 1u) * nx) xb_add(&bar[XB_TOPGEN], 1u);
            else XB_SPIN(xb_ld(&bar[XB_TOPGEN]) == tg, bar);
            __builtin_amdgcn_fence(__ATOMIC_ACQUIRE, "agent");
            xb_add(&bar[XB_XGEN(b.x)], 1u);
            asm volatile("s_waitcnt vmcnt(0)" ::: "memory");
        } else {
            XB_SPIN(xb_ld(&bar[XB_XGEN(b.x)]) == gen, bar);
            __builtin_amdgcn_fence(__ATOMIC_ACQUIRE, "agent");
            asm volatile("s_waitcnt vmcnt(0)" ::: "memory");
        }
    }
    __syncthreads();
}

constexpr size_t OFF_BAR = (size_t)520 << 20;

constexpr int STEPS = 13, NPH = 1 + 4 * STEPS;

__global__ void __launch_bounds__(512, 2) mega(Params p) {
    extern __shared__ __attribute__((aligned(16))) unsigned char shm[];
    LAS unsigned char* lds = (LAS unsigned char*)shm;
    cg::grid_group grid = cg::this_grid();
    __shared__ uint4 xb_words;
    if (threadIdx.x == 0) xb_words = make_uint4(0u, 0u, 0u, 0u);
    __syncthreads();
    if (p.ph_end - p.ph_begin > 1) (void)xcd_barrier_post((unsigned*)(p.ws + OFF_BAR), (volatile LAS unsigned*)&xb_words);
    bf16_t* hbuf = (bf16_t*)(p.ws + OFF_H);
    float* mod = (float*)(p.ws + OFF_MOD);
    bool first = true;
    for (int ph = p.ph_begin; ph < p.ph_end; ++ph) {
        int l = 0, s = -1;
        if (ph > 0) { l = (ph - 1) / STEPS; s = (ph - 1) % STEPS; }
        const bool odd = (l & 1) != 0; const int j = l >> 1;
        if (odd && (s == 7 || s == 8 || s == 9)) continue;
        if (s == 3 || s == 7 || s == 10 || (s == 0 && l > 0)) continue;
        if (!first) { if (ph == 1) grid.sync(); else { XcdBarrier xb; xb.bar = (unsigned*)(p.ws + OFF_BAR); xb.x = xb_xcc_id(); xb.st = (volatile LAS unsigned*)&xb_words; xcd_barrier(xb); } }
        first = false;
        const int bid = obid(), G = ogrid();
        if (ph == 0) { prologue_phase(p, lds); continue; }
        switch (s) {
            case 0: prologue_b(p, lds); break;
            case 1: {
                pg8::Gemm g{hbuf, (const bf16_t*)(p.ws + OFF_WGU1) + (size_t)l * 5632 * 1024, T_ALL, 5632, 1024};
                pg8::StaticOrder S; S.init(g.M, g.N, G, bid);
                EpiSwiGLU E{(bf16_t*)(p.ws + OFF_ACT), (const float*)(p.ws + OFF_RSP), (const float*)(p.ws + OFF_BIAS) + (size_t)(l * 3 + 0) * 9 * 5632};
                pg8::gemm_phase(lds, g, S, E);
                if (l == 0) {
                    if (G == 256) { if (bid >= 128) bias_items(p, lds, 44 + (bid - 128), 452, 128); }
                    else bias_items(p, lds, 44 + bid, 452, G);
                }
            } break;
            case 11: {
                pg8::Gemm g{hbuf, (const bf16_t*)(p.ws + OFF_WGU2) + (size_t)l * 5632 * 1024, T_ALL, 5632, 1024};
                pg8::StaticOrder S; S.init(g.M, g.N, G, bid);
                EpiSwiGLU E{(bf16_t*)(p.ws + OFF_ACT), (const float*)(p.ws + OFF_RSP), (const float*)(p.ws + OFF_BIAS) + (size_t)(l * 3 + 2) * 9 * 5632};
                pg8::gemm_phase(lds, g, S, E);
            } break;
            case 2: {
                pg8::Gemm g{(const bf16_t*)(p.ws + OFF_ACT), (const bf16_t*)(p.ws + OFF_WD1) + (size_t)l * 1024 * 2816, T_ALL, 1024, 2816};
                EpiResid E{p, l, 2};
                pg8::StaticOrder S; S.init(g.M, g.N, G, bid);
                pg8::gemm_phase(lds, g, S, E);
            } break;
            case 12: {
                pg8::Gemm g{(const bf16_t*)(p.ws + OFF_ACT), (const bf16_t*)(p.ws + OFF_WD2) + (size_t)l * 1024 * 2816, T_ALL, 1024, 2816};
                EpiResid E{p, l, 11};
                pg8::StaticOrder S; S.init(g.M, g.N, G, bid);
                pg8::gemm_phase(lds, g, S, E);
            } break;
            case 6: {
                if (!odd) {
                    {
                        pg8::Gemm g{(const bf16_t*)(p.ws + OFF_CQN), (const bf16_t*)(p.ws + OFF_WQB) + (size_t)j * 768 * 384, T_ALL, 768, 384};
                        EpiBf16 E{(bf16_t*)(p.ws + OFF_QRAW), 768, nullptr, nullptr};
                        pg8::StaticOrder S; S.init(g.M, g.N, G, bid);
                        pg8::gemm_phase(lds, g, S, E);
                    }
                    {
                        pg8::Gemm g{(const bf16_t*)(p.ws + OFF_CKVN), (const bf16_t*)(p.ws + OFF_WKVB) + (size_t)j * 1024 * 256, T_KV, 1024, 256};
                        EpiBf16 E{(bf16_t*)(p.ws + OFF_KVRAW), 1024, nullptr, nullptr};
                        pg8::StaticOrder S; S.init(g.M, g.N, G, (bid + G - (192 % G)) % G);
                        pg8::gemm_phase(lds, g, S, E);
                        Unit uu;
                        for (int i = 0; S.next(i, uu); ++i)
                            for (int q = 0; q < 8; ++q) kprep_tile(p, lds, j, ((uu.pm * 4 + (q >> 1)) << 3) | (uu.pn * 2 + (q & 1)));
                    }
                } else {
                    pg8::Gemm g{(const bf16_t*)(p.ws + OFF_GATED), (const bf16_t*)(p.ws + OFF_WOUTO) + (size_t)j * 1024 * 2048, T_ALL, 1024, 2048};
                    EpiResid E{p, l, 6};
                    pg8::StaticOrder S; S.init(g.M, g.N, G, bid);
                    pg8::gemm_phase(lds, g, S, E);
                }
            } break;
            case 9: {
                pg8::Gemm g{(const bf16_t*)(p.ws + OFF_CAT), (const bf16_t*)(p.ws + OFF_WOUTE) + (size_t)j * 1024 * 1024, T_ALL, 1024, 1024};
                EpiResid E{p, l, 8};
                pg8::StaticOrder S; S.init(g.M, g.N, G, bid);
                pg8::gemm_phase(lds, g, S, E);
            } break;
            case 4: {
                if (!odd) {
                    pg8::Gemm g{hbuf, (const bf16_t*)(p.ws + OFF_WINE) + (size_t)j * 2304 * 1024, T_ALL, 2304, 1024};
                    pg8::StaticOrder S; S.init(g.M, g.N, G, bid);
                    EpiBf16 E{(bf16_t*)(p.ws + OFF_PROJ), PROJ_LD, (const float*)(p.ws + OFF_RSP), (const float*)(p.ws + OFF_BIAS) + (size_t)(l * 3 + 1) * 9 * 5632};
                    pg8::gemm_phase(lds, g, S, E);
                } else {
                    pg8::Gemm g{hbuf, (const bf16_t*)(p.ws + OFF_WINO) + (size_t)j * 4096 * 1024, T_ALL, 4096, 1024};
                    pg8::StaticOrder S; S.init(g.M, g.N, G, bid);
                    EpiGeluUV E{(bf16_t*)(p.ws + OFF_UV), (float*)(p.ws + OFF_SSP), (const float*)(p.ws + OFF_RSP), (const float*)(p.ws + OFF_BIAS) + (size_t)(l * 3 + 1) * 9 * 5632};
                    pg8::gemm_phase(lds, g, S, E);
                }
            } break;
            case 5: {
                if (!odd) even2_phase(p, lds, j);
                else for (int t = bid; t < 2048; t += G) spatial_tile(p, lds, j, t);
            } break;
            case 7: {
                for (int t = bid; t < 2304; t += G) kprep_tile(p, lds, j, t);
            } break;
            case 8: {
                if (G == 256) {
                    const int xcd = bid & 7, slot = bid >> 3;
                    const int bh = xcd * 8 + (slot >> 2);
                    for (int r = 0; r < 2; ++r) { attn_tile(p, lds, j, bh * 8 + (slot & 3) * 2 + r); __syncthreads(); }
                    const int bhc = xcd * 32 + slot;
                    for (int r = 0; r < 2; ++r) { attn_tile(p, lds, j, 512 + bhc * 2 + r); __syncthreads(); }
                } else {
                    for (int t = bid; t < 1024; t += G) { attn_tile(p, lds, j, t); __syncthreads(); }
                }
                gla_finish_rows(p, j);
            } break;
            default: break;
        }
    }
}


extern "C" void kernel_launch(void* const* d_in, const int* in_sizes, int n_in, void* d_out, int out_size, void* d_ws, size_t ws_size, hipStream_t stream) {
    constexpr size_t kDynLds = 131072;
    static int grid_blocks = 0;
    if (!grid_blocks) {
        hipFuncSetAttribute((const void*)mega, hipFuncAttributeMaxDynamicSharedMemorySize, (int)kDynLds);
        int dev = 0, cus = 0, per_cu = 0;
        hipGetDevice(&dev);
        hipDeviceGetAttribute(&cus, hipDeviceAttributeMultiprocessorCount, dev);
        hipOccupancyMaxActiveBlocksPerMultiprocessor(&per_cu, mega, 512, kDynLds);
        if (per_cu < 1) per_cu = 1;
        if (per_cu > 1) per_cu = 1;
        grid_blocks = cus * per_cu;
    }
    Params p{};
    for (int i = 0; i < 32; ++i) p.in[i] = (const float*)d_in[i];
    p.out = (float*)d_out; p.ws = (unsigned char*)d_ws; p.ph_begin = 0; p.ph_end = NPH;
    hipMemsetAsync((unsigned char*)d_ws + OFF_BAR, 0, XCD_BAR_WORDS * sizeof(unsigned), stream);
    void* args[] = {&p};
    hipError_t e = hipLaunchCooperativeKernel((void*)mega, dim3(grid_blocks), dim3(512), args, kDynLds, stream);
    if (e != hipSuccess) fprintf(stderr, "cooperative launch failed: %s (grid %d)\n", hipGetErrorString(e), grid_blocks);
}
```

```cpp
#include <hip/hip_runtime.h>
#include <hip/hip_cooperative_groups.h>
#include <cstdio>
namespace cg = cooperative_groups;

#define LAS __attribute__((address_space(3)))
typedef unsigned short bf16_t;
typedef short bf16x8 __attribute__((ext_vector_type(8)));
typedef short bf16x4 __attribute__((ext_vector_type(4)));
typedef float f32x4 __attribute__((ext_vector_type(4)));
typedef float f32x2 __attribute__((ext_vector_type(2)));
typedef unsigned u32x4 __attribute__((ext_vector_type(4)));
typedef unsigned u32x2 __attribute__((ext_vector_type(2)));

constexpr int T_CTX = 8192, T_ALL = 16384, T_KV = 18432;
constexpr int PROJ_LD = 2304;
constexpr float EPS = 1e-6f;


constexpr size_t SZ_WGU = (size_t)4 * 5632 * 1024 * 2, SZ_WD = (size_t)4 * 1024 * 2816 * 2;
constexpr size_t OFF_WGU1 = 0;
constexpr size_t OFF_WD1 = OFF_WGU1 + SZ_WGU;
constexpr size_t OFF_WGU2 = OFF_WD1 + SZ_WD;
constexpr size_t OFF_WD2 = OFF_WGU2 + SZ_WGU;
constexpr size_t OFF_WINE = OFF_WD2 + SZ_WD;
constexpr size_t OFF_WOUTE = OFF_WINE + (size_t)2 * 2304 * 1024 * 2;
constexpr size_t OFF_WQB = OFF_WOUTE + (size_t)2 * 1024 * 1024 * 2;
constexpr size_t OFF_WKVB = OFF_WQB + (size_t)2 * 768 * 384 * 2;
constexpr size_t OFF_WINO = OFF_WKVB + (size_t)2 * 1024 * 256 * 2;
constexpr size_t OFF_WOUTO = OFF_WINO + (size_t)2 * 4096 * 1024 * 2;
constexpr size_t OFF_WS = OFF_WOUTO + (size_t)2 * 1024 * 2048 * 2;
constexpr size_t OFF_MOD = OFF_WS + (size_t)2 * 4 * 128 * 128 * 2;
constexpr size_t OFF_H = OFF_MOD + (size_t)4 * 9 * 9216 * 4;
constexpr size_t OFF_U = OFF_H + (size_t)T_ALL * 1024 * 2;
constexpr size_t OFF_ACT = OFF_U;
constexpr size_t OFF_PROJ = OFF_U;
constexpr size_t OFF_CQN = OFF_PROJ + (size_t)T_ALL * PROJ_LD * 2;
constexpr size_t OFF_CKVN = OFF_CQN + (size_t)T_ALL * 384 * 2;
constexpr size_t OFF_QRAW = OFF_CKVN + (size_t)T_KV * 256 * 2;
constexpr size_t OFF_KVRAW = OFF_QRAW + (size_t)T_ALL * 768 * 2;
constexpr size_t OFF_OF = OFF_KVRAW + (size_t)T_KV * 1024 * 2;
constexpr size_t OFF_OB = OFF_OF + (size_t)T_ALL * 512 * 4;
constexpr size_t OFF_CAT = OFF_OB + (size_t)T_ALL * 512 * 4;
constexpr size_t OFF_UV = OFF_U;
constexpr size_t OFF_GATED = OFF_UV + (size_t)T_ALL * 4096 * 2;
constexpr size_t OFF_SSP = OFF_GATED + (size_t)T_ALL * 2048 * 2;

constexpr size_t OFF_BIAS = (size_t)522 << 20;
constexpr size_t OFF_RSP = (size_t)526 << 20;
constexpr size_t OFF_KN = (size_t)456 << 20;
constexpr size_t OFF_VT = (size_t)484 << 20;
constexpr size_t VT_LAT = (size_t)32 * 8 * 64 * 256;
constexpr size_t OUT_CKV = 16777216, OUT_KROPE = 20971520, OUT_GLA = 21495808;

struct Params {
    const float* in[32];
    float* out;
    unsigned char* ws;
    int ph_begin, ph_end;
};

__device__ __forceinline__ int otid() { int t = threadIdx.x; asm volatile("" : "+v"(t)); return t; }
__device__ __forceinline__ int obid() { int t = blockIdx.x; asm volatile("" : "+s"(t)); return t; }
__device__ __forceinline__ int ogrid() { int t = gridDim.x; asm volatile("" : "+s"(t)); return t; }
__device__ __forceinline__ const float* pin(const Params& p, int i) { i = __builtin_amdgcn_readfirstlane(i); asm volatile("" : "+s"(i)); return p.in[i]; }
typedef __bf16 bf16x2_t __attribute__((ext_vector_type(2)));
__device__ __forceinline__ unsigned cvt_pk_bf16(float lo, float hi) { const f32x2 v = {lo, hi}; return __builtin_bit_cast(unsigned, __builtin_convertvector(v, bf16x2_t)); }
__device__ __forceinline__ unsigned pack_bf16_sw(float lo, float hi) {
    unsigned a = __float_as_uint(lo), b = __float_as_uint(hi);
    a += 0x7fffu + ((a >> 16) & 1u); b += 0x7fffu + ((b >> 16) & 1u);
    return (a >> 16) | (b & 0xffff0000u);
}
__device__ __forceinline__ bf16_t f2bf(float f) { return (bf16_t)(cvt_pk_bf16(f, 0.f) & 0xffffu); }
__device__ __forceinline__ float bf2f(bf16_t b) { return __uint_as_float(((unsigned)b) << 16); }
__device__ __forceinline__ float bflo(unsigned w) { return __uint_as_float(w << 16); }
__device__ __forceinline__ float bfhi(unsigned w) { return __uint_as_float(w & 0xffff0000u); }
__device__ __forceinline__ float silu_f(float x) { return x * __builtin_amdgcn_rcpf(1.f + __expf(-x)); }
__device__ __forceinline__ float gelu_tanh_f(float x) { const float u = 1.5957691216f * (x + 0.044715f * x * x * x); return x * __builtin_amdgcn_rcpf(1.f + __expf(-u)); }
__device__ __forceinline__ float wave_sum(float v) {
    v += __shfl_xor(v, 1); v += __shfl_xor(v, 2); v += __shfl_xor(v, 4); v += __shfl_xor(v, 8); v += __shfl_xor(v, 16); v += __shfl_xor(v, 32); return v; }

namespace pg8 {
constexpr int BM = 256, BK = 64, HALF = 128, HTB = HALF * BK * 2, STAGE_BYTES = 8 * HTB, NXCD = 8, WGM = 8;
__device__ __forceinline__ int lds_byte(int r, int c) { const int st = (r >> 4) * 2 + (c >> 5), rr = r & 15, cc = c & 31, ob = rr * 64 + cc * 2; return st * 1024 + (ob ^ (((ob >> 9) & 1) << 5)); }
__device__ __forceinline__ void stage_rc(int b, int& R, int& C) { const int st = b / 1024, sb = b % 1024, swz = sb ^ (((sb >> 9) & 1) << 5); R = (st >> 1) * 16 + swz / 64; C = (st & 1) * 32 + (swz % 64) / 2; }
__device__ __forceinline__ int perm32(int rho) { const int n = rho >> 4, i = rho & 15; return 8 * (i >> 2) + 4 * n + (i & 3); }
struct Unit { int pm, pn; };
struct Gemm { const bf16_t* A; const bf16_t* Bt; int M, N, K; };
struct StaticOrder {
    int nM, nN, nwg, G, c;
    __device__ void init(int M, int N, int G_, int c_) { nM = M / BM; nN = N / BM; nwg = nM * nN; G = G_; c = c_; }
    __device__ bool next(int i, Unit& u) const {
        const long L = (long)i * G + c; if (L >= nwg) return false;
        int wgid = (int)L; { const int q = nwg / NXCD, r = nwg % NXCD, xcd = wgid % NXCD, off = wgid / NXCD; wgid = (xcd < r ? xcd * (q + 1) : r * (q + 1) + (xcd - r) * q) + off; }
        const int nig = WGM * nN, gid = wgid / nig, fm = gid * WGM, gsz = (nM - fm) < WGM ? (nM - fm) : WGM;
        u.pm = fm + ((wgid % nig) % gsz); u.pn = (wgid % nig) / gsz; return true;
    }
};

template <class Epi>
__device__ __forceinline__ void gemm_phase(LAS unsigned char* lds, const Gemm g, const StaticOrder& S, const Epi& E) {
    const int tid = otid(), wid = __builtin_amdgcn_readfirstlane(tid >> 6), lane = tid & 63, wr = wid >> 2, wc = wid & 3, fr = lane & 15, fq = lane >> 4;
    const int K = g.K, nt = K / BK;
    unsigned voffA[2], voffB[2];
#pragma unroll
    for (int i = 0; i < 2; ++i) { int R, C; stage_rc(tid * 16 + i * 8192, R, C); const int Rb = Epi::PERM ? ((R & ~31) + perm32(R & 31)) : R;
        voffA[i] = (unsigned)(R * K + C) * 2u; voffB[i] = (unsigned)(Rb * K + C) * 2u; }
    const size_t kstep = (size_t)(BK * 2);
    const size_t hstep = (size_t)HALF * K * 2;
    const size_t tstep = 2 * hstep;
    const unsigned ldsw = (unsigned)wid * 1024u;
    const int aoff = lds_byte(wr * 64 + fr, fq * 8), boff = lds_byte(wc * 32 + fr, fq * 8);
#define PG8_SA(b, h) (((b) * 2 + (h)) * HTB)
#define PG8_SB(b, h) ((4 + (b) * 2 + (h)) * HTB)
#define PG8_STAGE(bufoff, gbase, voff) do { _Pragma("unroll") for (int _i = 0; _i < 2; ++_i) \
        __builtin_amdgcn_global_load_lds((const unsigned*)((const char*)(gbase) + (voff)[_i]), (LAS unsigned*)(lds + (bufoff) + ldsw + _i * 8192), 16, 0, 0); } while (0)
#define PG8_LDA(dst, b, h) do { _Pragma("unroll") for (int m = 0; m < 4; ++m) _Pragma("unroll") for (int k = 0; k < 2; ++k) dst[m][k] = *(const LAS bf16x8*)(lds + PG8_SA(b, h) + aoff + m * 2048 + k * 1024); } while (0)
#define PG8_LDB(dst, b, h) do { _Pragma("unroll") for (int n = 0; n < 2; ++n) _Pragma("unroll") for (int k = 0; k < 2; ++k) dst[n][k] = *(const LAS bf16x8*)(lds + PG8_SB(b, h) + boff + n * 2048 + k * 1024); } while (0)
#define PG8_MMA(ai, bj, At, Bt) do { __builtin_amdgcn_s_setprio(1); _Pragma("unroll") for (int m = 0; m < 4; ++m) _Pragma("unroll") for (int n = 0; n < 2; ++n) _Pragma("unroll") for (int k = 0; k < 2; ++k) \
        acc[ai][bj][m][n] = __builtin_amdgcn_mfma_f32_16x16x32_bf16(Bt[n][k], At[m][k], acc[ai][bj][m][n], 0, 0, 0); __builtin_amdgcn_s_setprio(0); } while (0)
#define PG8_WAIT_V(n) asm volatile("s_waitcnt vmcnt(" #n ")" ::: "memory")
#define PG8_WAIT_L(n) asm volatile("s_waitcnt lgkmcnt(" #n ")" ::: "memory")
#define PG8_BAR __builtin_amdgcn_s_barrier()
#define PG8_SCHED __builtin_amdgcn_sched_barrier(0)
    Unit cur, nxt; int ui = 0;
    if (!S.next(0, cur)) return;
    f32x4 acc[2][2][4][2];
#pragma unroll
    for (int a = 0; a < 2; ++a)
#pragma unroll
        for (int b = 0; b < 2; ++b)
#pragma unroll
            for (int m = 0; m < 4; ++m)
#pragma unroll
                for (int n = 0; n < 2; ++n) acc[a][b][m][n] = (f32x4){0.f, 0.f, 0.f, 0.f};
    bf16x8 At[4][2], B0[2][2], B1[2][2];
    const char* cA = (const char*)g.A + (size_t)cur.pm * tstep; const char* cB = (const char*)g.Bt + (size_t)cur.pn * tstep;
    PG8_STAGE(PG8_SB(0, 0), cB, voffB); PG8_STAGE(PG8_SA(0, 0), cA, voffA); PG8_STAGE(PG8_SB(0, 1), cB + hstep, voffB); PG8_STAGE(PG8_SA(0, 1), cA + hstep, voffA);
    if (wr == 1) PG8_BAR;
    PG8_WAIT_V(4); PG8_BAR;
    PG8_STAGE(PG8_SB(1, 0), cB + kstep, voffB); PG8_STAGE(PG8_SA(1, 0), cA + kstep, voffA); PG8_STAGE(PG8_SB(1, 1), cB + hstep + kstep, voffB);
    PG8_WAIT_V(6); PG8_BAR;
    for (;;) {
        const bool has_next = S.next(ui + 1, nxt);
        const char* nA = has_next ? (const char*)g.A + (size_t)nxt.pm * tstep : cA; const char* nB = has_next ? (const char*)g.Bt + (size_t)nxt.pn * tstep : cB;
        for (int t = 0; t < nt; t += 2) {
            const bool last = (t == nt - 2);
            const char* a1 = cA + (size_t)(t + 1) * kstep;
            const char* a2 = last ? nA : cA + (size_t)(t + 2) * kstep; const char* b2 = last ? nB : cB + (size_t)(t + 2) * kstep;
            const char* a3 = a2 + kstep; const char* b3 = b2 + kstep;
            PG8_LDB(B0, 0, 0); PG8_SCHED; PG8_LDA(At, 0, 0); PG8_STAGE(PG8_SA(1, 1), a1 + hstep, voffA);
            PG8_WAIT_L(8); PG8_BAR; PG8_WAIT_L(0); PG8_MMA(0, 0, At, B0); PG8_BAR; PG8_SCHED;
            PG8_LDB(B1, 0, 1); PG8_STAGE(PG8_SB(0, 0), b2, voffB);
            PG8_BAR; PG8_WAIT_L(0); PG8_MMA(0, 1, At, B1); PG8_BAR;
            PG8_LDA(At, 0, 1); PG8_STAGE(PG8_SA(0, 0), a2, voffA);
            PG8_BAR; PG8_WAIT_L(0); PG8_MMA(1, 0, At, B0); PG8_BAR; PG8_SCHED;
            PG8_STAGE(PG8_SB(0, 1), b2 + hstep, voffB);
            PG8_WAIT_V(6); PG8_BAR; PG8_MMA(1, 1, At, B1); PG8_BAR;
            PG8_LDB(B0, 1, 0); PG8_SCHED; PG8_LDA(At, 1, 0); PG8_STAGE(PG8_SA(0, 1), a2 + hstep, voffA);
            PG8_WAIT_L(8); PG8_BAR; PG8_WAIT_L(0); PG8_MMA(0, 0, At, B0); PG8_BAR; PG8_SCHED;
            PG8_LDB(B1, 1, 1); PG8_STAGE(PG8_SB(1, 0), b3, voffB);
            PG8_BAR; PG8_WAIT_L(0); PG8_MMA(0, 1, At, B1); PG8_BAR;
            PG8_LDA(At, 1, 1); PG8_STAGE(PG8_SA(1, 0), a3, voffA);
            PG8_BAR; PG8_WAIT_L(0); PG8_MMA(1, 0, At, B0); PG8_BAR; PG8_SCHED;
            PG8_STAGE(PG8_SB(1, 1), b3 + hstep, voffB);
            PG8_WAIT_V(6); PG8_BAR; PG8_MMA(1, 1, At, B1); PG8_BAR;
        }
        E(acc, cur, wr, wc, fr, fq);
        if (!has_next) break;
#pragma unroll
        for (int a = 0; a < 2; ++a)
#pragma unroll
            for (int b = 0; b < 2; ++b)
#pragma unroll
                for (int m = 0; m < 4; ++m)
#pragma unroll
                    for (int n = 0; n < 2; ++n) acc[a][b][m][n] = (f32x4){0.f, 0.f, 0.f, 0.f};
        cur = nxt; cA = nA; cB = nB; ++ui;
    }
    PG8_WAIT_V(0);
    if (wr == 0) PG8_BAR;
    PG8_BAR;
#undef PG8_SA
#undef PG8_SB
#undef PG8_STAGE
#undef PG8_LDA
#undef PG8_LDB
#undef PG8_MMA
#undef PG8_WAIT_V
#undef PG8_WAIT_L
#undef PG8_BAR
#undef PG8_SCHED
}
}
using pg8::Unit;


struct Rstd8 { float v[2][4]; };
__device__ __forceinline__ Rstd8 load_rstd8(const float* rsp, int row0, int fq) {
    f32x4 pv[2][4]; Rstd8 r;
#pragma unroll
    for (int ai = 0; ai < 2; ++ai)
#pragma unroll
        for (int m = 0; m < 4; ++m) pv[ai][m] = *(const f32x4*)(rsp + (size_t)(row0 + ai * 128 + m * 16) * 16 + fq * 4);
#pragma unroll
    for (int ai = 0; ai < 2; ++ai)
#pragma unroll
        for (int m = 0; m < 4; ++m) {
            float t = pv[ai][m][0] + pv[ai][m][1] + pv[ai][m][2] + pv[ai][m][3];
            t += __shfl_xor(t, 16); t += __shfl_xor(t, 32);
            r.v[ai][m] = rsqrtf(t * (1.f / 1024.f) + EPS);
        }
    return r;
}
struct EpiSwiGLU {
    static constexpr bool PERM = true;
    bf16_t* O; const float* rsp; const float* bias;
    __device__ __forceinline__ void operator()(const f32x4 (&acc)[2][2][4][2], const Unit& u, int wr, int wc, int fr, int fq) const {
        const int cond = u.pm < 32 ? 0 : 1 + ((u.pm - 32) >> 2);
        const int row0 = u.pm * 256 + wr * 64 + fr, col0 = u.pn * 128 + wc * 32 + 8 * fq;
        const Rstd8 R = load_rstd8(rsp, row0, fq);
        const float* bp = bias + (size_t)cond * 5632 + u.pn * 256 + wc * 32 + 8 * fq;
        const f32x4 bg0 = *(const f32x4*)bp, bg1 = *(const f32x4*)(bp + 4), bu0 = *(const f32x4*)(bp + 128), bu1 = *(const f32x4*)(bp + 132);
#pragma unroll
        for (int ai = 0; ai < 2; ++ai)
#pragma unroll
            for (int m = 0; m < 4; ++m) {
                bf16_t* rowp = O + (size_t)(row0 + ai * 128 + m * 16) * 2816 + col0;
                const float rs = R.v[ai][m];
                f32x4 v0, v1;
#pragma unroll
                for (int j = 0; j < 4; ++j) {
                    v0[j] = silu_f(acc[ai][0][m][0][j] * rs + bg0[j]) * (acc[ai][1][m][0][j] * rs + bu0[j]);
                    v1[j] = silu_f(acc[ai][0][m][1][j] * rs + bg1[j]) * (acc[ai][1][m][1][j] * rs + bu1[j]);
                }
                u32x4 w; w.x = cvt_pk_bf16(v0[0], v0[1]); w.y = cvt_pk_bf16(v0[2], v0[3]); w.z = cvt_pk_bf16(v1[0], v1[1]); w.w = cvt_pk_bf16(v1[2], v1[3]);
                *(u32x4*)rowp = w;
            }
    }
};
struct EpiResid {
    static constexpr bool PERM = false;
    const Params& p; int l; int kind;
    __device__ __forceinline__ void operator()(const f32x4 (&acc)[2][2][4][2], const Unit& u, int wr, int wc, int fr, int fq) const {
        float* X = p.out; const float* mod = (const float*)(p.ws + OFF_MOD);
        const int gidx = kind == 2 ? 2 : (kind == 11 ? 8 : 5);
        const float coef = (kind == 2 || kind == 11) ? 0.5f : 1.0f;
        const float* gate = mod + (size_t)l * 9 * 9216 + gidx * 1024;
        const bool nn = !(kind == 11 && l == 3);
        const int nl = kind == 11 ? (l < 3 ? l + 1 : l) : l, ns = kind == 2 ? 1 : (kind == 11 ? 0 : 2);
        const float* ng = pin(p, 9) + (size_t)(nl * 3 + ns) * 1024;
        const float* msc = mod + (size_t)nl * 9 * 9216 + (size_t)(3 * ns + 1) * 1024;
        bf16_t* H = (bf16_t*)(p.ws + OFF_H); float* rsp = (float*)(p.ws + OFF_RSP);
        const int cond = u.pm < 32 ? 0 : 1 + ((u.pm - 32) >> 2);
        const float* gp = gate + (size_t)cond * 9216;
        const int row0 = u.pm * 256 + wr * 64 + fr, col0 = u.pn * 256 + wc * 32 + 4 * fq;
        f32x4 gv[2][2], gs[2][2];
#pragma unroll
        for (int bj = 0; bj < 2; ++bj)
#pragma unroll
            for (int n = 0; n < 2; ++n) {
                gv[bj][n] = *(const f32x4*)(gp + col0 + bj * 128 + n * 16) * coef;
                gs[bj][n] = (f32x4){0.f, 0.f, 0.f, 0.f};
                if (nn) gs[bj][n] = *(const f32x4*)(ng + col0 + bj * 128 + n * 16) * (*(const f32x4*)(msc + (size_t)cond * 9216 + col0 + bj * 128 + n * 16) + 1.f);
            }
#pragma unroll
        for (int ai = 0; ai < 2; ++ai)
#pragma unroll
            for (int mp = 0; mp < 2; ++mp) {
                f32x4 xv[2][2][2];
#pragma unroll
                for (int mi = 0; mi < 2; ++mi)
#pragma unroll
                    for (int bj = 0; bj < 2; ++bj)
#pragma unroll
                        for (int n = 0; n < 2; ++n) xv[mi][bj][n] = *(const f32x4*)(X + (size_t)(row0 + ai * 128 + (mp * 2 + mi) * 16) * 1024 + col0 + bj * 128 + n * 16);
#pragma unroll
                for (int mi = 0; mi < 2; ++mi) {
                    const int m = mp * 2 + mi;
                    const int row = row0 + ai * 128 + m * 16;
                    float* rowp = X + (size_t)row * 1024 + col0;
                    float ss = 0.f;
#pragma unroll
                    for (int bj = 0; bj < 2; ++bj)
#pragma unroll
                        for (int n = 0; n < 2; ++n) {
                            const f32x4 xn = xv[mi][bj][n] + gv[bj][n] * acc[ai][bj][m][n];
                            *(f32x4*)(rowp + bj * 128 + n * 16) = xn;
                            if (nn) {
                                ss += xn[0] * xn[0] + xn[1] * xn[1] + xn[2] * xn[2] + xn[3] * xn[3];
                                const f32x4 hv = xn * gs[bj][n];
                                u32x2 w; w.x = cvt_pk_bf16(hv[0], hv[1]); w.y = cvt_pk_bf16(hv[2], hv[3]);
                                *(u32x2*)(H + (size_t)row * 1024 + col0 + bj * 128 + n * 16) = w;
                            }
                        }
                    if (nn) { ss += __shfl_xor(ss, 16); ss += __shfl_xor(ss, 32); if (fq == 0) rsp[(size_t)row * 16 + u.pn * 4 + wc] = ss; }
                }
            }
    }
};
struct EpiBf16 {
    static constexpr bool PERM = true;
    bf16_t* O; int ldc; const float* rsp; const float* bias;
    __device__ __forceinline__ void operator()(const f32x4 (&acc)[2][2][4][2], const Unit& u, int wr, int wc, int fr, int fq) const {
        const int row0 = u.pm * 256 + wr * 64 + fr, col0 = u.pn * 256 + wc * 32 + 8 * fq;
        const bool nn = rsp != nullptr;
        f32x4 b0[2], b1[2]; Rstd8 R;
#pragma unroll
        for (int bj = 0; bj < 2; ++bj) { b0[bj] = (f32x4){0.f, 0.f, 0.f, 0.f}; b1[bj] = b0[bj]; }
#pragma unroll
        for (int ai = 0; ai < 2; ++ai)
#pragma unroll
            for (int m = 0; m < 4; ++m) R.v[ai][m] = 1.f;
        if (nn) {
            const int cond = u.pm < 32 ? 0 : 1 + ((u.pm - 32) >> 2);
            R = load_rstd8(rsp, row0, fq);
#pragma unroll
            for (int bj = 0; bj < 2; ++bj) { const float* bp = bias + (size_t)cond * 5632 + col0 + bj * 128; b0[bj] = *(const f32x4*)bp; b1[bj] = *(const f32x4*)(bp + 4); }
        }
#pragma unroll
        for (int ai = 0; ai < 2; ++ai)
#pragma unroll
            for (int m = 0; m < 4; ++m) {
                bf16_t* rowp = O + (size_t)(row0 + ai * 128 + m * 16) * ldc + col0;
                const float rs = R.v[ai][m];
#pragma unroll
                for (int bj = 0; bj < 2; ++bj) {
                    const f32x4 v0 = acc[ai][bj][m][0] * rs + b0[bj], v1 = acc[ai][bj][m][1] * rs + b1[bj];
                    u32x4 w; w.x = cvt_pk_bf16(v0[0], v0[1]); w.y = cvt_pk_bf16(v0[2], v0[3]); w.z = cvt_pk_bf16(v1[0], v1[1]); w.w = cvt_pk_bf16(v1[2], v1[3]);
                    *(u32x4*)(rowp + bj * 128) = w;
                }
            }
    }
};
struct EpiGeluUV {
    static constexpr bool PERM = true;
    bf16_t* O; float* ssp; const float* rsp; const float* bias;
    __device__ __forceinline__ void operator()(const f32x4 (&acc)[2][2][4][2], const Unit& u, int wr, int wc, int fr, int fq) const {
        const int cond = u.pm < 32 ? 0 : 1 + ((u.pm - 32) >> 2);
        const int row0 = u.pm * 256 + wr * 64 + fr, col0 = u.pn * 256 + wc * 32 + 8 * fq;
        const Rstd8 R = load_rstd8(rsp, row0, fq);
        f32x4 b0[2], b1[2];
#pragma unroll
        for (int bj = 0; bj < 2; ++bj) { const float* bp = bias + (size_t)cond * 5632 + col0 + bj * 128; b0[bj] = *(const f32x4*)bp; b1[bj] = *(const f32x4*)(bp + 4); }
#pragma unroll
        for (int ai = 0; ai < 2; ++ai)
#pragma unroll
            for (int m = 0; m < 4; ++m) {
                const int row = row0 + ai * 128 + m * 16;
                bf16_t* rowp = O + (size_t)row * 4096 + col0;
                const float rs = R.v[ai][m];
                float ss = 0.f;
#pragma unroll
                for (int bj = 0; bj < 2; ++bj) {
                    f32x4 v0, v1;
#pragma unroll
                    for (int j = 0; j < 4; ++j) { v0[j] = gelu_tanh_f(acc[ai][bj][m][0][j] * rs + b0[bj][j]); v1[j] = gelu_tanh_f(acc[ai][bj][m][1][j] * rs + b1[bj][j]); ss += v0[j] * v0[j] + v1[j] * v1[j]; }
                    u32x4 w; w.x = cvt_pk_bf16(v0[0], v0[1]); w.y = cvt_pk_bf16(v0[2], v0[3]); w.z = cvt_pk_bf16(v1[0], v1[1]); w.w = cvt_pk_bf16(v1[2], v1[3]);
                    *(u32x4*)(rowp + bj * 128) = w;
                }
                if (u.pn >= 8) { ss += __shfl_xor(ss, 16); ss += __shfl_xor(ss, 32); if (fq == 0) ssp[(size_t)row * 32 + (u.pn - 8) * 4 + wc] = ss; }
            }
    }
};

struct TJob { int src; int batch, K, N; unsigned long long dst; int rows_pb, blk, blk_stride, off; };
__device__ const TJob g_jobs[12] = {
    {10, 4, 1024, 2816, OFF_WGU1, 5632, 128, 256, 0},
    {11, 4, 1024, 2816, OFF_WGU1, 5632, 128, 256, 128},
    {12, 4, 2816, 1024, OFF_WD1, 1024, 1024, 1024, 0},
    {13, 4, 1024, 2816, OFF_WGU2, 5632, 128, 256, 0},
    {14, 4, 1024, 2816, OFF_WGU2, 5632, 128, 256, 128},
    {15, 4, 2816, 1024, OFF_WD2, 1024, 1024, 1024, 0},
    {16, 2, 1024, 2240, OFF_WINE, 2304, 4096, 4096, 0},
    {17, 2, 1024, 1024, OFF_WOUTE, 1024, 1024, 1024, 0},
    {22, 2, 384, 768, OFF_WQB, 768, 1024, 1024, 0},
    {24, 2, 256, 1024, OFF_WKVB, 1024, 1024, 1024, 0},
    {27, 2, 1024, 4096, OFF_WINO, 4096, 4096, 4096, 0},
    {31, 2, 2048, 1024, OFF_WOUTO, 1024, 1024, 1024, 0}};
__device__ __forceinline__ TJob get_job(int j) { return g_jobs[j]; }
constexpr int NJOBS = 12;
__device__ __forceinline__ int job_tiles(const TJob& J) { return J.batch * (J.K / 128) * ((J.N + 127) / 128); }

__device__ __forceinline__ void tt_load(const Params& p, const TJob& J, int t, int tid, f32x4 (&va)[4], f32x4 (&vb)[4]) {
    const int nk = J.K / 128, nn = (J.N + 127) / 128;
    const int bt = t / (nk * nn), rem = t % (nk * nn), kt = rem / nn, ntile = rem % nn;
    const float* src = pin(p, J.src) + (size_t)bt * J.K * J.N + (size_t)(kt * 128) * J.N + ntile * 128;
    const int c4 = tid & 31, r0 = tid >> 5;
    const bool colok = (ntile * 128 + c4 * 4) < J.N;
#pragma unroll
    for (int i = 0; i < 4; ++i) {
        const int k = 2 * (r0 + 16 * i);
        if (colok) { va[i] = *(const f32x4*)(src + (size_t)k * J.N + c4 * 4); vb[i] = *(const f32x4*)(src + (size_t)(k + 1) * J.N + c4 * 4); }
        else { va[i] = (f32x4){0.f, 0.f, 0.f, 0.f}; vb[i] = va[i]; }
    }
}
__device__ __forceinline__ void tt_process(const Params& p, LAS unsigned char* lds, const TJob& J, int t, int tid, const f32x4 (&va)[4], const f32x4 (&vb)[4]) {
    const int nk = J.K / 128, nn = (J.N + 127) / 128;
    const int bt = t / (nk * nn), rem = t % (nk * nn), kt = rem / nn, ntile = rem % nn;
    LAS unsigned* sT = (LAS unsigned*)lds;
    const int c4 = tid & 31, r0 = tid >> 5;
#pragma unroll
    for (int i = 0; i < 4; ++i) {
        const int k2 = r0 + 16 * i;
#pragma unroll
        for (int e = 0; e < 4; ++e) sT[(c4 * 4 + e) * 65 + k2] = cvt_pk_bf16(va[i][e], vb[i][e]);
    }
    __syncthreads();
    bf16_t* dstb = (bf16_t*)(p.ws + J.dst) + (size_t)bt * J.rows_pb * J.K + kt * 128;
    const int k8 = tid & 15, nr = tid >> 4;
#pragma unroll
    for (int i = 0; i < 4; ++i) {
        const int nl = nr + 32 * i, n = ntile * 128 + nl;
        if (n < J.N) {
            u32x4 w; w.x = sT[nl * 65 + k8 * 4]; w.y = sT[nl * 65 + k8 * 4 + 1]; w.z = sT[nl * 65 + k8 * 4 + 2]; w.w = sT[nl * 65 + k8 * 4 + 3];
            const int drow = (n / J.blk) * J.blk_stride + (n % J.blk) + J.off;
            *(u32x4*)(dstb + (size_t)drow * J.K + k8 * 8) = w;
        }
    }
    __syncthreads();
}
__device__ __forceinline__ void transpose_job(const Params& p, LAS unsigned char* lds, const TJob& J, int t0, int nt, int G) {
    const int tid = otid();
    for (int t = t0; t < nt; t += 4 * G) {
        f32x4 va[4][4], vb[4][4];
#pragma unroll
        for (int q = 0; q < 4; ++q) if (t + q * G < nt) tt_load(p, J, t + q * G, tid, va[q], vb[q]);
#pragma unroll
        for (int q = 0; q < 4; ++q) if (t + q * G < nt) tt_process(p, lds, J, t + q * G, tid, va[q], vb[q]);
    }
}

__device__ __forceinline__ void mod_tile(const Params& p, LAS unsigned char* lds, int t) {
    const int tid = otid();
    const int l = t / 72, n0 = (t % 72) * 128;
    LAS float* sC = (LAS float*)lds;
    LAS float* sR = (LAS float*)(lds + 36864);
    { const float* cctx = pin(p, 3); const float* cc = pin(p, 2);
      for (int i = tid; i < 9 * 1024; i += 512) { const int c = i >> 10, k = i & 1023; const float v = c == 0 ? cctx[k] : cc[(c - 1) * 1024 + k]; sC[i] = silu_f(v); } }
    __syncthreads();
    const int cgp = tid & 31, ks = tid >> 5;
    const float* w = pin(p, 7) + (size_t)l * 1024 * 9216 + (size_t)(ks * 64) * 9216 + n0 + cgp * 4;
    f32x4 acc[9];
#pragma unroll
    for (int c = 0; c < 9; ++c) acc[c] = (f32x4){0.f, 0.f, 0.f, 0.f};
    for (int k0 = 0; k0 < 64; k0 += 8) {
        f32x4 wv[8];
#pragma unroll
        for (int i = 0; i < 8; ++i) wv[i] = *(const f32x4*)(w + (size_t)(k0 + i) * 9216);
#pragma unroll
        for (int i = 0; i < 8; ++i)
#pragma unroll
            for (int c = 0; c < 9; ++c) acc[c] += wv[i] * sC[c * 1024 + ks * 64 + k0 + i];
    }
#pragma unroll
    for (int c = 0; c < 9; ++c) *(LAS f32x4*)(sR + (ks * 9 + c) * 128 + cgp * 4) = acc[c];
    __syncthreads();
    float* mod = (float*)(p.ws + OFF_MOD);
    const float* adab = pin(p, 8);
    for (int i = tid; i < 9 * 128; i += 512) {
        const int c = i >> 7, col = i & 127;
        float s = adab[l * 9216 + n0 + col];
#pragma unroll
        for (int k = 0; k < 16; ++k) s += sR[(k * 9 + c) * 128 + col];
        mod[((size_t)l * 9 + c) * 9216 + n0 + col] = s;
    }
    __syncthreads();
}

__device__ __forceinline__ void transpose_layer(const Params& p, LAS unsigned char* lds, int l, int first, int stride) {
    int base = 0;
    for (int jj = 0; jj < 10; ++jj) {
        int j, bt;
        if (jj < 6) { j = jj; bt = l; }
        else if (l & 1) { if (jj >= 8) break; j = 10 + (jj - 6); bt = l >> 1; }
        else { j = 6 + (jj - 6); bt = l >> 1; }
        const TJob J = get_job(j);
        const int tpb = (J.K / 128) * ((J.N + 127) / 128);
        const int lo = bt * tpb;
        transpose_job(p, lds, J, lo + (first + stride - (base % stride)) % stride, lo + tpb, stride);
        base += tpb;
    }
}
__device__ __forceinline__ void prologue_phase(const Params& p, LAS unsigned char* lds) {
    const int tid = otid(), G = ogrid(), bid = obid();
    for (int t = bid; t < 288; t += G) mod_tile(p, lds, t);
    {
        const float* s = pin(p, 29); bf16_t* d = (bf16_t*)(p.ws + OFF_WS);
        for (int i = bid * 512 + tid; i < 2 * 4 * 128 * 128 / 2; i += G * 512) ((unsigned*)d)[i] = cvt_pk_bf16(s[2 * i], s[2 * i + 1]);
    }
    transpose_layer(p, lds, 0, bid, G);
}

__device__ __forceinline__ void bias_items(const Params& p, LAS unsigned char* lds, int first, int last, int stride) {
    const int tid = otid(), wid = tid >> 6, lane = tid & 63;
    const float* mod = (const float*)(p.ws + OFF_MOD);
    LAS float* sC = (LAS float*)lds;
    LAS float* sP = (LAS float*)(lds + 36864);
    float* biasb = (float*)(p.ws + OFF_BIAS);
    for (int item = first; item < last; item += stride) {
        int u = 0, c0 = item;
#pragma unroll 1
        for (;;) { const int s3 = u % 3, lo = u / 3; const int nch = (s3 == 1) ? ((lo & 1) ? 32 : 18) : 44; if (c0 < nch) break; c0 -= nch; ++u; }
        const int l = u / 3, s3 = u % 3, j = l >> 1;
        const bf16_t* Bt = (s3 == 0) ? (const bf16_t*)(p.ws + OFF_WGU1) + (size_t)l * 5632 * 1024
                         : (s3 == 2) ? (const bf16_t*)(p.ws + OFF_WGU2) + (size_t)l * 5632 * 1024
                         : (l & 1)   ? (const bf16_t*)(p.ws + OFF_WINO) + (size_t)j * 4096 * 1024
                                     : (const bf16_t*)(p.ws + OFF_WINE) + (size_t)j * 2304 * 1024;
        __syncthreads();
        {
            float tmp[18];
#pragma unroll
            for (int i = 0; i < 18; ++i) { const int idx = tid + 512 * i, c = idx >> 10, k = idx & 1023; tmp[i] = mod[((size_t)l * 9 + c) * 9216 + (size_t)(3 * s3) * 1024 + k]; }
#pragma unroll
            for (int i = 0; i < 18; ++i) sC[tid + 512 * i] = tmp[i];
        }
        __syncthreads();
        const int rw = (wid & 1) * 64 + lane, ks = wid >> 1;
        const bf16_t* wrow = Bt + (size_t)(c0 * 128 + rw) * 1024 + ks * 256;
        float acc[9];
#pragma unroll
        for (int c = 0; c < 9; ++c) acc[c] = 0.f;
#pragma unroll 4
        for (int kk = 0; kk < 256; kk += 8) {
            const u32x4 ww = *(const u32x4*)(wrow + kk);
            float wv[8];
#pragma unroll
            for (int e = 0; e < 4; ++e) { wv[2 * e] = bflo(ww[e]); wv[2 * e + 1] = bfhi(ww[e]); }
#pragma unroll
            for (int c = 0; c < 9; ++c) {
                const f32x4 s0 = *(const LAS f32x4*)(sC + c * 1024 + ks * 256 + kk), s1 = *(const LAS f32x4*)(sC + c * 1024 + ks * 256 + kk + 4);
                acc[c] += wv[0] * s0[0] + wv[1] * s0[1] + wv[2] * s0[2] + wv[3] * s0[3] + wv[4] * s1[0] + wv[5] * s1[1] + wv[6] * s1[2] + wv[7] * s1[3];
            }
        }
#pragma unroll
        for (int c = 0; c < 9; ++c) sP[(ks * 9 + c) * 128 + rw] = acc[c];
        __syncthreads();
        for (int idx = tid; idx < 9 * 128; idx += 512) {
            const int c = idx >> 7, r = idx & 127;
            const float t = sP[(0 * 9 + c) * 128 + r] + sP[(1 * 9 + c) * 128 + r] + sP[(2 * 9 + c) * 128 + r] + sP[(3 * 9 + c) * 128 + r];
            biasb[((size_t)u * 9 + c) * 5632 + c0 * 128 + r] = t;
        }
    }
    __syncthreads();
}


__device__ __forceinline__ void prologue_b(const Params& p, LAS unsigned char* lds) {
    const int tid = otid(), wid = tid >> 6, lane = tid & 63, bid = obid(), G = ogrid();
    const float* mod = (const float*)(p.ws + OFF_MOD);
    {
        const float* g = pin(p, 9); const float* x0 = pin(p, 0); const float* x1 = pin(p, 1);
        bf16_t* h = (bf16_t*)(p.ws + OFF_H); float* rsp = (float*)(p.ws + OFF_RSP);
        for (int row = bid * 8 + wid; row < T_ALL; row += G * 8) {
            const int cond = row < T_CTX ? 0 : 1 + ((row - T_CTX) >> 10);
            const float* src = row < T_CTX ? x0 + (size_t)row * 1024 : x1 + (size_t)(row - T_CTX) * 1024;
            const float* mp = mod + (size_t)cond * 9216 + 1024;
            f32x4 v[4]; float ss = 0.f;
#pragma unroll
            for (int i = 0; i < 4; ++i) { v[i] = *(const f32x4*)(src + i * 256 + lane * 4); ss += v[i][0] * v[i][0] + v[i][1] * v[i][1] + v[i][2] * v[i][2] + v[i][3] * v[i][3]; }
            ss = wave_sum(ss);
#pragma unroll
            for (int i = 0; i < 4; ++i) {
                const int col = i * 256 + lane * 4;
                const f32x4 gs = *(const f32x4*)(g + col) * (*(const f32x4*)(mp + col) + 1.f);
                const f32x4 hv = v[i] * gs;
                u32x2 w; w.x = cvt_pk_bf16(hv[0], hv[1]); w.y = cvt_pk_bf16(hv[2], hv[3]);
                *(u32x2*)(h + (size_t)row * 1024 + col) = w;
                *(f32x4*)(p.out + (size_t)row * 1024 + col) = v[i];
            }
            if (lane < 16) rsp[(size_t)row * 16 + lane] = lane == 0 ? ss : 0.f;
        }
    }
    bias_items(p, lds, bid, 106, G);
}

__device__ __forceinline__ f32x4 mfma16(bf16x8 a, bf16x8 b, f32x4 c) { return __builtin_amdgcn_mfma_f32_16x16x32_bf16(a, b, c, 0, 0, 0); }

__device__ __forceinline__ void gla_unit(const Params& p, LAS unsigned char* lds, int j, int unit) {
    const int tid = otid(), wid = tid >> 6, lane = tid & 63, fr = lane & 15, fq = lane >> 4;
    int b, h, dir, Tn, row0; bool lat;
    if (unit < 64) { lat = true; b = unit >> 3; h = (unit >> 1) & 3; dir = unit & 1; Tn = 1024; row0 = T_CTX + b * 1024; }
    else { const int u2 = unit - 64; lat = false; b = u2 >> 3; h = (u2 >> 1) & 3; dir = u2 & 1; Tn = 256; row0 = b * 256; }
    const bf16_t* proj = (const bf16_t*)(p.ws + OFF_PROJ);
    float* obuf = (float*)(p.ws + (dir ? OFF_OB : OFF_OF));
    LAS bf16_t* sQ = (LAS bf16_t*)lds;
    LAS bf16_t* sK = (LAS bf16_t*)(lds + 9216);
    LAS bf16_t* sKT = (LAS bf16_t*)(lds + 18432);
    LAS bf16_t* sVT = (LAS bf16_t*)(lds + 27648);
    LAS bf16_t* sAtt = (LAS bf16_t*)(lds + 46080);
    LAS bf16_t* sST = (LAS bf16_t*)(lds + 55296);
    LAS float* sCum = (LAS float*)(lds + 73728);
    LAS float* sGl = (LAS float*)(lds + 90112);
    LAS float* sSeg = (LAS float*)(lds + 94208);
    LAS float* sLast = (LAS float*)(lds + 96256);
    const int d_ = tid & 63, seg = tid >> 6;
    float w2r[16];
    const float* w2p = pin(p, 18); const float* stp = pin(p, 6);
#pragma unroll
    for (int r = 0; r < 16; ++r) w2r[r] = w2p[(size_t)((j * 2 + dir) * 16 + r) * 256 + h * 64 + d_];
    const float bz = pin(p, 19)[(j * 2 + dir) * 256 + h * 64 + d_];
    f32x4 Sacc[4];
    const size_t sbase_in = ((((size_t)b * 2 + j) * 2 + dir) * 4 + h) * 64 * 128;
#pragma unroll
    for (int dt = 0; dt < 4; ++dt) {
#pragma unroll
        for (int reg = 0; reg < 4; ++reg) Sacc[dt][reg] = lat ? stp[sbase_in + (size_t)(dt * 16 + fq * 4 + reg) * 128 + wid * 16 + fr] : 0.f;
        u32x2 w; w.x = cvt_pk_bf16(Sacc[dt][0], Sacc[dt][1]); w.y = cvt_pk_bf16(Sacc[dt][2], Sacc[dt][3]);
        *(LAS u32x2*)(sST + (wid * 16 + fr) * 72 + dt * 16 + fq * 4) = w;
    }
    const int nch = Tn / 64;
    const int sig = tid >> 3, part = tid & 7;
    u32x4 pq, pk; bf16x8 pv0, pv1; unsigned pgl;
#define GLA_LOAD(C) do { const int tokl_ = dir ? (Tn - 1 - ((C) * 64 + sig)) : ((C) * 64 + sig); const bf16_t* pr_ = proj + (size_t)(row0 + tokl_) * PROJ_LD; \
        pq = *(const u32x4*)(pr_ + h * 64 + part * 8); pk = *(const u32x4*)(pr_ + 256 + h * 64 + part * 8); \
        pv0 = *(const bf16x8*)(pr_ + 512 + h * 128 + part * 16); pv1 = *(const bf16x8*)(pr_ + 512 + h * 128 + part * 16 + 8); \
        pgl = *(const unsigned*)(pr_ + 1536 + dir * 16 + part * 2); } while (0)
    GLA_LOAD(0);
    for (int c = 0; c < nch; ++c) {
        const u32x4 qv = pq, kv = pk; const bf16x8 v0 = pv0, v1 = pv1; const unsigned glw = pgl;
        if (c + 1 < nch) GLA_LOAD(c + 1);
        sGl[sig * 16 + part * 2] = bflo(glw); sGl[sig * 16 + part * 2 + 1] = bfhi(glw);
        __syncthreads();
        float cumv[8]; float run = 0.f;
#pragma unroll
        for (int i = 0; i < 8; ++i) {
            const int tau = seg * 8 + i; float z = bz;
#pragma unroll
            for (int r = 0; r < 16; ++r) z += sGl[tau * 16 + r] * w2r[r];
            const float la = (fminf(z, 0.f) - __logf(1.f + __expf(-fabsf(z)))) * (1.f / 16.f);
            run += la; cumv[i] = run;
        }
        sSeg[seg * 64 + d_] = run;
        __syncthreads();
        float pre = 0.f;
#pragma unroll
        for (int s = 0; s < 7; ++s) pre += (s < seg) ? sSeg[s * 64 + d_] : 0.f;
#pragma unroll
        for (int i = 0; i < 8; ++i) sCum[(seg * 8 + i) * 64 + d_] = cumv[i] + pre;
        if (seg == 7) sLast[d_] = __expf(cumv[7] + pre);
        __syncthreads();
        {
            float qf[8], kt[8], kh[8];
#pragma unroll
            for (int e2 = 0; e2 < 4; ++e2) {
                const unsigned qw = qv[e2], kw = kv[e2];
#pragma unroll
                for (int hh = 0; hh < 2; ++hh) {
                    const int e = e2 * 2 + hh, d = part * 8 + e;
                    const float cm = sCum[sig * 64 + d], lc = sCum[63 * 64 + d];
                    const float q_ = hh ? bfhi(qw) : bflo(qw), k_ = hh ? bfhi(kw) : bflo(kw);
                    qf[e] = q_ * 0.125f * __expf(cm); kt[e] = k_ * __expf(-cm); kh[e] = k_ * __expf(lc - cm);
                }
            }
            u32x4 wq, wk;
            wq.x = cvt_pk_bf16(qf[0], qf[1]); wq.y = cvt_pk_bf16(qf[2], qf[3]); wq.z = cvt_pk_bf16(qf[4], qf[5]); wq.w = cvt_pk_bf16(qf[6], qf[7]);
            wk.x = cvt_pk_bf16(kt[0], kt[1]); wk.y = cvt_pk_bf16(kt[2], kt[3]); wk.z = cvt_pk_bf16(kt[4], kt[5]); wk.w = cvt_pk_bf16(kt[6], kt[7]);
            *(LAS u32x4*)(sQ + sig * 72 + part * 8) = wq;
            *(LAS u32x4*)(sK + sig * 72 + part * 8) = wk;
#pragma unroll
            for (int e = 0; e < 8; ++e) sKT[(part * 8 + e) * 72 + (sig ^ (part << 3))] = f2bf(kh[e]);
#pragma unroll
            for (int e = 0; e < 8; ++e) { sVT[(part * 16 + e) * 72 + (sig ^ (part << 3))] = (bf16_t)v0[e]; sVT[(part * 16 + 8 + e) * 72 + (sig ^ (part << 3))] = (bf16_t)v1[e]; }
        }
        __syncthreads();
        {
            const int taut = wid >> 1;
#pragma unroll
            for (int s2 = 0; s2 < 2; ++s2) {
                const int sigt = (wid & 1) * 2 + s2;
                f32x4 a4 = (f32x4){0.f, 0.f, 0.f, 0.f};
#pragma unroll
                for (int kk = 0; kk < 2; ++kk) {
                    const bf16x8 a = *(const LAS bf16x8*)(sK + (sigt * 16 + fr) * 72 + kk * 32 + fq * 8);
                    const bf16x8 bq = *(const LAS bf16x8*)(sQ + (taut * 16 + fr) * 72 + kk * 32 + fq * 8);
                    a4 = mfma16(a, bq, a4);
                }
#pragma unroll
                for (int reg = 0; reg < 4; ++reg) a4[reg] = ((sigt * 16 + fq * 4 + reg) <= (taut * 16 + fr)) ? a4[reg] : 0.f;
                u32x2 w; w.x = cvt_pk_bf16(a4[0], a4[1]); w.y = cvt_pk_bf16(a4[2], a4[3]);
                *(LAS u32x2*)(sAtt + (taut * 16 + fr) * 72 + sigt * 16 + fq * 4) = w;
            }
        }
        __syncthreads();
#pragma unroll
        for (int taut = 0; taut < 4; ++taut) {
            f32x4 o4 = (f32x4){0.f, 0.f, 0.f, 0.f};
#pragma unroll
            for (int kk = 0; kk < 2; ++kk) {
                const bf16x8 a = *(const LAS bf16x8*)(sQ + (taut * 16 + fr) * 72 + kk * 32 + fq * 8);
                const u32x4 bbu = *(const LAS u32x4*)(sST + (wid * 16 + fr) * 72 + kk * 32 + fq * 8);
                o4 = mfma16(a, __builtin_bit_cast(bf16x8, bbu), o4);
            }
#pragma unroll
            for (int kk = 0; kk < 2; ++kk) {
                const bf16x8 a = *(const LAS bf16x8*)(sAtt + (taut * 16 + fr) * 72 + kk * 32 + fq * 8);
                const bf16x8 bb = *(const LAS bf16x8*)(sVT + (wid * 16 + fr) * 72 + (((kk * 4 + fq) ^ wid) << 3));
                o4 = mfma16(a, bb, o4);
            }
#pragma unroll
            for (int reg = 0; reg < 4; ++reg) {
                const int tau = taut * 16 + fq * 4 + reg;
                const int tk = dir ? (Tn - 1 - (c * 64 + tau)) : (c * 64 + tau);
                obuf[(size_t)(row0 + tk) * 512 + h * 128 + wid * 16 + fr] = o4[reg];
            }
        }
        __syncthreads();
#pragma unroll
        for (int dt = 0; dt < 4; ++dt) {
#pragma unroll
            for (int reg = 0; reg < 4; ++reg) Sacc[dt][reg] *= sLast[dt * 16 + fq * 4 + reg];
#pragma unroll
            for (int kk = 0; kk < 2; ++kk) {
                const bf16x8 a = *(const LAS bf16x8*)(sKT + (dt * 16 + fr) * 72 + (((kk * 4 + fq) ^ (dt * 2 + (fr >> 3))) << 3));
                const bf16x8 bb = *(const LAS bf16x8*)(sVT + (wid * 16 + fr) * 72 + (((kk * 4 + fq) ^ wid) << 3));
                Sacc[dt] = mfma16(a, bb, Sacc[dt]);
            }
            u32x2 w; w.x = cvt_pk_bf16(Sacc[dt][0], Sacc[dt][1]); w.y = cvt_pk_bf16(Sacc[dt][2], Sacc[dt][3]);
            *(LAS u32x2*)(sST + (wid * 16 + fr) * 72 + dt * 16 + fq * 4) = w;
        }
        __syncthreads();
    }
    if (!lat) {
        float* og = p.out + OUT_GLA + ((((size_t)b * 2 + j) * 2 + dir) * 4 + h) * 64 * 128;
#pragma unroll
        for (int dt = 0; dt < 4; ++dt)
#pragma unroll
            for (int reg = 0; reg < 4; ++reg) og[(size_t)(dt * 16 + fq * 4 + reg) * 128 + wid * 16 + fr] = Sacc[dt][reg];
    }
}

__device__ __forceinline__ void mla_prep_tile(const Params& p, int j, int t) {
    const int tid = otid(), wid = tid >> 6, lane = tid & 63;
    const bf16_t* proj = (const bf16_t*)(p.ws + OFF_PROJ);
    bf16_t* cqn = (bf16_t*)(p.ws + OFF_CQN); bf16_t* ckvn = (bf16_t*)(p.ws + OFF_CKVN);
    const float* qag = pin(p, 21); const float* kvag = pin(p, 23); const float* cckv = pin(p, 4);
    for (int i = 0; i < 8; ++i) {
        const int r = t * 64 + wid * 8 + i;
        if (r < T_ALL) {
            const bf16_t* pr = proj + (size_t)r * PROJ_LD;
            float cq[6]; float ss = 0.f;
#pragma unroll
            for (int k = 0; k < 3; ++k) { const unsigned w = *(const unsigned*)(pr + 1568 + k * 128 + lane * 2); cq[2 * k] = bflo(w); cq[2 * k + 1] = bfhi(w); ss += cq[2 * k] * cq[2 * k] + cq[2 * k + 1] * cq[2 * k + 1]; }
            ss = wave_sum(ss);
            const float rq = rsqrtf(ss * (1.f / 384.f) + EPS);
#pragma unroll
            for (int k = 0; k < 3; ++k) { const int col = k * 128 + lane * 2; const float g0 = qag[j * 384 + col], g1 = qag[j * 384 + col + 1];
                *(unsigned*)(cqn + (size_t)r * 384 + col) = cvt_pk_bf16(cq[2 * k] * rq * g0, cq[2 * k + 1] * rq * g1); }
            const u32x2 kw = *(const u32x2*)(pr + 1952 + lane * 4);
            float kv[4] = {bflo(kw.x), bfhi(kw.x), bflo(kw.y), bfhi(kw.y)};
            float s2 = kv[0] * kv[0] + kv[1] * kv[1] + kv[2] * kv[2] + kv[3] * kv[3];
            s2 = wave_sum(s2);
            const float rk = rsqrtf(s2 * (1.f / 256.f) + EPS);
            const f32x4 gk = *(const f32x4*)(kvag + j * 256 + lane * 4);
            f32x4 y;
#pragma unroll
            for (int e = 0; e < 4; ++e) y[e] = kv[e] * rk * gk[e];
            u32x2 w; w.x = cvt_pk_bf16(y[0], y[1]); w.y = cvt_pk_bf16(y[2], y[3]);
            *(u32x2*)(ckvn + (size_t)r * 256 + lane * 4) = w;
            if (r < T_CTX) {
                const int bb = r >> 8, tt = r & 255;
                *(f32x4*)(p.out + OUT_CKV + (((size_t)bb * 2 + j) * 256 + tt) * 256 + lane * 4) = y;
                if (lane < 32) p.out[OUT_KROPE + (((size_t)bb * 2 + j) * 256 + tt) * 32 + lane] = bf2f(pr[2208 + lane]);
            }
        } else {
            const int rc = r - T_ALL, bb = rc >> 8, m = rc & 255;
            const f32x4 v = *(const f32x4*)(cckv + (((size_t)bb * 2 + j) * 256 + m) * 256 + lane * 4);
            u32x2 w; w.x = cvt_pk_bf16(v[0], v[1]); w.y = cvt_pk_bf16(v[2], v[3]);
            *(u32x2*)(ckvn + (size_t)r * 256 + lane * 4) = w;
        }
    }
}

__device__ __forceinline__ void even2_phase(const Params& p, LAS unsigned char* lds, int j) {
    const int bid = obid(), G = ogrid();
    if (G >= 128) {
        if (bid < 64) { gla_unit(p, lds, j, bid); __syncthreads(); }
        else { for (int it = 64 + (bid - 64); it < 608; it += (G - 64)) { if (it < 320) { gla_unit(p, lds, j, it); __syncthreads(); } else mla_prep_tile(p, j, it - 320); } }
    } else {
        for (int it = bid; it < 608; it += G) { if (it < 320) { gla_unit(p, lds, j, it); __syncthreads(); } else mla_prep_tile(p, j, it - 320); }
    }
}


__device__ __forceinline__ float rope_inv(int i) { return __builtin_amdgcn_exp2f(-(float)(i & 7) * 1.6609640474f); }


__device__ __forceinline__ void kprep_tile(const Params& p, LAS unsigned char* lds, int j, int tile) {
    const int tid = otid();
    const int rt = tile >> 3, h = tile & 7, row0 = rt * 64;
    const bf16_t* proj = (const bf16_t*)(p.ws + OFF_PROJ); const bf16_t* kvraw = (const bf16_t*)(p.ws + OFF_KVRAW);
    bf16_t* KN = (bf16_t*)(p.ws + OFF_KN); bf16_t* VT = (bf16_t*)(p.ws + OFF_VT);
    LAS bf16_t* sVT = (LAS bf16_t*)lds;
    const float* kg = pin(p, 26) + j * 96; const float* ckr = pin(p, 5);
    const int key = tid >> 3, part = tid & 7, row = row0 + key;
    float kr[4]; bool rope = false; int pos = 0;
    if (row < T_ALL) { const u32x2 w = *(const u32x2*)(proj + (size_t)row * PROJ_LD + 2208 + part * 4); kr[0] = bflo(w.x); kr[1] = bfhi(w.x); kr[2] = bflo(w.y); kr[3] = bfhi(w.y);
        if (row >= T_CTX) { rope = true; pos = (row - T_CTX) & 1023; } }
    else { const int rc = row - T_ALL, bb = rc >> 8, m = rc & 255; const f32x4 w = *(const f32x4*)(ckr + (((size_t)bb * 2 + j) * 256 + m) * 32 + part * 4); kr[0] = w[0]; kr[1] = w[1]; kr[2] = w[2]; kr[3] = w[3]; }
    const bf16_t* kp = kvraw + (size_t)row * 1024 + h * 128;
    const u32x4 kn = *(const u32x4*)(kp + part * 8); const bf16x8 vv = *(const bf16x8*)(kp + 64 + part * 8);
    float kf[8];
#pragma unroll
    for (int e = 0; e < 4; ++e) { kf[2 * e] = bflo(kn[e]); kf[2 * e + 1] = bfhi(kn[e]); }
    float ss = kr[0] * kr[0] + kr[1] * kr[1] + kr[2] * kr[2] + kr[3] * kr[3];
#pragma unroll
    for (int e = 0; e < 8; ++e) ss += kf[e] * kf[e];
    ss += __shfl_xor(ss, 1); ss += __shfl_xor(ss, 2); ss += __shfl_xor(ss, 4);
    const float rstd = rsqrtf(ss * (1.f / 96.f) + EPS);
#pragma unroll
    for (int e = 0; e < 8; ++e) kf[e] *= rstd * kg[part * 8 + e];
#pragma unroll
    for (int e = 0; e < 4; ++e) kr[e] *= rstd * kg[64 + part * 4 + e];
    if (rope) {
        const float prow = (float)(pos >> 6), pcol = (float)(pos & 63);
#pragma unroll
        for (int pr = 0; pr < 2; ++pr) {
            const int i = part * 2 + pr;
            const float ang = (i < 8 ? prow : pcol) * rope_inv(i);
            const float rev = ang * 0.15915494309f;
            const float cs = __builtin_amdgcn_cosf(rev), sn = __builtin_amdgcn_sinf(rev);
            const float x1 = kr[2 * pr], x2 = kr[2 * pr + 1];
            kr[2 * pr] = x1 * cs - x2 * sn; kr[2 * pr + 1] = x1 * sn + x2 * cs;
        }
    }
    bf16_t* kd = KN + ((size_t)row * 8 + h) * 96;
    u32x4 w; w.x = cvt_pk_bf16(kf[0], kf[1]); w.y = cvt_pk_bf16(kf[2], kf[3]); w.z = cvt_pk_bf16(kf[4], kf[5]); w.w = cvt_pk_bf16(kf[6], kf[7]);
    *(u32x4*)(kd + part * 8) = w;
    u32x2 w2; w2.x = cvt_pk_bf16(kr[0], kr[1]); w2.y = cvt_pk_bf16(kr[2], kr[3]);
    *(u32x2*)(kd + 64 + part * 4) = w2;
#pragma unroll
    for (int e = 0; e < 8; ++e) sVT[(part * 8 + e) * 72 + key] = (bf16_t)vv[e];
    __syncthreads();
    {
        size_t base; int nk, k0;
        if (row0 < T_CTX) { base = (size_t)((row0 >> 8) * 8 + h) * 64 * 256; nk = 256; k0 = row0 & 255; }
        else if (row0 < T_ALL) { base = VT_LAT + (size_t)(((row0 - T_CTX) >> 10) * 8 + h) * 64 * 1280; nk = 1280; k0 = 256 + ((row0 - T_CTX) & 1023); }
        else { base = VT_LAT + (size_t)(((row0 - T_ALL) >> 8) * 8 + h) * 64 * 1280; nk = 1280; k0 = (row0 - T_ALL) & 255; }
        const int dv = tid >> 3, c8 = tid & 7;
        *(u32x4*)(VT + base + (size_t)dv * nk + k0 + c8 * 8) = *(const LAS u32x4*)(sVT + dv * 72 + c8 * 8);
    }
    __syncthreads();
}

__device__ __forceinline__ void attn_tile(const Params& p, LAS unsigned char* lds, int j, int tile) {
    const int tid = otid(), wid = tid >> 6, lane = tid & 63, fr = lane & 15, fq = lane >> 4;
    bool lat; int b, h, qb, nkb, qrow0;
    if (tile < 512) { lat = true; b = tile >> 6; h = (tile >> 3) & 7; qb = tile & 7; nkb = 20; qrow0 = T_CTX + b * 1024 + qb * 128; }
    else { const int t2 = tile - 512; lat = false; b = t2 >> 4; h = (t2 >> 1) & 7; qb = t2 & 1; nkb = 4; qrow0 = b * 256 + qb * 128; }
    const bf16_t* proj = (const bf16_t*)(p.ws + OFF_PROJ);
    const bf16_t* qraw = (const bf16_t*)(p.ws + OFF_QRAW);
    const bf16_t* kvraw = (const bf16_t*)(p.ws + OFF_KVRAW);
    bf16_t* cat = (bf16_t*)(p.ws + OFF_CAT);
    LAS bf16_t* sQ = (LAS bf16_t*)lds;
    LAS bf16_t* sK = (LAS bf16_t*)(lds + 26624);
    LAS bf16_t* sVT = (LAS bf16_t*)(lds + 39936);
    {
        const int q = tid >> 2, part = tid & 3;
        const bf16_t* qp = qraw + (size_t)(qrow0 + q) * 768 + h * 96;
        const u32x4 n0 = *(const u32x4*)(qp + part * 16), n1 = *(const u32x4*)(qp + part * 16 + 8), rp = *(const u32x4*)(qp + 64 + part * 8);
        float f[24];
#pragma unroll
        for (int e = 0; e < 4; ++e) { f[2 * e] = bflo(n0[e]); f[2 * e + 1] = bfhi(n0[e]); f[8 + 2 * e] = bflo(n1[e]); f[8 + 2 * e + 1] = bfhi(n1[e]); f[16 + 2 * e] = bflo(rp[e]); f[16 + 2 * e + 1] = bfhi(rp[e]); }
        float ss = 0.f;
#pragma unroll
        for (int e = 0; e < 24; ++e) ss += f[e] * f[e];
        ss += __shfl_xor(ss, 1); ss += __shfl_xor(ss, 2);
        const float rstd = rsqrtf(ss * (1.f / 96.f) + EPS);
        const float* g = pin(p, 25) + j * 96;
#pragma unroll
        for (int e = 0; e < 16; ++e) f[e] *= rstd * g[part * 16 + e];
#pragma unroll
        for (int e = 0; e < 8; ++e) f[16 + e] *= rstd * g[64 + part * 8 + e];
        if (lat) {
            const int pos = qb * 128 + q; const float prow = (float)(pos >> 6), pcol = (float)(pos & 63);
#pragma unroll
            for (int pr = 0; pr < 4; ++pr) {
                const int i = part * 4 + pr;
                const float ang = (i < 8 ? prow : pcol) * rope_inv(i);
                const float rev = ang * 0.15915494309f;
                const float cs = __builtin_amdgcn_cosf(rev), sn = __builtin_amdgcn_sinf(rev);
                const float x1 = f[16 + 2 * pr], x2 = f[16 + 2 * pr + 1];
                f[16 + 2 * pr] = x1 * cs - x2 * sn; f[16 + 2 * pr + 1] = x1 * sn + x2 * cs;
            }
        }
        const float sc = 0.10206207262f * 1.44269504089f;
        u32x4 w0, w1, w2;
#pragma unroll
        for (int e = 0; e < 4; ++e) { w0[e] = cvt_pk_bf16(f[2 * e] * sc, f[2 * e + 1] * sc); w1[e] = cvt_pk_bf16(f[8 + 2 * e] * sc, f[8 + 2 * e + 1] * sc); w2[e] = cvt_pk_bf16(f[16 + 2 * e] * sc, f[16 + 2 * e + 1] * sc); }
        *(LAS u32x4*)(sQ + q * 104 + part * 16) = w0; *(LAS u32x4*)(sQ + q * 104 + part * 16 + 8) = w1; *(LAS u32x4*)(sQ + q * 104 + 64 + part * 8) = w2;
    }
    __syncthreads();
    bf16x8 bQ[3];
#pragma unroll
    for (int kk = 0; kk < 3; ++kk) bQ[kk] = *(const LAS bf16x8*)(sQ + (wid * 16 + fr) * 104 + kk * 32 + fq * 8);
    float m_run = -1e30f, l_run = 0.f;
    f32x4 oacc[4];
#pragma unroll
    for (int dt = 0; dt < 4; ++dt) oacc[dt] = (f32x4){0.f, 0.f, 0.f, 0.f};
    const float* kg = pin(p, 26) + j * 96; const float* ckr = pin(p, 5);
    const bf16_t* KN = (const bf16_t*)(p.ws + OFF_KN);
    const bf16_t* VTg = (const bf16_t*)(p.ws + OFF_VT) + (lat ? VT_LAT + (size_t)(b * 8 + h) * 64 * 1280 : (size_t)(b * 8 + h) * 64 * 256);
    const int NK = lat ? 1280 : 256;
    u32x4 pf_k0, pf_k1, pf_v;
    const int kc0 = tid, kc1 = tid + 512;
    const int key0_ = kc0 / 12, pc0_ = kc0 % 12, key1_ = kc1 / 12, pc1_ = kc1 % 12;
#define ATT_ROW(KB, KEY) (!lat ? (b * 256 + (KB) * 64 + (KEY)) : ((KB) < 4 ? (T_ALL + b * 256 + (KB) * 64 + (KEY)) : (T_CTX + b * 1024 + ((KB) - 4) * 64 + (KEY))))
#define ATT_LOAD(KB) do { \
        pf_k0 = *(const u32x4*)(KN + ((size_t)ATT_ROW(KB, key0_) * 8 + h) * 96 + pc0_ * 8); \
        if (tid < 256) pf_k1 = *(const u32x4*)(KN + ((size_t)ATT_ROW(KB, key1_) * 8 + h) * 96 + pc1_ * 8); \
        pf_v = *(const u32x4*)(VTg + (size_t)(tid >> 3) * NK + (KB) * 64 + (tid & 7) * 8); } while (0)
    pf_k1 = (u32x4){0u, 0u, 0u, 0u};
    ATT_LOAD(0);
    for (int kb = 0; kb < nkb; ++kb) {
        *(LAS u32x4*)(sK + key0_ * 104 + pc0_ * 8) = pf_k0;
        if (tid < 256) *(LAS u32x4*)(sK + key1_ * 104 + pc1_ * 8) = pf_k1;
        *(LAS u32x4*)(sVT + (tid >> 3) * 72 + (tid & 7) * 8) = pf_v;
        __syncthreads();
        if (kb + 1 < nkb) ATT_LOAD(kb + 1);
        {
            f32x4 s[4];
#pragma unroll
            for (int g4 = 0; g4 < 4; ++g4) {
                s[g4] = (f32x4){0.f, 0.f, 0.f, 0.f};
#pragma unroll
                for (int kk = 0; kk < 3; ++kk) { const bf16x8 a = *(const LAS bf16x8*)(sK + (g4 * 16 + fr) * 104 + kk * 32 + fq * 8); s[g4] = mfma16(a, bQ[kk], s[g4]); }
            }
            float mx = s[0][0];
#pragma unroll
            for (int g4 = 0; g4 < 4; ++g4)
#pragma unroll
                for (int reg = 0; reg < 4; ++reg) mx = fmaxf(mx, s[g4][reg]);
            mx = fmaxf(mx, __shfl_xor(mx, 16)); mx = fmaxf(mx, __shfl_xor(mx, 32));
            const float m_new = fmaxf(m_run, mx);
            const float alpha = __builtin_amdgcn_exp2f(m_run - m_new);
            m_run = m_new;
            float ls = 0.f;
#pragma unroll
            for (int g4 = 0; g4 < 4; ++g4)
#pragma unroll
                for (int reg = 0; reg < 4; ++reg) { s[g4][reg] = __builtin_amdgcn_exp2f(s[g4][reg] - m_new); ls += s[g4][reg]; }
            l_run = l_run * alpha + ls;
#pragma unroll
            for (int dt = 0; dt < 4; ++dt) oacc[dt] *= alpha;
#pragma unroll
            for (int ks = 0; ks < 2; ++ks) {
                u32x4 pw; pw.x = cvt_pk_bf16(s[2 * ks][0], s[2 * ks][1]); pw.y = cvt_pk_bf16(s[2 * ks][2], s[2 * ks][3]); pw.z = cvt_pk_bf16(s[2 * ks + 1][0], s[2 * ks + 1][1]); pw.w = cvt_pk_bf16(s[2 * ks + 1][2], s[2 * ks + 1][3]);
                const bf16x8 bP = __builtin_bit_cast(bf16x8, pw);
#pragma unroll
                for (int dt = 0; dt < 4; ++dt) {
                    const u32x2 lo = *(const LAS u32x2*)(sVT + (dt * 16 + fr) * 72 + ks * 32 + fq * 4);
                    const u32x2 hi = *(const LAS u32x2*)(sVT + (dt * 16 + fr) * 72 + ks * 32 + 16 + fq * 4);
                    u32x4 av; av.x = lo.x; av.y = lo.y; av.z = hi.x; av.w = hi.y;
                    oacc[dt] = mfma16(__builtin_bit_cast(bf16x8, av), bP, oacc[dt]);
                }
            }
        }
        __syncthreads();
    }
    l_run += __shfl_xor(l_run, 16); l_run += __shfl_xor(l_run, 32);
    const float inv = 1.f / l_run;
    bf16_t* op = cat + (size_t)(qrow0 + wid * 16 + fr) * 1024 + 512 + h * 64;
#pragma unroll
    for (int dt = 0; dt < 4; ++dt) { u32x2 w; w.x = cvt_pk_bf16(oacc[dt][0] * inv, oacc[dt][1] * inv); w.y = cvt_pk_bf16(oacc[dt][2] * inv, oacc[dt][3] * inv); *(u32x2*)(op + dt * 16 + fq * 4) = w; }
}

__device__ __forceinline__ void gla_finish_rows(const Params& p, int j) {
    const int tid = otid(), wid = tid >> 6, lane = tid & 63;
    const float* of = (const float*)(p.ws + OFF_OF); const float* ob = (const float*)(p.ws + OFF_OB);
    const bf16_t* proj = (const bf16_t*)(p.ws + OFF_PROJ); bf16_t* cat = (bf16_t*)(p.ws + OFF_CAT);
    const int e0 = (lane & 15) * 8;
    const float* glag = pin(p, 20);
    for (int row = obid() * 8 + wid; row < T_ALL; row += ogrid() * 8) {
        const float* a = of + (size_t)row * 512 + lane * 8; const float* bb = ob + (size_t)row * 512 + lane * 8;
        f32x4 x0 = *(const f32x4*)a + *(const f32x4*)bb, x1 = *(const f32x4*)(a + 4) + *(const f32x4*)(bb + 4);
        float ss = x0[0] * x0[0] + x0[1] * x0[1] + x0[2] * x0[2] + x0[3] * x0[3] + x1[0] * x1[0] + x1[1] * x1[1] + x1[2] * x1[2] + x1[3] * x1[3];
        ss += __shfl_xor(ss, 1); ss += __shfl_xor(ss, 2); ss += __shfl_xor(ss, 4); ss += __shfl_xor(ss, 8);
        const float rstd = rsqrtf(ss * (1.f / 128.f) + EPS);
        const f32x4 g0 = *(const f32x4*)(glag + j * 128 + e0), g1 = *(const f32x4*)(glag + j * 128 + e0 + 4);
        const u32x4 ogw = *(const u32x4*)(proj + (size_t)row * PROJ_LD + 1024 + lane * 8);
        float y[8];
#pragma unroll
        for (int e = 0; e < 4; ++e) { y[e] = x0[e] * rstd * g0[e]; y[4 + e] = x1[e] * rstd * g1[e]; }
#pragma unroll
        for (int e = 0; e < 4; ++e) { y[2 * e] *= silu_f(bflo(ogw[e])); y[2 * e + 1] *= silu_f(bfhi(ogw[e])); }
        u32x4 w; w.x = cvt_pk_bf16(y[0], y[1]); w.y = cvt_pk_bf16(y[2], y[3]); w.z = cvt_pk_bf16(y[4], y[5]); w.w = cvt_pk_bf16(y[6], y[7]);
        *(u32x4*)(cat + (size_t)row * 1024 + lane * 8) = w;
    }
}


__device__ __forceinline__ void spatial_tile(const Params& p, LAS unsigned char* lds, int j, int tile) {
    const int tid = otid(), wid = tid >> 6, lane = tid & 63, fr = lane & 15, fq = lane >> 4;
    const int chunk = tile >> 4, slab = tile & 15, g = slab >> 2;
    const bf16_t* uv = (const bf16_t*)(p.ws + OFF_UV); bf16_t* gated = (bf16_t*)(p.ws + OFF_GATED);
    const float* ssp = (const float*)(p.ws + OFF_SSP);
    const bf16_t* Ws = (const bf16_t*)(p.ws + OFF_WS) + (size_t)(j * 4 + g) * 128 * 128;
    LAS bf16_t* sW = (LAS bf16_t*)lds;
    LAS bf16_t* sVT = (LAS bf16_t*)(lds + 34816);
    LAS float* sR = (LAS float*)(lds + 69632);
    if (tid < 128) { const float* s = ssp + (size_t)(chunk * 128 + tid) * 32; float a = 0.f;
#pragma unroll
        for (int i = 0; i < 32; i += 4) { const f32x4 v = *(const f32x4*)(s + i); a += v[0] + v[1] + v[2] + v[3]; }
        sR[tid] = rsqrtf(a * (1.f / 2048.f) + EPS); }
#pragma unroll
    for (int i = 0; i < 4; ++i) { const int idx = tid + 512 * i, row = idx >> 4, c8 = idx & 15; *(LAS u32x4*)(sW + row * 136 + c8 * 8) = *(const u32x4*)(Ws + row * 128 + c8 * 8); }
    __syncthreads();
    const float* vgp = pin(p, 28);
#pragma unroll
    for (int i = 0; i < 4; ++i) {
        const int idx = tid + 512 * i, q = idx >> 4, c8 = idx & 15;
        const u32x4 vv = *(const u32x4*)(uv + (size_t)(chunk * 128 + q) * 4096 + 2048 + slab * 128 + c8 * 8);
        const float rs = sR[q]; const float* vg = vgp + j * 2048 + slab * 128 + c8 * 8;
#pragma unroll
        for (int e = 0; e < 4; ++e) {
            sVT[(c8 * 8 + 2 * e) * 136 + (q ^ (c8 << 3))] = f2bf(bflo(vv[e]) * rs * vg[2 * e]);
            sVT[(c8 * 8 + 2 * e + 1) * 136 + (q ^ (c8 << 3))] = f2bf(bfhi(vv[e]) * rs * vg[2 * e + 1]);
        }
    }
    __syncthreads();
    bf16x8 aV[4];
#pragma unroll
    for (int kk = 0; kk < 4; ++kk) aV[kk] = *(const LAS bf16x8*)(sVT + (wid * 16 + fr) * 136 + (((kk * 4 + fq) ^ (wid * 2 + (fr >> 3))) << 3));
    const float* bs = pin(p, 30) + (size_t)(j * 4 + g) * 128;
#pragma unroll
    for (int pt = 0; pt < 8; ++pt) {
        f32x4 acc = (f32x4){0.f, 0.f, 0.f, 0.f};
#pragma unroll
        for (int kk = 0; kk < 4; ++kk) { const bf16x8 bw = *(const LAS bf16x8*)(sW + (pt * 16 + fr) * 136 + kk * 32 + fq * 8); acc = mfma16(aV[kk], bw, acc); }
        const int prow = pt * 16 + fr; const float bias = bs[prow];
        const size_t row = (size_t)chunk * 128 + prow; const int col = slab * 128 + wid * 16 + fq * 4;
        const u32x2 uw = *(const u32x2*)(uv + row * 4096 + col);
        u32x2 w; w.x = cvt_pk_bf16(bflo(uw.x) * (acc[0] + bias), bfhi(uw.x) * (acc[1] + bias)); w.y = cvt_pk_bf16(bflo(uw.y) * (acc[2] + bias), bfhi(uw.y) * (acc[3] + bias));
        *(u32x2*)(gated + row * 2048 + col) = w;
    }
    __syncthreads();
}

#define XB_TMO      128
#define XB_XCNT(j)  (256  + 64 * (j))
#define XB_XSUB(j)  (1280 + 64 * (j))
#define XB_XGEN(j)  (2304 + 64 * (j))
#define XB_TOP      3328
#define XB_TOPGEN   3392
#define XCD_BAR_WORDS 3456
#define XB_SPIN_CAP (1u << 18)

__device__ __forceinline__ unsigned xb_ld(unsigned* p)              { return __hip_atomic_load(p, __ATOMIC_RELAXED, __HIP_MEMORY_SCOPE_AGENT); }
__device__ __forceinline__ unsigned xb_add(unsigned* p, unsigned v) { return __hip_atomic_fetch_add(p, v, __ATOMIC_RELAXED, __HIP_MEMORY_SCOPE_AGENT); }
__device__ __forceinline__ unsigned xb_xcc_id() { return (unsigned)__builtin_amdgcn_s_getreg((3 << 11) | 20) & 0xFu; }
#define XB_SPIN(cond, bar) do { unsigned _sp = 0; while (cond) { __builtin_amdgcn_s_sleep(1); \
    if ((++_sp & 255u) == 0u) { if (xb_ld(&(bar)[XB_TMO])) break; if (_sp > XB_SPIN_CAP) { atomicAdd(&(bar)[XB_TMO], 1u); break; } } } } while (0)

struct XcdBarrier {
    unsigned* bar; unsigned x;
    volatile LAS unsigned* st;
};

__device__ __forceinline__ XcdBarrier xcd_barrier_post(unsigned* bar, volatile LAS unsigned* st) {
    XcdBarrier b; b.bar = bar; b.x = xb_xcc_id(); b.st = st;
    if (threadIdx.x == 0) (void)xb_add(&bar[XB_XCNT(b.x)], 1u);
    return b;
}
__device__ __forceinline__ void xcd_barrier_complete(unsigned* bar, unsigned x, unsigned& nloc, unsigned& nx) {
    const unsigned G = gridDim.x * gridDim.y * gridDim.z;
    unsigned sum, cnt, mine, sp = 0u;
    for (;;) {
        sum = 0u; cnt = 0u; mine = 0u;
#pragma unroll
        for (unsigned j = 0; j < 16; ++j) { const unsigned c = xb_ld(&bar[XB_XCNT(j)]); sum += c; cnt += (c > 0u) ? 1u : 0u; mine = (j == x) ? c : mine; }
        if (sum == G) break;
        __builtin_amdgcn_s_sleep(1);
        if ((++sp & 255u) == 0u) { if (xb_ld(&bar[XB_TMO])) break; if (sp > XB_SPIN_CAP) { atomicAdd(&bar[XB_TMO], 1u); break; } }
    }
    nloc = mine > 0u ? mine : 1u; nx = cnt > 0u ? cnt : 1u;
}

__device__ __forceinline__ void xcd_barrier(const XcdBarrier& b) {
    asm volatile("s_waitcnt vmcnt(0)" ::: "memory");
    __syncthreads();
    if (threadIdx.x == 0) {
        unsigned* bar = b.bar;
        __builtin_amdgcn_s_waitcnt(0);
        unsigned nloc = b.st[0], nx = b.st[1];
        if (nloc == 0u) { xcd_barrier_complete(bar, b.x, nloc, nx); b.st[0] = nloc; b.st[1] = nx; }
        const unsigned old = xb_add(&bar[XB_XSUB(b.x)], 1u);
        const unsigned gen = old / nloc;
        if (old + 1u == (gen + 1u) * nloc) {
            __builtin_amdgcn_fence(__ATOMIC_RELEASE, "agent");
            asm volatile("s_waitcnt vmcnt(0)" ::: "memory");
            const unsigned og = xb_add(&bar[XB_TOP], 1u);
            const unsigned tg = og / nx;
            if (og + 1u == (tg + 1u) * nx) xb_add(&bar[XB_TOPGEN], 1u);
            else XB_SPIN(xb_ld(&bar[XB_TOPGEN]) == tg, bar);
            __builtin_amdgcn_fence(__ATOMIC_ACQUIRE, "agent");
            xb_add(&bar[XB_XGEN(b.x)], 1u);
            asm volatile("s_waitcnt vmcnt(0)" ::: "memory");
        } else {
            XB_SPIN(xb_ld(&bar[XB_XGEN(b.x)]) == gen, bar);
            __builtin_amdgcn_fence(__ATOMIC_ACQUIRE, "agent");
            asm volatile("s_waitcnt vmcnt(0)" ::: "memory");
        }
    }
    __syncthreads();
}

constexpr size_t OFF_BAR = (size_t)520 << 20;

constexpr int STEPS = 13, NPH = 1 + 4 * STEPS;

__global__ void __launch_bounds__(512, 2) mega(Params p) {
    extern __shared__ __attribute__((aligned(16))) unsigned char shm[];
    LAS unsigned char* lds = (LAS unsigned char*)shm;
    cg::grid_group grid = cg::this_grid();
    __shared__ uint4 xb_words;
    if (threadIdx.x == 0) xb_words = make_uint4(0u, 0u, 0u, 0u);
    __syncthreads();
    if (p.ph_end - p.ph_begin > 1) (void)xcd_barrier_post((unsigned*)(p.ws + OFF_BAR), (volatile LAS unsigned*)&xb_words);
    bf16_t* hbuf = (bf16_t*)(p.ws + OFF_H);
    float* mod = (float*)(p.ws + OFF_MOD);
    bool first = true;
    for (int ph = p.ph_begin; ph < p.ph_end; ++ph) {
        int l = 0, s = -1;
        if (ph > 0) { l = (ph - 1) / STEPS; s = (ph - 1) % STEPS; }
        const bool odd = (l & 1) != 0; const int j = l >> 1;
        if (odd && (s == 7 || s == 8 || s == 9)) continue;
        if (s == 3 || s == 7 || s == 10 || (s == 0 && l > 0)) continue;
        if (!first) { if (ph == 1) grid.sync(); else { XcdBarrier xb; xb.bar = (unsigned*)(p.ws + OFF_BAR); xb.x = xb_xcc_id(); xb.st = (volatile LAS unsigned*)&xb_words; xcd_barrier(xb); } }
        first = false;
        const int bid = obid(), G = ogrid();
        if (ph == 0) { prologue_phase(p, lds); continue; }
        switch (s) {
            case 0: prologue_b(p, lds); break;
            case 1: {
                pg8::Gemm g{hbuf, (const bf16_t*)(p.ws + OFF_WGU1) + (size_t)l * 5632 * 1024, T_ALL, 5632, 1024};
                pg8::StaticOrder S; S.init(g.M, g.N, G, bid);
                EpiSwiGLU E{(bf16_t*)(p.ws + OFF_ACT), (const float*)(p.ws + OFF_RSP), (const float*)(p.ws + OFF_BIAS) + (size_t)(l * 3 + 0) * 9 * 5632};
                pg8::gemm_phase(lds, g, S, E);
                if (l < 3) {
                    if (G == 256) { if (bid >= 128) transpose_layer(p, lds, l + 1, bid - 128, 128); }
                    else transpose_layer(p, lds, l + 1, bid, G);
                }
            } break;
            case 11: {
                pg8::Gemm g{hbuf, (const bf16_t*)(p.ws + OFF_WGU2) + (size_t)l * 5632 * 1024, T_ALL, 5632, 1024};
                pg8::StaticOrder S; S.init(g.M, g.N, G, bid);
                EpiSwiGLU E{(bf16_t*)(p.ws + OFF_ACT), (const float*)(p.ws + OFF_RSP), (const float*)(p.ws + OFF_BIAS) + (size_t)(l * 3 + 2) * 9 * 5632};
                pg8::gemm_phase(lds, g, S, E);
                if (l < 3) {
                    const int b0 = l == 0 ? 106 : (l == 1 ? 226 : 332), b1 = l == 0 ? 226 : (l == 1 ? 332 : 452);
                    if (G == 256) { if (bid >= 128) bias_items(p, lds, b0 + (bid - 128), b1, 128); }
                    else bias_items(p, lds, b0 + bid, b1, G);
                }
            } break;
            case 2: {
                pg8::Gemm g{(const bf16_t*)(p.ws + OFF_ACT), (const bf16_t*)(p.ws + OFF_WD1) + (size_t)l * 1024 * 2816, T_ALL, 1024, 2816};
                EpiResid E{p, l, 2};
                pg8::StaticOrder S; S.init(g.M, g.N, G, bid);
                pg8::gemm_phase(lds, g, S, E);
            } break;
            case 12: {
                pg8::Gemm g{(const bf16_t*)(p.ws + OFF_ACT), (const bf16_t*)(p.ws + OFF_WD2) + (size_t)l * 1024 * 2816, T_ALL, 1024, 2816};
                EpiResid E{p, l, 11};
                pg8::StaticOrder S; S.init(g.M, g.N, G, bid);
                pg8::gemm_phase(lds, g, S, E);
            } break;
            case 6: {
                if (!odd) {
                    {
                        pg8::Gemm g{(const bf16_t*)(p.ws + OFF_CQN), (const bf16_t*)(p.ws + OFF_WQB) + (size_t)j * 768 * 384, T_ALL, 768, 384};
                        EpiBf16 E{(bf16_t*)(p.ws + OFF_QRAW), 768, nullptr, nullptr};
                        pg8::StaticOrder S; S.init(g.M, g.N, G, bid);
                        pg8::gemm_phase(lds, g, S, E);
                    }
                    {
                        pg8::Gemm g{(const bf16_t*)(p.ws + OFF_CKVN), (const bf16_t*)(p.ws + OFF_WKVB) + (size_t)j * 1024 * 256, T_KV, 1024, 256};
                        EpiBf16 E{(bf16_t*)(p.ws + OFF_KVRAW), 1024, nullptr, nullptr};
                        pg8::StaticOrder S; S.init(g.M, g.N, G, (bid + G - (192 % G)) % G);
                        pg8::gemm_phase(lds, g, S, E);
                        Unit uu;
                        for (int i = 0; S.next(i, uu); ++i)
                            for (int q = 0; q < 8; ++q) kprep_tile(p, lds, j, ((uu.pm * 4 + (q >> 1)) << 3) | (uu.pn * 2 + (q & 1)));
                    }
                } else {
                    pg8::Gemm g{(const bf16_t*)(p.ws + OFF_GATED), (const bf16_t*)(p.ws + OFF_WOUTO) + (size_t)j * 1024 * 2048, T_ALL, 1024, 2048};
                    EpiResid E{p, l, 6};
                    pg8::StaticOrder S; S.init(g.M, g.N, G, bid);
                    pg8::gemm_phase(lds, g, S, E);
                }
            } break;
            case 9: {
                pg8::Gemm g{(const bf16_t*)(p.ws + OFF_CAT), (const bf16_t*)(p.ws + OFF_WOUTE) + (size_t)j * 1024 * 1024, T_ALL, 1024, 1024};
                EpiResid E{p, l, 8};
                pg8::StaticOrder S; S.init(g.M, g.N, G, bid);
                pg8::gemm_phase(lds, g, S, E);
            } break;
            case 4: {
                if (!odd) {
                    pg8::Gemm g{hbuf, (const bf16_t*)(p.ws + OFF_WINE) + (size_t)j * 2304 * 1024, T_ALL, 2304, 1024};
                    pg8::StaticOrder S; S.init(g.M, g.N, G, bid);
                    EpiBf16 E{(bf16_t*)(p.ws + OFF_PROJ), PROJ_LD, (const float*)(p.ws + OFF_RSP), (const float*)(p.ws + OFF_BIAS) + (size_t)(l * 3 + 1) * 9 * 5632};
                    pg8::gemm_phase(lds, g, S, E);
                } else {
                    pg8::Gemm g{hbuf, (const bf16_t*)(p.ws + OFF_WINO) + (size_t)j * 4096 * 1024, T_ALL, 4096, 1024};
                    pg8::StaticOrder S; S.init(g.M, g.N, G, bid);
                    EpiGeluUV E{(bf16_t*)(p.ws + OFF_UV), (float*)(p.ws + OFF_SSP), (const float*)(p.ws + OFF_RSP), (const float*)(p.ws + OFF_BIAS) + (size_t)(l * 3 + 1) * 9 * 5632};
                    pg8::gemm_phase(lds, g, S, E);
                }
            } break;
            case 5: {
                if (!odd) even2_phase(p, lds, j);
                else for (int t = bid; t < 2048; t += G) spatial_tile(p, lds, j, t);
            } break;
            case 7: {
                for (int t = bid; t < 2304; t += G) kprep_tile(p, lds, j, t);
            } break;
            case 8: {
                if (G == 256) {
                    const int xcd = bid & 7, slot = bid >> 3;
                    const int bh = xcd * 8 + (slot >> 2);
                    for (int r = 0; r < 2; ++r) { attn_tile(p, lds, j, bh * 8 + (slot & 3) * 2 + r); __syncthreads(); }
                    const int bhc = xcd * 32 + slot;
                    for (int r = 0; r < 2; ++r) { attn_tile(p, lds, j, 512 + bhc * 2 + r); __syncthreads(); }
                } else {
                    for (int t = bid; t < 1024; t += G) { attn_tile(p, lds, j, t); __syncthreads(); }
                }
                gla_finish_rows(p, j);
            } break;
            default: break;
        }
    }
}


extern "C" void kernel_launch(void* const* d_in, const int* in_sizes, int n_in, void* d_out, int out_size, void* d_ws, size_t ws_size, hipStream_t stream) {
    constexpr size_t kDynLds = 131072;
    static int grid_blocks = 0;
    if (!grid_blocks) {
        hipFuncSetAttribute((const void*)mega, hipFuncAttributeMaxDynamicSharedMemorySize, (int)kDynLds);
        int dev = 0, cus = 0, per_cu = 0;
        hipGetDevice(&dev);
        hipDeviceGetAttribute(&cus, hipDeviceAttributeMultiprocessorCount, dev);
        hipOccupancyMaxActiveBlocksPerMultiprocessor(&per_cu, mega, 512, kDynLds);
        if (per_cu < 1) per_cu = 1;
        if (per_cu > 1) per_cu = 1;
        grid_blocks = cus * per_cu;
    }
    Params p{};
    for (int i = 0; i < 32; ++i) p.in[i] = (const float*)d_in[i];
    p.out = (float*)d_out; p.ws = (unsigned char*)d_ws; p.ph_begin = 0; p.ph_end = NPH;
    hipMemsetAsync((unsigned char*)d_ws + OFF_BAR, 0, XCD_BAR_WORDS * sizeof(unsigned), stream);
    void* args[] = {&p};
    hipError_t e = hipLaunchCooperativeKernel((void*)mega, dim3(grid_blocks), dim3(512), args, kDynLds, stream);
    if (e != hipSuccess) fprintf(stderr, "cooperative launch failed: %s (grid %d)\n", hipGetErrorString(e), grid_blocks);
}
```

```cpp
#include <hip/hip_runtime.h>
#include <hip/hip_cooperative_groups.h>
#include <cstdio>
namespace cg = cooperative_groups;

#define LAS __attribute__((address_space(3)))
typedef unsigned short bf16_t;
typedef short bf16x8 __attribute__((ext_vector_type(8)));
typedef short bf16x4 __attribute__((ext_vector_type(4)));
typedef float f32x4 __attribute__((ext_vector_type(4)));
typedef float f32x2 __attribute__((ext_vector_type(2)));
typedef unsigned u32x4 __attribute__((ext_vector_type(4)));
typedef unsigned u32x2 __attribute__((ext_vector_type(2)));

constexpr int T_CTX = 8192, T_ALL = 16384, T_KV = 18432;
constexpr int PROJ_LD = 2304;
constexpr float EPS = 1e-6f;


constexpr size_t SZ_WGU = (size_t)4 * 5632 * 1024 * 2, SZ_WD = (size_t)4 * 1024 * 2816 * 2;
constexpr size_t OFF_WGU1 = 0;
constexpr size_t OFF_WD1 = OFF_WGU1 + SZ_WGU;
constexpr size_t OFF_WGU2 = OFF_WD1 + SZ_WD;
constexpr size_t OFF_WD2 = OFF_WGU2 + SZ_WGU;
constexpr size_t OFF_WINE = OFF_WD2 + SZ_WD;
constexpr size_t OFF_WOUTE = OFF_WINE + (size_t)2 * 2304 * 1024 * 2;
constexpr size_t OFF_WQB = OFF_WOUTE + (size_t)2 * 1024 * 1024 * 2;
constexpr size_t OFF_WKVB = OFF_WQB + (size_t)2 * 768 * 384 * 2;
constexpr size_t OFF_WINO = OFF_WKVB + (size_t)2 * 1024 * 256 * 2;
constexpr size_t OFF_WOUTO = OFF_WINO + (size_t)2 * 4096 * 1024 * 2;
constexpr size_t OFF_WS = OFF_WOUTO + (size_t)2 * 1024 * 2048 * 2;
constexpr size_t OFF_MOD = OFF_WS + (size_t)2 * 4 * 128 * 128 * 2;
constexpr size_t OFF_H = OFF_MOD + (size_t)4 * 9 * 9216 * 4;
constexpr size_t OFF_U = OFF_H + (size_t)T_ALL * 1024 * 2;
constexpr size_t OFF_ACT = OFF_U;
constexpr size_t OFF_PROJ = OFF_U;
constexpr size_t OFF_CQN = OFF_PROJ + (size_t)T_ALL * PROJ_LD * 2;
constexpr size_t OFF_CKVN = OFF_CQN + (size_t)T_ALL * 384 * 2;
constexpr size_t OFF_QRAW = OFF_CKVN + (size_t)T_KV * 256 * 2;
constexpr size_t OFF_KVRAW = OFF_QRAW + (size_t)T_ALL * 768 * 2;
constexpr size_t OFF_OF = OFF_KVRAW + (size_t)T_KV * 1024 * 2;
constexpr size_t OFF_OB = OFF_OF + (size_t)T_ALL * 512 * 4;
constexpr size_t OFF_CAT = OFF_OB + (size_t)T_ALL * 512 * 4;
constexpr size_t OFF_UV = OFF_U;
constexpr size_t OFF_GATED = OFF_UV + (size_t)T_ALL * 4096 * 2;
constexpr size_t OFF_SSP = OFF_GATED + (size_t)T_ALL * 2048 * 2;

constexpr size_t OFF_BIAS = (size_t)522 << 20;
constexpr size_t OFF_RSP = (size_t)526 << 20;
constexpr size_t OFF_KN = (size_t)456 << 20;
constexpr size_t OFF_VT = (size_t)484 << 20;
constexpr size_t VT_LAT = (size_t)32 * 8 * 64 * 256;
constexpr size_t OUT_CKV = 16777216, OUT_KROPE = 20971520, OUT_GLA = 21495808;

struct Params {
    const float* in[32];
    float* out;
    unsigned char* ws;
    int ph_begin, ph_end;
};

__device__ __forceinline__ int otid() { int t = threadIdx.x; asm volatile("" : "+v"(t)); return t; }
__device__ __forceinline__ int obid() { int t = blockIdx.x; asm volatile("" : "+s"(t)); return t; }
__device__ __forceinline__ int ogrid() { int t = gridDim.x; asm volatile("" : "+s"(t)); return t; }
__device__ __forceinline__ const float* pin(const Params& p, int i) { asm volatile("" : "+s"(i)); return p.in[i]; }
typedef __bf16 bf16x2_t __attribute__((ext_vector_type(2)));
__device__ __forceinline__ unsigned cvt_pk_bf16(float lo, float hi) { const f32x2 v = {lo, hi}; return __builtin_bit_cast(unsigned, __builtin_convertvector(v, bf16x2_t)); }
__device__ __forceinline__ unsigned pack_bf16_sw(float lo, float hi) {
    unsigned a = __float_as_uint(lo), b = __float_as_uint(hi);
    a += 0x7fffu + ((a >> 16) & 1u); b += 0x7fffu + ((b >> 16) & 1u);
    return (a >> 16) | (b & 0xffff0000u);
}
__device__ __forceinline__ bf16_t f2bf(float f) { return (bf16_t)(cvt_pk_bf16(f, 0.f) & 0xffffu); }
__device__ __forceinline__ float bf2f(bf16_t b) { return __uint_as_float(((unsigned)b) << 16); }
__device__ __forceinline__ float bflo(unsigned w) { return __uint_as_float(w << 16); }
__device__ __forceinline__ float bfhi(unsigned w) { return __uint_as_float(w & 0xffff0000u); }
__device__ __forceinline__ float silu_f(float x) { return x * __builtin_amdgcn_rcpf(1.f + __expf(-x)); }
__device__ __forceinline__ float gelu_tanh_f(float x) { const float u = 1.5957691216f * (x + 0.044715f * x * x * x); return x * __builtin_amdgcn_rcpf(1.f + __expf(-u)); }
__device__ __forceinline__ float wave_sum(float v) {
    v += __shfl_xor(v, 1); v += __shfl_xor(v, 2); v += __shfl_xor(v, 4); v += __shfl_xor(v, 8); v += __shfl_xor(v, 16); v += __shfl_xor(v, 32); return v; }

namespace pg8 {
constexpr int BM = 256, BK = 64, HALF = 128, HTB = HALF * BK * 2, STAGE_BYTES = 8 * HTB, NXCD = 8, WGM = 8;
__device__ __forceinline__ int lds_byte(int r, int c) { const int st = (r >> 4) * 2 + (c >> 5), rr = r & 15, cc = c & 31, ob = rr * 64 + cc * 2; return st * 1024 + (ob ^ (((ob >> 9) & 1) << 5)); }
__device__ __forceinline__ void stage_rc(int b, int& R, int& C) { const int st = b / 1024, sb = b % 1024, swz = sb ^ (((sb >> 9) & 1) << 5); R = (st >> 1) * 16 + swz / 64; C = (st & 1) * 32 + (swz % 64) / 2; }
__device__ __forceinline__ int perm32(int rho) { const int n = rho >> 4, i = rho & 15; return 8 * (i >> 2) + 4 * n + (i & 3); }
struct Unit { int pm, pn; };
struct Gemm { const bf16_t* A; const bf16_t* Bt; int M, N, K; };
struct StaticOrder {
    int nM, nN, nwg, G, c;
    __device__ void init(int M, int N, int G_, int c_) { nM = M / BM; nN = N / BM; nwg = nM * nN; G = G_; c = c_; }
    __device__ bool next(int i, Unit& u) const {
        const long L = (long)i * G + c; if (L >= nwg) return false;
        int wgid = (int)L; { const int q = nwg / NXCD, r = nwg % NXCD, xcd = wgid % NXCD, off = wgid / NXCD; wgid = (xcd < r ? xcd * (q + 1) : r * (q + 1) + (xcd - r) * q) + off; }
        const int nig = WGM * nN, gid = wgid / nig, fm = gid * WGM, gsz = (nM - fm) < WGM ? (nM - fm) : WGM;
        u.pm = fm + ((wgid % nig) % gsz); u.pn = (wgid % nig) / gsz; return true;
    }
};

template <class Epi>
__device__ __forceinline__ void gemm_phase(LAS unsigned char* lds, const Gemm g, const StaticOrder& S, const Epi& E) {
    const int tid = otid(), wid = __builtin_amdgcn_readfirstlane(tid >> 6), lane = tid & 63, wr = wid >> 2, wc = wid & 3, fr = lane & 15, fq = lane >> 4;
    const int K = g.K, nt = K / BK;
    unsigned voffA[2], voffB[2];
#pragma unroll
    for (int i = 0; i < 2; ++i) { int R, C; stage_rc(tid * 16 + i * 8192, R, C); const int Rb = Epi::PERM ? ((R & ~31) + perm32(R & 31)) : R;
        voffA[i] = (unsigned)(R * K + C) * 2u; voffB[i] = (unsigned)(Rb * K + C) * 2u; }
    const size_t kstep = (size_t)(BK * 2);
    const size_t hstep = (size_t)HALF * K * 2;
    const size_t tstep = 2 * hstep;
    const unsigned ldsw = (unsigned)wid * 1024u;
    const int aoff = lds_byte(wr * 64 + fr, fq * 8), boff = lds_byte(wc * 32 + fr, fq * 8);
#define PG8_SA(b, h) (((b) * 2 + (h)) * HTB)
#define PG8_SB(b, h) ((4 + (b) * 2 + (h)) * HTB)
#define PG8_STAGE(bufoff, gbase, voff) do { _Pragma("unroll") for (int _i = 0; _i < 2; ++_i) \
        __builtin_amdgcn_global_load_lds((const unsigned*)((const char*)(gbase) + (voff)[_i]), (LAS unsigned*)(lds + (bufoff) + ldsw + _i * 8192), 16, 0, 0); } while (0)
#define PG8_LDA(dst, b, h) do { _Pragma("unroll") for (int m = 0; m < 4; ++m) _Pragma("unroll") for (int k = 0; k < 2; ++k) dst[m][k] = *(const LAS bf16x8*)(lds + PG8_SA(b, h) + aoff + m * 2048 + k * 1024); } while (0)
#define PG8_LDB(dst, b, h) do { _Pragma("unroll") for (int n = 0; n < 2; ++n) _Pragma("unroll") for (int k = 0; k < 2; ++k) dst[n][k] = *(const LAS bf16x8*)(lds + PG8_SB(b, h) + boff + n * 2048 + k * 1024); } while (0)
#define PG8_MMA(ai, bj, At, Bt) do { __builtin_amdgcn_s_setprio(1); _Pragma("unroll") for (int m = 0; m < 4; ++m) _Pragma("unroll") for (int n = 0; n < 2; ++n) _Pragma("unroll") for (int k = 0; k < 2; ++k) \
        acc[ai][bj][m][n] = __builtin_amdgcn_mfma_f32_16x16x32_bf16(Bt[n][k], At[m][k], acc[ai][bj][m][n], 0, 0, 0); __builtin_amdgcn_s_setprio(0); } while (0)
#define PG8_WAIT_V(n) asm volatile("s_waitcnt vmcnt(" #n ")" ::: "memory")
#define PG8_WAIT_L(n) asm volatile("s_waitcnt lgkmcnt(" #n ")" ::: "memory")
#define PG8_BAR __builtin_amdgcn_s_barrier()
#define PG8_SCHED __builtin_amdgcn_sched_barrier(0)
    Unit cur, nxt; int ui = 0;
    if (!S.next(0, cur)) return;
    f32x4 acc[2][2][4][2];
#pragma unroll
    for (int a = 0; a < 2; ++a)
#pragma unroll
        for (int b = 0; b < 2; ++b)
#pragma unroll
            for (int m = 0; m < 4; ++m)
#pragma unroll
                for (int n = 0; n < 2; ++n) acc[a][b][m][n] = (f32x4){0.f, 0.f, 0.f, 0.f};
    bf16x8 At[4][2], B0[2][2], B1[2][2];
    const char* cA = (const char*)g.A + (size_t)cur.pm * tstep; const char* cB = (const char*)g.Bt + (size_t)cur.pn * tstep;
    PG8_STAGE(PG8_SB(0, 0), cB, voffB); PG8_STAGE(PG8_SA(0, 0), cA, voffA); PG8_STAGE(PG8_SB(0, 1), cB + hstep, voffB); PG8_STAGE(PG8_SA(0, 1), cA + hstep, voffA);
    if (wr == 1) PG8_BAR;
    PG8_WAIT_V(4); PG8_BAR;
    PG8_STAGE(PG8_SB(1, 0), cB + kstep, voffB); PG8_STAGE(PG8_SA(1, 0), cA + kstep, voffA); PG8_STAGE(PG8_SB(1, 1), cB + hstep + kstep, voffB);
    PG8_WAIT_V(6); PG8_BAR;
    for (;;) {
        const bool has_next = S.next(ui + 1, nxt);
        const char* nA = has_next ? (const char*)g.A + (size_t)nxt.pm * tstep : cA; const char* nB = has_next ? (const char*)g.Bt + (size_t)nxt.pn * tstep : cB;
        for (int t = 0; t < nt; t += 2) {
            const bool last = (t == nt - 2);
            const char* a1 = cA + (size_t)(t + 1) * kstep;
            const char* a2 = last ? nA : cA + (size_t)(t + 2) * kstep; const char* b2 = last ? nB : cB + (size_t)(t + 2) * kstep;
            const char* a3 = a2 + kstep; const char* b3 = b2 + kstep;
            PG8_LDB(B0, 0, 0); PG8_SCHED; PG8_LDA(At, 0, 0); PG8_STAGE(PG8_SA(1, 1), a1 + hstep, voffA);
            PG8_WAIT_L(8); PG8_BAR; PG8_WAIT_L(0); PG8_MMA(0, 0, At, B0); PG8_BAR; PG8_SCHED;
            PG8_LDB(B1, 0, 1); PG8_STAGE(PG8_SB(0, 0), b2, voffB);
            PG8_BAR; PG8_WAIT_L(0); PG8_MMA(0, 1, At, B1); PG8_BAR;
            PG8_LDA(At, 0, 1); PG8_STAGE(PG8_SA(0, 0), a2, voffA);
            PG8_BAR; PG8_WAIT_L(0); PG8_MMA(1, 0, At, B0); PG8_BAR; PG8_SCHED;
            PG8_STAGE(PG8_SB(0, 1), b2 + hstep, voffB);
            PG8_WAIT_V(6); PG8_BAR; PG8_MMA(1, 1, At, B1); PG8_BAR;
            PG8_LDB(B0, 1, 0); PG8_SCHED; PG8_LDA(At, 1, 0); PG8_STAGE(PG8_SA(0, 1), a2 + hstep, voffA);
            PG8_WAIT_L(8); PG8_BAR; PG8_WAIT_L(0); PG8_MMA(0, 0, At, B0); PG8_BAR; PG8_SCHED;
            PG8_LDB(B1, 1, 1); PG8_STAGE(PG8_SB(1, 0), b3, voffB);
            PG8_BAR; PG8_WAIT_L(0); PG8_MMA(0, 1, At, B1); PG8_BAR;
            PG8_LDA(At, 1, 1); PG8_STAGE(PG8_SA(1, 0), a3, voffA);
            PG8_BAR; PG8_WAIT_L(0); PG8_MMA(1, 0, At, B0); PG8_BAR; PG8_SCHED;
            PG8_STAGE(PG8_SB(1, 1), b3 + hstep, voffB);
            PG8_WAIT_V(6); PG8_BAR; PG8_MMA(1, 1, At, B1); PG8_BAR;
        }
        E(acc, cur, wr, wc, fr, fq);
        if (!has_next) break;
#pragma unroll
        for (int a = 0; a < 2; ++a)
#pragma unroll
            for (int b = 0; b < 2; ++b)
#pragma unroll
                for (int m = 0; m < 4; ++m)
#pragma unroll
                    for (int n = 0; n < 2; ++n) acc[a][b][m][n] = (f32x4){0.f, 0.f, 0.f, 0.f};
        cur = nxt; cA = nA; cB = nB; ++ui;
    }
    PG8_WAIT_V(0);
    if (wr == 0) PG8_BAR;
    PG8_BAR;
#undef PG8_SA
#undef PG8_SB
#undef PG8_STAGE
#undef PG8_LDA
#undef PG8_LDB
#undef PG8_MMA
#undef PG8_WAIT_V
#undef PG8_WAIT_L
#undef PG8_BAR
#undef PG8_SCHED
}
}
using pg8::Unit;


struct Rstd8 { float v[2][4]; };
__device__ __forceinline__ Rstd8 load_rstd8(const float* rsp, int row0, int fq) {
    f32x4 pv[2][4]; Rstd8 r;
#pragma unroll
    for (int ai = 0; ai < 2; ++ai)
#pragma unroll
        for (int m = 0; m < 4; ++m) pv[ai][m] = *(const f32x4*)(rsp + (size_t)(row0 + ai * 128 + m * 16) * 16 + fq * 4);
#pragma unroll
    for (int ai = 0; ai < 2; ++ai)
#pragma unroll
        for (int m = 0; m < 4; ++m) {
            float t = pv[ai][m][0] + pv[ai][m][1] + pv[ai][m][2] + pv[ai][m][3];
            t += __shfl_xor(t, 16); t += __shfl_xor(t, 32);
            r.v[ai][m] = rsqrtf(t * (1.f / 1024.f) + EPS);
        }
    return r;
}
struct EpiSwiGLU {
    static constexpr bool PERM = true;
    bf16_t* O; const float* rsp; const float* bias;
    __device__ __forceinline__ void operator()(const f32x4 (&acc)[2][2][4][2], const Unit& u, int wr, int wc, int fr, int fq) const {
        const int cond = u.pm < 32 ? 0 : 1 + ((u.pm - 32) >> 2);
        const int row0 = u.pm * 256 + wr * 64 + fr, col0 = u.pn * 128 + wc * 32 + 8 * fq;
        const Rstd8 R = load_rstd8(rsp, row0, fq);
        const float* bp = bias + (size_t)cond * 5632 + u.pn * 256 + wc * 32 + 8 * fq;
        const f32x4 bg0 = *(const f32x4*)bp, bg1 = *(const f32x4*)(bp + 4), bu0 = *(const f32x4*)(bp + 128), bu1 = *(const f32x4*)(bp + 132);
#pragma unroll
        for (int ai = 0; ai < 2; ++ai)
#pragma unroll
            for (int m = 0; m < 4; ++m) {
                bf16_t* rowp = O + (size_t)(row0 + ai * 128 + m * 16) * 2816 + col0;
                const float rs = R.v[ai][m];
                f32x4 v0, v1;
#pragma unroll
                for (int j = 0; j < 4; ++j) {
                    v0[j] = silu_f(acc[ai][0][m][0][j] * rs + bg0[j]) * (acc[ai][1][m][0][j] * rs + bu0[j]);
                    v1[j] = silu_f(acc[ai][0][m][1][j] * rs + bg1[j]) * (acc[ai][1][m][1][j] * rs + bu1[j]);
                }
                u32x4 w; w.x = cvt_pk_bf16(v0[0], v0[1]); w.y = cvt_pk_bf16(v0[2], v0[3]); w.z = cvt_pk_bf16(v1[0], v1[1]); w.w = cvt_pk_bf16(v1[2], v1[3]);
                *(u32x4*)rowp = w;
            }
    }
};
struct EpiResid {
    static constexpr bool PERM = false;
    const Params& p; int l; int kind;
    __device__ __forceinline__ void operator()(const f32x4 (&acc)[2][2][4][2], const Unit& u, int wr, int wc, int fr, int fq) const {
        float* X = p.out; const float* mod = (const float*)(p.ws + OFF_MOD);
        const int gidx = kind == 2 ? 2 : (kind == 11 ? 8 : 5);
        const float coef = (kind == 2 || kind == 11) ? 0.5f : 1.0f;
        const float* gate = mod + (size_t)l * 9 * 9216 + gidx * 1024;
        const bool nn = !(kind == 11 && l == 3);
        const int nl = kind == 11 ? (l < 3 ? l + 1 : l) : l, ns = kind == 2 ? 1 : (kind == 11 ? 0 : 2);
        const float* ng = pin(p, 9) + (size_t)(nl * 3 + ns) * 1024;
        const float* msc = mod + (size_t)nl * 9 * 9216 + (size_t)(3 * ns + 1) * 1024;
        bf16_t* H = (bf16_t*)(p.ws + OFF_H); float* rsp = (float*)(p.ws + OFF_RSP);
        const int cond = u.pm < 32 ? 0 : 1 + ((u.pm - 32) >> 2);
        const float* gp = gate + (size_t)cond * 9216;
        const int row0 = u.pm * 256 + wr * 64 + fr, col0 = u.pn * 256 + wc * 32 + 4 * fq;
        f32x4 gv[2][2], gs[2][2];
#pragma unroll
        for (int bj = 0; bj < 2; ++bj)
#pragma unroll
            for (int n = 0; n < 2; ++n) {
                gv[bj][n] = *(const f32x4*)(gp + col0 + bj * 128 + n * 16) * coef;
                gs[bj][n] = (f32x4){0.f, 0.f, 0.f, 0.f};
                if (nn) gs[bj][n] = *(const f32x4*)(ng + col0 + bj * 128 + n * 16) * (*(const f32x4*)(msc + (size_t)cond * 9216 + col0 + bj * 128 + n * 16) + 1.f);
            }
#pragma unroll
        for (int ai = 0; ai < 2; ++ai)
#pragma unroll
            for (int mp = 0; mp < 2; ++mp) {
                f32x4 xv[2][2][2];
#pragma unroll
                for (int mi = 0; mi < 2; ++mi)
#pragma unroll
                    for (int bj = 0; bj < 2; ++bj)
#pragma unroll
                        for (int n = 0; n < 2; ++n) xv[mi][bj][n] = *(const f32x4*)(X + (size_t)(row0 + ai * 128 + (mp * 2 + mi) * 16) * 1024 + col0 + bj * 128 + n * 16);
#pragma unroll
                for (int mi = 0; mi < 2; ++mi) {
                    const int m = mp * 2 + mi;
                    const int row = row0 + ai * 128 + m * 16;
                    float* rowp = X + (size_t)row * 1024 + col0;
                    float ss = 0.f;
#pragma unroll
                    for (int bj = 0; bj < 2; ++bj)
#pragma unroll
                        for (int n = 0; n < 2; ++n) {
                            const f32x4 xn = xv[mi][bj][n] + gv[bj][n] * acc[ai][bj][m][n];
                            *(f32x4*)(rowp + bj * 128 + n * 16) = xn;
                            if (nn) {
                                ss += xn[0] * xn[0] + xn[1] * xn[1] + xn[2] * xn[2] + xn[3] * xn[3];
                                const f32x4 hv = xn * gs[bj][n];
                                u32x2 w; w.x = cvt_pk_bf16(hv[0], hv[1]); w.y = cvt_pk_bf16(hv[2], hv[3]);
                                *(u32x2*)(H + (size_t)row * 1024 + col0 + bj * 128 + n * 16) = w;
                            }
                        }
                    if (nn) { ss += __shfl_xor(ss, 16); ss += __shfl_xor(ss, 32); if (fq == 0) rsp[(size_t)row * 16 + u.pn * 4 + wc] = ss; }
                }
            }
    }
};
struct EpiBf16 {
    static constexpr bool PERM = true;
    bf16_t* O; int ldc; const float* rsp; const float* bias;
    __device__ __forceinline__ void operator()(const f32x4 (&acc)[2][2][4][2], const Unit& u, int wr, int wc, int fr, int fq) const {
        const int row0 = u.pm * 256 + wr * 64 + fr, col0 = u.pn * 256 + wc * 32 + 8 * fq;
        const bool nn = rsp != nullptr;
        f32x4 b0[2], b1[2]; Rstd8 R;
#pragma unroll
        for (int bj = 0; bj < 2; ++bj) { b0[bj] = (f32x4){0.f, 0.f, 0.f, 0.f}; b1[bj] = b0[bj]; }
#pragma unroll
        for (int ai = 0; ai < 2; ++ai)
#pragma unroll
            for (int m = 0; m < 4; ++m) R.v[ai][m] = 1.f;
        if (nn) {
            const int cond = u.pm < 32 ? 0 : 1 + ((u.pm - 32) >> 2);
            R = load_rstd8(rsp, row0, fq);
#pragma unroll
            for (int bj = 0; bj < 2; ++bj) { const float* bp = bias + (size_t)cond * 5632 + col0 + bj * 128; b0[bj] = *(const f32x4*)bp; b1[bj] = *(const f32x4*)(bp + 4); }
        }
#pragma unroll
        for (int ai = 0; ai < 2; ++ai)
#pragma unroll
            for (int m = 0; m < 4; ++m) {
                bf16_t* rowp = O + (size_t)(row0 + ai * 128 + m * 16) * ldc + col0;
                const float rs = R.v[ai][m];
#pragma unroll
                for (int bj = 0; bj < 2; ++bj) {
                    const f32x4 v0 = acc[ai][bj][m][0] * rs + b0[bj], v1 = acc[ai][bj][m][1] * rs + b1[bj];
                    u32x4 w; w.x = cvt_pk_bf16(v0[0], v0[1]); w.y = cvt_pk_bf16(v0[2], v0[3]); w.z = cvt_pk_bf16(v1[0], v1[1]); w.w = cvt_pk_bf16(v1[2], v1[3]);
                    *(u32x4*)(rowp + bj * 128) = w;
                }
            }
    }
};
struct EpiGeluUV {
    static constexpr bool PERM = true;
    bf16_t* O; float* ssp; const float* rsp; const float* bias;
    __device__ __forceinline__ void operator()(const f32x4 (&acc)[2][2][4][2], const Unit& u, int wr, int wc, int fr, int fq) const {
        const int cond = u.pm < 32 ? 0 : 1 + ((u.pm - 32) >> 2);
        const int row0 = u.pm * 256 + wr * 64 + fr, col0 = u.pn * 256 + wc * 32 + 8 * fq;
        const Rstd8 R = load_rstd8(rsp, row0, fq);
        f32x4 b0[2], b1[2];
#pragma unroll
        for (int bj = 0; bj < 2; ++bj) { const float* bp = bias + (size_t)cond * 5632 + col0 + bj * 128; b0[bj] = *(const f32x4*)bp; b1[bj] = *(const f32x4*)(bp + 4); }
#pragma unroll
        for (int ai = 0; ai < 2; ++ai)
#pragma unroll
            for (int m = 0; m < 4; ++m) {
                const int row = row0 + ai * 128 + m * 16;
                bf16_t* rowp = O + (size_t)row * 4096 + col0;
                const float rs = R.v[ai][m];
                float ss = 0.f;
#pragma unroll
                for (int bj = 0; bj < 2; ++bj) {
                    f32x4 v0, v1;
#pragma unroll
                    for (int j = 0; j < 4; ++j) { v0[j] = gelu_tanh_f(acc[ai][bj][m][0][j] * rs + b0[bj][j]); v1[j] = gelu_tanh_f(acc[ai][bj][m][1][j] * rs + b1[bj][j]); ss += v0[j] * v0[j] + v1[j] * v1[j]; }
                    u32x4 w; w.x = cvt_pk_bf16(v0[0], v0[1]); w.y = cvt_pk_bf16(v0[2], v0[3]); w.z = cvt_pk_bf16(v1[0], v1[1]); w.w = cvt_pk_bf16(v1[2], v1[3]);
                    *(u32x4*)(rowp + bj * 128) = w;
                }
                if (u.pn >= 8) { ss += __shfl_xor(ss, 16); ss += __shfl_xor(ss, 32); if (fq == 0) ssp[(size_t)row * 32 + (u.pn - 8) * 4 + wc] = ss; }
            }
    }
};

struct TJob { int src; int batch, K, N; unsigned long long dst; int rows_pb, blk, blk_stride, off; };
__device__ const TJob g_jobs[12] = {
    {10, 4, 1024, 2816, OFF_WGU1, 5632, 128, 256, 0},
    {11, 4, 1024, 2816, OFF_WGU1, 5632, 128, 256, 128},
    {12, 4, 2816, 1024, OFF_WD1, 1024, 1024, 1024, 0},
    {13, 4, 1024, 2816, OFF_WGU2, 5632, 128, 256, 0},
    {14, 4, 1024, 2816, OFF_WGU2, 5632, 128, 256, 128},
    {15, 4, 2816, 1024, OFF_WD2, 1024, 1024, 1024, 0},
    {16, 2, 1024, 2240, OFF_WINE, 2304, 4096, 4096, 0},
    {17, 2, 1024, 1024, OFF_WOUTE, 1024, 1024, 1024, 0},
    {22, 2, 384, 768, OFF_WQB, 768, 1024, 1024, 0},
    {24, 2, 256, 1024, OFF_WKVB, 1024, 1024, 1024, 0},
    {27, 2, 1024, 4096, OFF_WINO, 4096, 4096, 4096, 0},
    {31, 2, 2048, 1024, OFF_WOUTO, 1024, 1024, 1024, 0}};
__device__ __forceinline__ TJob get_job(int j) { return g_jobs[j]; }
constexpr int NJOBS = 12;
__device__ __forceinline__ int job_tiles(const TJob& J) { return J.batch * (J.K / 128) * ((J.N + 127) / 128); }

__device__ __forceinline__ void tt_load(const Params& p, const TJob& J, int t, int tid, f32x4 (&va)[4], f32x4 (&vb)[4]) {
    const int nk = J.K / 128, nn = (J.N + 127) / 128;
    const int bt = t / (nk * nn), rem = t % (nk * nn), kt = rem / nn, ntile = rem % nn;
    const float* src = pin(p, J.src) + (size_t)bt * J.K * J.N + (size_t)(kt * 128) * J.N + ntile * 128;
    const int c4 = tid & 31, r0 = tid >> 5;
    const bool colok = (ntile * 128 + c4 * 4) < J.N;
#pragma unroll
    for (int i = 0; i < 4; ++i) {
        const int k = 2 * (r0 + 16 * i);
        if (colok) { va[i] = *(const f32x4*)(src + (size_t)k * J.N + c4 * 4); vb[i] = *(const f32x4*)(src + (size_t)(k + 1) * J.N + c4 * 4); }
        else { va[i] = (f32x4){0.f, 0.f, 0.f, 0.f}; vb[i] = va[i]; }
    }
}
__device__ __forceinline__ void tt_process(const Params& p, LAS unsigned char* lds, const TJob& J, int t, int tid, const f32x4 (&va)[4], const f32x4 (&vb)[4]) {
    const int nk = J.K / 128, nn = (J.N + 127) / 128;
    const int bt = t / (nk * nn), rem = t % (nk * nn), kt = rem / nn, ntile = rem % nn;
    LAS unsigned* sT = (LAS unsigned*)lds;
    const int c4 = tid & 31, r0 = tid >> 5;
#pragma unroll
    for (int i = 0; i < 4; ++i) {
        const int k2 = r0 + 16 * i;
#pragma unroll
        for (int e = 0; e < 4; ++e) sT[(c4 * 4 + e) * 65 + k2] = cvt_pk_bf16(va[i][e], vb[i][e]);
    }
    __syncthreads();
    bf16_t* dstb = (bf16_t*)(p.ws + J.dst) + (size_t)bt * J.rows_pb * J.K + kt * 128;
    const int k8 = tid & 15, nr = tid >> 4;
#pragma unroll
    for (int i = 0; i < 4; ++i) {
        const int nl = nr + 32 * i, n = ntile * 128 + nl;
        if (n < J.N) {
            u32x4 w; w.x = sT[nl * 65 + k8 * 4]; w.y = sT[nl * 65 + k8 * 4 + 1]; w.z = sT[nl * 65 + k8 * 4 + 2]; w.w = sT[nl * 65 + k8 * 4 + 3];
            const int drow = (n / J.blk) * J.blk_stride + (n % J.blk) + J.off;
            *(u32x4*)(dstb + (size_t)drow * J.K + k8 * 8) = w;
        }
    }
    __syncthreads();
}
__device__ __forceinline__ void transpose_job(const Params& p, LAS unsigned char* lds, const TJob& J, int t0, int nt, int G) {
    const int tid = otid();
    for (int t = t0; t < nt; t += 4 * G) {
        f32x4 va[4][4], vb[4][4];
#pragma unroll
        for (int q = 0; q < 4; ++q) if (t + q * G < nt) tt_load(p, J, t + q * G, tid, va[q], vb[q]);
#pragma unroll
        for (int q = 0; q < 4; ++q) if (t + q * G < nt) tt_process(p, lds, J, t + q * G, tid, va[q], vb[q]);
    }
}

__device__ __forceinline__ void mod_tile(const Params& p, LAS unsigned char* lds, int t) {
    const int tid = otid();
    const int l = t / 72, n0 = (t % 72) * 128;
    LAS float* sC = (LAS float*)lds;
    LAS float* sR = (LAS float*)(lds + 36864);
    { const float* cctx = pin(p, 3); const float* cc = pin(p, 2);
      for (int i = tid; i < 9 * 1024; i += 512) { const int c = i >> 10, k = i & 1023; const float v = c == 0 ? cctx[k] : cc[(c - 1) * 1024 + k]; sC[i] = silu_f(v); } }
    __syncthreads();
    const int cgp = tid & 31, ks = tid >> 5;
    const float* w = pin(p, 7) + (size_t)l * 1024 * 9216 + (size_t)(ks * 64) * 9216 + n0 + cgp * 4;
    f32x4 acc[9];
#pragma unroll
    for (int c = 0; c < 9; ++c) acc[c] = (f32x4){0.f, 0.f, 0.f, 0.f};
    for (int k0 = 0; k0 < 64; k0 += 8) {
        f32x4 wv[8];
#pragma unroll
        for (int i = 0; i < 8; ++i) wv[i] = *(const f32x4*)(w + (size_t)(k0 + i) * 9216);
#pragma unroll
        for (int i = 0; i < 8; ++i)
#pragma unroll
            for (int c = 0; c < 9; ++c) acc[c] += wv[i] * sC[c * 1024 + ks * 64 + k0 + i];
    }
#pragma unroll
    for (int c = 0; c < 9; ++c) *(LAS f32x4*)(sR + (ks * 9 + c) * 128 + cgp * 4) = acc[c];
    __syncthreads();
    float* mod = (float*)(p.ws + OFF_MOD);
    const float* adab = pin(p, 8);
    for (int i = tid; i < 9 * 128; i += 512) {
        const int c = i >> 7, col = i & 127;
        float s = adab[l * 9216 + n0 + col];
#pragma unroll
        for (int k = 0; k < 16; ++k) s += sR[(k * 9 + c) * 128 + col];
        mod[((size_t)l * 9 + c) * 9216 + n0 + col] = s;
    }
    __syncthreads();
}

__device__ __forceinline__ void prologue_phase(const Params& p, LAS unsigned char* lds) {
    const int tid = otid(), G = ogrid(), bid = obid();
    for (int t = bid; t < 288; t += G) mod_tile(p, lds, t);
    {
        const float* s = pin(p, 29); bf16_t* d = (bf16_t*)(p.ws + OFF_WS);
        for (int i = bid * 512 + tid; i < 2 * 4 * 128 * 128 / 2; i += G * 512) ((unsigned*)d)[i] = cvt_pk_bf16(s[2 * i], s[2 * i + 1]);
    }
    int base = 0;
    for (int j = 0; j < NJOBS; ++j) {
        const TJob J = get_job(j); const int nt = job_tiles(J);
        transpose_job(p, lds, J, (bid + G - (base % G)) % G, nt, G);
        base += nt;
    }
}


__device__ __forceinline__ void prologue_b(const Params& p, LAS unsigned char* lds) {
    const int tid = otid(), wid = tid >> 6, lane = tid & 63, bid = obid(), G = ogrid();
    const float* mod = (const float*)(p.ws + OFF_MOD);
    {
        const float* g = pin(p, 9); const float* x0 = pin(p, 0); const float* x1 = pin(p, 1);
        bf16_t* h = (bf16_t*)(p.ws + OFF_H); float* rsp = (float*)(p.ws + OFF_RSP);
        for (int row = bid * 8 + wid; row < T_ALL; row += G * 8) {
            const int cond = row < T_CTX ? 0 : 1 + ((row - T_CTX) >> 10);
            const float* src = row < T_CTX ? x0 + (size_t)row * 1024 : x1 + (size_t)(row - T_CTX) * 1024;
            const float* mp = mod + (size_t)cond * 9216 + 1024;
            f32x4 v[4]; float ss = 0.f;
#pragma unroll
            for (int i = 0; i < 4; ++i) { v[i] = *(const f32x4*)(src + i * 256 + lane * 4); ss += v[i][0] * v[i][0] + v[i][1] * v[i][1] + v[i][2] * v[i][2] + v[i][3] * v[i][3]; }
            ss = wave_sum(ss);
#pragma unroll
            for (int i = 0; i < 4; ++i) {
                const int col = i * 256 + lane * 4;
                const f32x4 gs = *(const f32x4*)(g + col) * (*(const f32x4*)(mp + col) + 1.f);
                const f32x4 hv = v[i] * gs;
                u32x2 w; w.x = cvt_pk_bf16(hv[0], hv[1]); w.y = cvt_pk_bf16(hv[2], hv[3]);
                *(u32x2*)(h + (size_t)row * 1024 + col) = w;
                *(f32x4*)(p.out + (size_t)row * 1024 + col) = v[i];
            }
            if (lane < 16) rsp[(size_t)row * 16 + lane] = lane == 0 ? ss : 0.f;
        }
    }
    LAS float* sC = (LAS float*)lds;
    LAS float* sP = (LAS float*)(lds + 36864);
    float* biasb = (float*)(p.ws + OFF_BIAS);
    for (int item = bid; item < 452; item += G) {
        int u = 0, c0 = item;
#pragma unroll 1
        for (;;) { const int s3 = u % 3, lo = u / 3; const int nch = (s3 == 1) ? ((lo & 1) ? 32 : 18) : 44; if (c0 < nch) break; c0 -= nch; ++u; }
        const int l = u / 3, s3 = u % 3, j = l >> 1;
        const bf16_t* Bt = (s3 == 0) ? (const bf16_t*)(p.ws + OFF_WGU1) + (size_t)l * 5632 * 1024
                         : (s3 == 2) ? (const bf16_t*)(p.ws + OFF_WGU2) + (size_t)l * 5632 * 1024
                         : (l & 1)   ? (const bf16_t*)(p.ws + OFF_WINO) + (size_t)j * 4096 * 1024
                                     : (const bf16_t*)(p.ws + OFF_WINE) + (size_t)j * 2304 * 1024;
        __syncthreads();
        {
            float tmp[18];
#pragma unroll
            for (int i = 0; i < 18; ++i) { const int idx = tid + 512 * i, c = idx >> 10, k = idx & 1023; tmp[i] = mod[((size_t)l * 9 + c) * 9216 + (size_t)(3 * s3) * 1024 + k]; }
#pragma unroll
            for (int i = 0; i < 18; ++i) sC[tid + 512 * i] = tmp[i];
        }
        __syncthreads();
        const int rw = (wid & 1) * 64 + lane, ks = wid >> 1;
        const bf16_t* wrow = Bt + (size_t)(c0 * 128 + rw) * 1024 + ks * 256;
        float acc[9];
#pragma unroll
        for (int c = 0; c < 9; ++c) acc[c] = 0.f;
#pragma unroll 4
        for (int kk = 0; kk < 256; kk += 8) {
            const u32x4 ww = *(const u32x4*)(wrow + kk);
            float wv[8];
#pragma unroll
            for (int e = 0; e < 4; ++e) { wv[2 * e] = bflo(ww[e]); wv[2 * e + 1] = bfhi(ww[e]); }
#pragma unroll
            for (int c = 0; c < 9; ++c) {
                const f32x4 s0 = *(const LAS f32x4*)(sC + c * 1024 + ks * 256 + kk), s1 = *(const LAS f32x4*)(sC + c * 1024 + ks * 256 + kk + 4);
                acc[c] += wv[0] * s0[0] + wv[1] * s0[1] + wv[2] * s0[2] + wv[3] * s0[3] + wv[4] * s1[0] + wv[5] * s1[1] + wv[6] * s1[2] + wv[7] * s1[3];
            }
        }
#pragma unroll
        for (int c = 0; c < 9; ++c) sP[(ks * 9 + c) * 128 + rw] = acc[c];
        __syncthreads();
        for (int idx = tid; idx < 9 * 128; idx += 512) {
            const int c = idx >> 7, r = idx & 127;
            const float t = sP[(0 * 9 + c) * 128 + r] + sP[(1 * 9 + c) * 128 + r] + sP[(2 * 9 + c) * 128 + r] + sP[(3 * 9 + c) * 128 + r];
            biasb[((size_t)u * 9 + c) * 5632 + c0 * 128 + r] = t;
        }
    }
    __syncthreads();
}

__device__ __forceinline__ f32x4 mfma16(bf16x8 a, bf16x8 b, f32x4 c) { return __builtin_amdgcn_mfma_f32_16x16x32_bf16(a, b, c, 0, 0, 0); }

__device__ __forceinline__ void gla_unit(const Params& p, LAS unsigned char* lds, int j, int unit) {
    const int tid = otid(), wid = tid >> 6, lane = tid & 63, fr = lane & 15, fq = lane >> 4;
    int b, h, dir, Tn, row0; bool lat;
    if (unit < 64) { lat = true; b = unit >> 3; h = (unit >> 1) & 3; dir = unit & 1; Tn = 1024; row0 = T_CTX + b * 1024; }
    else { const int u2 = unit - 64; lat = false; b = u2 >> 3; h = (u2 >> 1) & 3; dir = u2 & 1; Tn = 256; row0 = b * 256; }
    const bf16_t* proj = (const bf16_t*)(p.ws + OFF_PROJ);
    float* obuf = (float*)(p.ws + (dir ? OFF_OB : OFF_OF));
    LAS bf16_t* sQ = (LAS bf16_t*)lds;
    LAS bf16_t* sK = (LAS bf16_t*)(lds + 9216);
    LAS bf16_t* sKT = (LAS bf16_t*)(lds + 18432);
    LAS bf16_t* sVT = (LAS bf16_t*)(lds + 27648);
    LAS bf16_t* sAtt = (LAS bf16_t*)(lds + 46080);
    LAS bf16_t* sST = (LAS bf16_t*)(lds + 55296);
    LAS float* sCum = (LAS float*)(lds + 73728);
    LAS float* sGl = (LAS float*)(lds + 90112);
    LAS float* sSeg = (LAS float*)(lds + 94208);
    LAS float* sLast = (LAS float*)(lds + 96256);
    const int d_ = tid & 63, seg = tid >> 6;
    float w2r[16];
    const float* w2p = pin(p, 18); const float* stp = pin(p, 6);
#pragma unroll
    for (int r = 0; r < 16; ++r) w2r[r] = w2p[(size_t)((j * 2 + dir) * 16 + r) * 256 + h * 64 + d_];
    const float bz = pin(p, 19)[(j * 2 + dir) * 256 + h * 64 + d_];
    f32x4 Sacc[4];
    const size_t sbase_in = ((((size_t)b * 2 + j) * 2 + dir) * 4 + h) * 64 * 128;
#pragma unroll
    for (int dt = 0; dt < 4; ++dt) {
#pragma unroll
        for (int reg = 0; reg < 4; ++reg) Sacc[dt][reg] = lat ? stp[sbase_in + (size_t)(dt * 16 + fq * 4 + reg) * 128 + wid * 16 + fr] : 0.f;
        u32x2 w; w.x = cvt_pk_bf16(Sacc[dt][0], Sacc[dt][1]); w.y = cvt_pk_bf16(Sacc[dt][2], Sacc[dt][3]);
        *(LAS u32x2*)(sST + (wid * 16 + fr) * 72 + dt * 16 + fq * 4) = w;
    }
    const int nch = Tn / 64;
    const int sig = tid >> 3, part = tid & 7;
    u32x4 pq, pk; bf16x8 pv0, pv1; unsigned pgl;
#define GLA_LOAD(C) do { const int tokl_ = dir ? (Tn - 1 - ((C) * 64 + sig)) : ((C) * 64 + sig); const bf16_t* pr_ = proj + (size_t)(row0 + tokl_) * PROJ_LD; \
        pq = *(const u32x4*)(pr_ + h * 64 + part * 8); pk = *(const u32x4*)(pr_ + 256 + h * 64 + part * 8); \
        pv0 = *(const bf16x8*)(pr_ + 512 + h * 128 + part * 16); pv1 = *(const bf16x8*)(pr_ + 512 + h * 128 + part * 16 + 8); \
        pgl = *(const unsigned*)(pr_ + 1536 + dir * 16 + part * 2); } while (0)
    GLA_LOAD(0);
    for (int c = 0; c < nch; ++c) {
        const u32x4 qv = pq, kv = pk; const bf16x8 v0 = pv0, v1 = pv1; const unsigned glw = pgl;
        if (c + 1 < nch) GLA_LOAD(c + 1);
        sGl[sig * 16 + part * 2] = bflo(glw); sGl[sig * 16 + part * 2 + 1] = bfhi(glw);
        __syncthreads();
        float cumv[8]; float run = 0.f;
#pragma unroll
        for (int i = 0; i < 8; ++i) {
            const int tau = seg * 8 + i; float z = bz;
#pragma unroll
            for (int r = 0; r < 16; ++r) z += sGl[tau * 16 + r] * w2r[r];
            const float la = (fminf(z, 0.f) - __logf(1.f + __expf(-fabsf(z)))) * (1.f / 16.f);
            run += la; cumv[i] = run;
        }
        sSeg[seg * 64 + d_] = run;
        __syncthreads();
        float pre = 0.f;
#pragma unroll
        for (int s = 0; s < 7; ++s) pre += (s < seg) ? sSeg[s * 64 + d_] : 0.f;
#pragma unroll
        for (int i = 0; i < 8; ++i) sCum[(seg * 8 + i) * 64 + d_] = cumv[i] + pre;
        if (seg == 7) sLast[d_] = __expf(cumv[7] + pre);
        __syncthreads();
        {
            float qf[8], kt[8], kh[8];
#pragma unroll
            for (int e2 = 0; e2 < 4; ++e2) {
                const unsigned qw = qv[e2], kw = kv[e2];
#pragma unroll
                for (int hh = 0; hh < 2; ++hh) {
                    const int e = e2 * 2 + hh, d = part * 8 + e;
                    const float cm = sCum[sig * 64 + d], lc = sCum[63 * 64 + d];
                    const float q_ = hh ? bfhi(qw) : bflo(qw), k_ = hh ? bfhi(kw) : bflo(kw);
                    qf[e] = q_ * 0.125f * __expf(cm); kt[e] = k_ * __expf(-cm); kh[e] = k_ * __expf(lc - cm);
                }
            }
            u32x4 wq, wk;
            wq.x = cvt_pk_bf16(qf[0], qf[1]); wq.y = cvt_pk_bf16(qf[2], qf[3]); wq.z = cvt_pk_bf16(qf[4], qf[5]); wq.w = cvt_pk_bf16(qf[6], qf[7]);
            wk.x = cvt_pk_bf16(kt[0], kt[1]); wk.y = cvt_pk_bf16(kt[2], kt[3]); wk.z = cvt_pk_bf16(kt[4], kt[5]); wk.w = cvt_pk_bf16(kt[6], kt[7]);
            *(LAS u32x4*)(sQ + sig * 72 + part * 8) = wq;
            *(LAS u32x4*)(sK + sig * 72 + part * 8) = wk;
#pragma unroll
            for (int e = 0; e < 8; ++e) sKT[(part * 8 + e) * 72 + (sig ^ (part << 3))] = f2bf(kh[e]);
#pragma unroll
            for (int e = 0; e < 8; ++e) { sVT[(part * 16 + e) * 72 + (sig ^ (part << 3))] = (bf16_t)v0[e]; sVT[(part * 16 + 8 + e) * 72 + (sig ^ (part << 3))] = (bf16_t)v1[e]; }
        }
        __syncthreads();
        {
            const int taut = wid >> 1;
#pragma unroll
            for (int s2 = 0; s2 < 2; ++s2) {
                const int sigt = (wid & 1) * 2 + s2;
                f32x4 a4 = (f32x4){0.f, 0.f, 0.f, 0.f};
#pragma unroll
                for (int kk = 0; kk < 2; ++kk) {
                    const bf16x8 a = *(const LAS bf16x8*)(sK + (sigt * 16 + fr) * 72 + kk * 32 + fq * 8);
                    const bf16x8 bq = *(const LAS bf16x8*)(sQ + (taut * 16 + fr) * 72 + kk * 32 + fq * 8);
                    a4 = mfma16(a, bq, a4);
                }
#pragma unroll
                for (int reg = 0; reg < 4; ++reg) a4[reg] = ((sigt * 16 + fq * 4 + reg) <= (taut * 16 + fr)) ? a4[reg] : 0.f;
                u32x2 w; w.x = cvt_pk_bf16(a4[0], a4[1]); w.y = cvt_pk_bf16(a4[2], a4[3]);
                *(LAS u32x2*)(sAtt + (taut * 16 + fr) * 72 + sigt * 16 + fq * 4) = w;
            }
        }
        __syncthreads();
#pragma unroll
        for (int taut = 0; taut < 4; ++taut) {
            f32x4 o4 = (f32x4){0.f, 0.f, 0.f, 0.f};
#pragma unroll
            for (int kk = 0; kk < 2; ++kk) {
                const bf16x8 a = *(const LAS bf16x8*)(sQ + (taut * 16 + fr) * 72 + kk * 32 + fq * 8);
                const u32x4 bbu = *(const LAS u32x4*)(sST + (wid * 16 + fr) * 72 + kk * 32 + fq * 8);
                o4 = mfma16(a, __builtin_bit_cast(bf16x8, bbu), o4);
            }
#pragma unroll
            for (int kk = 0; kk < 2; ++kk) {
                const bf16x8 a = *(const LAS bf16x8*)(sAtt + (taut * 16 + fr) * 72 + kk * 32 + fq * 8);
                const bf16x8 bb = *(const LAS bf16x8*)(sVT + (wid * 16 + fr) * 72 + (((kk * 4 + fq) ^ wid) << 3));
                o4 = mfma16(a, bb, o4);
            }
#pragma unroll
            for (int reg = 0; reg < 4; ++reg) {
                const int tau = taut * 16 + fq * 4 + reg;
                const int tk = dir ? (Tn - 1 - (c * 64 + tau)) : (c * 64 + tau);
                obuf[(size_t)(row0 + tk) * 512 + h * 128 + wid * 16 + fr] = o4[reg];
            }
        }
        __syncthreads();
#pragma unroll
        for (int dt = 0; dt < 4; ++dt) {
#pragma unroll
            for (int reg = 0; reg < 4; ++reg) Sacc[dt][reg] *= sLast[dt * 16 + fq * 4 + reg];
#pragma unroll
            for (int kk = 0; kk < 2; ++kk) {
                const bf16x8 a = *(const LAS bf16x8*)(sKT + (dt * 16 + fr) * 72 + (((kk * 4 + fq) ^ (dt * 2 + (fr >> 3))) << 3));
                const bf16x8 bb = *(const LAS bf16x8*)(sVT + (wid * 16 + fr) * 72 + (((kk * 4 + fq) ^ wid) << 3));
                Sacc[dt] = mfma16(a, bb, Sacc[dt]);
            }
            u32x2 w; w.x = cvt_pk_bf16(Sacc[dt][0], Sacc[dt][1]); w.y = cvt_pk_bf16(Sacc[dt][2], Sacc[dt][3]);
            *(LAS u32x2*)(sST + (wid * 16 + fr) * 72 + dt * 16 + fq * 4) = w;
        }
        __syncthreads();
    }
    if (!lat) {
        float* og = p.out + OUT_GLA + ((((size_t)b * 2 + j) * 2 + dir) * 4 + h) * 64 * 128;
#pragma unroll
        for (int dt = 0; dt < 4; ++dt)
#pragma unroll
            for (int reg = 0; reg < 4; ++reg) og[(size_t)(dt * 16 + fq * 4 + reg) * 128 + wid * 16 + fr] = Sacc[dt][reg];
    }
}

__device__ __forceinline__ void mla_prep_tile(const Params& p, int j, int t) {
    const int tid = otid(), wid = tid >> 6, lane = tid & 63;
    const bf16_t* proj = (const bf16_t*)(p.ws + OFF_PROJ);
    bf16_t* cqn = (bf16_t*)(p.ws + OFF_CQN); bf16_t* ckvn = (bf16_t*)(p.ws + OFF_CKVN);
    const float* qag = pin(p, 21); const float* kvag = pin(p, 23); const float* cckv = pin(p, 4);
    for (int i = 0; i < 8; ++i) {
        const int r = t * 64 + wid * 8 + i;
        if (r < T_ALL) {
            const bf16_t* pr = proj + (size_t)r * PROJ_LD;
            float cq[6]; float ss = 0.f;
#pragma unroll
            for (int k = 0; k < 3; ++k) { const unsigned w = *(const unsigned*)(pr + 1568 + k * 128 + lane * 2); cq[2 * k] = bflo(w); cq[2 * k + 1] = bfhi(w); ss += cq[2 * k] * cq[2 * k] + cq[2 * k + 1] * cq[2 * k + 1]; }
            ss = wave_sum(ss);
            const float rq = rsqrtf(ss * (1.f / 384.f) + EPS);
#pragma unroll
            for (int k = 0; k < 3; ++k) { const int col = k * 128 + lane * 2; const float g0 = qag[j * 384 + col], g1 = qag[j * 384 + col + 1];
                *(unsigned*)(cqn + (size_t)r * 384 + col) = cvt_pk_bf16(cq[2 * k] * rq * g0, cq[2 * k + 1] * rq * g1); }
            const u32x2 kw = *(const u32x2*)(pr + 1952 + lane * 4);
            float kv[4] = {bflo(kw.x), bfhi(kw.x), bflo(kw.y), bfhi(kw.y)};
            float s2 = kv[0] * kv[0] + kv[1] * kv[1] + kv[2] * kv[2] + kv[3] * kv[3];
            s2 = wave_sum(s2);
            const float rk = rsqrtf(s2 * (1.f / 256.f) + EPS);
            const f32x4 gk = *(const f32x4*)(kvag + j * 256 + lane * 4);
            f32x4 y;
#pragma unroll
            for (int e = 0; e < 4; ++e) y[e] = kv[e] * rk * gk[e];
            u32x2 w; w.x = cvt_pk_bf16(y[0], y[1]); w.y = cvt_pk_bf16(y[2], y[3]);
            *(u32x2*)(ckvn + (size_t)r * 256 + lane * 4) = w;
            if (r < T_CTX) {
                const int bb = r >> 8, tt = r & 255;
                *(f32x4*)(p.out + OUT_CKV + (((size_t)bb * 2 + j) * 256 + tt) * 256 + lane * 4) = y;
                if (lane < 32) p.out[OUT_KROPE + (((size_t)bb * 2 + j) * 256 + tt) * 32 + lane] = bf2f(pr[2208 + lane]);
            }
        } else {
            const int rc = r - T_ALL, bb = rc >> 8, m = rc & 255;
            const f32x4 v = *(const f32x4*)(cckv + (((size_t)bb * 2 + j) * 256 + m) * 256 + lane * 4);
            u32x2 w; w.x = cvt_pk_bf16(v[0], v[1]); w.y = cvt_pk_bf16(v[2], v[3]);
            *(u32x2*)(ckvn + (size_t)r * 256 + lane * 4) = w;
        }
    }
}

__device__ __forceinline__ void even2_phase(const Params& p, LAS unsigned char* lds, int j) {
    const int bid = obid(), G = ogrid();
    if (G >= 128) {
        if (bid < 64) { gla_unit(p, lds, j, bid); __syncthreads(); }
        else { for (int it = 64 + (bid - 64); it < 608; it += (G - 64)) { if (it < 320) { gla_unit(p, lds, j, it); __syncthreads(); } else mla_prep_tile(p, j, it - 320); } }
    } else {
        for (int it = bid; it < 608; it += G) { if (it < 320) { gla_unit(p, lds, j, it); __syncthreads(); } else mla_prep_tile(p, j, it - 320); }
    }
}


__device__ __forceinline__ float rope_inv(int i) { return __builtin_amdgcn_exp2f(-(float)(i & 7) * 1.6609640474f); }


__device__ __forceinline__ void kprep_tile(const Params& p, LAS unsigned char* lds, int j, int tile) {
    const int tid = otid();
    const int rt = tile >> 3, h = tile & 7, row0 = rt * 64;
    const bf16_t* proj = (const bf16_t*)(p.ws + OFF_PROJ); const bf16_t* kvraw = (const bf16_t*)(p.ws + OFF_KVRAW);
    bf16_t* KN = (bf16_t*)(p.ws + OFF_KN); bf16_t* VT = (bf16_t*)(p.ws + OFF_VT);
    LAS bf16_t* sVT = (LAS bf16_t*)lds;
    const float* kg = pin(p, 26) + j * 96; const float* ckr = pin(p, 5);
    const int key = tid >> 3, part = tid & 7, row = row0 + key;
    float kr[4]; bool rope = false; int pos = 0;
    if (row < T_ALL) { const u32x2 w = *(const u32x2*)(proj + (size_t)row * PROJ_LD + 2208 + part * 4); kr[0] = bflo(w.x); kr[1] = bfhi(w.x); kr[2] = bflo(w.y); kr[3] = bfhi(w.y);
        if (row >= T_CTX) { rope = true; pos = (row - T_CTX) & 1023; } }
    else { const int rc = row - T_ALL, bb = rc >> 8, m = rc & 255; const f32x4 w = *(const f32x4*)(ckr + (((size_t)bb * 2 + j) * 256 + m) * 32 + part * 4); kr[0] = w[0]; kr[1] = w[1]; kr[2] = w[2]; kr[3] = w[3]; }
    const bf16_t* kp = kvraw + (size_t)row * 1024 + h * 128;
    const u32x4 kn = *(const u32x4*)(kp + part * 8); const bf16x8 vv = *(const bf16x8*)(kp + 64 + part * 8);
    float kf[8];
#pragma unroll
    for (int e = 0; e < 4; ++e) { kf[2 * e] = bflo(kn[e]); kf[2 * e + 1] = bfhi(kn[e]); }
    float ss = kr[0] * kr[0] + kr[1] * kr[1] + kr[2] * kr[2] + kr[3] * kr[3];
#pragma unroll
    for (int e = 0; e < 8; ++e) ss += kf[e] * kf[e];
    ss += __shfl_xor(ss, 1); ss += __shfl_xor(ss, 2); ss += __shfl_xor(ss, 4);
    const float rstd = rsqrtf(ss * (1.f / 96.f) + EPS);
#pragma unroll
    for (int e = 0; e < 8; ++e) kf[e] *= rstd * kg[part * 8 + e];
#pragma unroll
    for (int e = 0; e < 4; ++e) kr[e] *= rstd * kg[64 + part * 4 + e];
    if (rope) {
        const float prow = (float)(pos >> 6), pcol = (float)(pos & 63);
#pragma unroll
        for (int pr = 0; pr < 2; ++pr) {
            const int i = part * 2 + pr;
            const float ang = (i < 8 ? prow : pcol) * rope_inv(i);
            const float rev = ang * 0.15915494309f;
            const float cs = __builtin_amdgcn_cosf(rev), sn = __builtin_amdgcn_sinf(rev);
            const float x1 = kr[2 * pr], x2 = kr[2 * pr + 1];
            kr[2 * pr] = x1 * cs - x2 * sn; kr[2 * pr + 1] = x1 * sn + x2 * cs;
        }
    }
    bf16_t* kd = KN + ((size_t)row * 8 + h) * 96;
    u32x4 w; w.x = cvt_pk_bf16(kf[0], kf[1]); w.y = cvt_pk_bf16(kf[2], kf[3]); w.z = cvt_pk_bf16(kf[4], kf[5]); w.w = cvt_pk_bf16(kf[6], kf[7]);
    *(u32x4*)(kd + part * 8) = w;
    u32x2 w2; w2.x = cvt_pk_bf16(kr[0], kr[1]); w2.y = cvt_pk_bf16(kr[2], kr[3]);
    *(u32x2*)(kd + 64 + part * 4) = w2;
#pragma unroll
    for (int e = 0; e < 8; ++e) sVT[(part * 8 + e) * 72 + key] = (bf16_t)vv[e];
    __syncthreads();
    {
        size_t base; int nk, k0;
        if (row0 < T_CTX) { base = (size_t)((row0 >> 8) * 8 + h) * 64 * 256; nk = 256; k0 = row0 & 255; }
        else if (row0 < T_ALL) { base = VT_LAT + (size_t)(((row0 - T_CTX) >> 10) * 8 + h) * 64 * 1280; nk = 1280; k0 = 256 + ((row0 - T_CTX) & 1023); }
        else { base = VT_LAT + (size_t)(((row0 - T_ALL) >> 8) * 8 + h) * 64 * 1280; nk = 1280; k0 = (row0 - T_ALL) & 255; }
        const int dv = tid >> 3, c8 = tid & 7;
        *(u32x4*)(VT + base + (size_t)dv * nk + k0 + c8 * 8) = *(const LAS u32x4*)(sVT + dv * 72 + c8 * 8);
    }
    __syncthreads();
}

__device__ __forceinline__ void attn_tile(const Params& p, LAS unsigned char* lds, int j, int tile) {
    const int tid = otid(), wid = tid >> 6, lane = tid & 63, fr = lane & 15, fq = lane >> 4;
    bool lat; int b, h, qp_, nkb, qrow0;
    if (tile < 256) { lat = true; b = tile >> 5; h = (tile >> 2) & 7; qp_ = tile & 3; nkb = 20; qrow0 = T_CTX + b * 1024 + qp_ * 256; }
    else { const int t2 = tile - 256; lat = false; b = t2 >> 3; h = t2 & 7; qp_ = 0; nkb = 4; qrow0 = b * 256; }
    const bf16_t* qraw = (const bf16_t*)(p.ws + OFF_QRAW);
    bf16_t* cat = (bf16_t*)(p.ws + OFF_CAT);
    LAS bf16_t* sQ = (LAS bf16_t*)lds;
    LAS bf16_t* sK = (LAS bf16_t*)(lds + 53248);
    LAS bf16_t* sVT = (LAS bf16_t*)(lds + 66560);
    const float* g = pin(p, 25) + j * 96;
#pragma unroll 1
    for (int r = 0; r < 2; ++r) {
        const int q = (tid >> 2) + 128 * r, part = tid & 3;
        const bf16_t* qp = qraw + (size_t)(qrow0 + q) * 768 + h * 96;
        const u32x4 n0 = *(const u32x4*)(qp + part * 16), n1 = *(const u32x4*)(qp + part * 16 + 8), rp = *(const u32x4*)(qp + 64 + part * 8);
        float f[24];
#pragma unroll
        for (int e = 0; e < 4; ++e) { f[2 * e] = bflo(n0[e]); f[2 * e + 1] = bfhi(n0[e]); f[8 + 2 * e] = bflo(n1[e]); f[8 + 2 * e + 1] = bfhi(n1[e]); f[16 + 2 * e] = bflo(rp[e]); f[16 + 2 * e + 1] = bfhi(rp[e]); }
        float ss = 0.f;
#pragma unroll
        for (int e = 0; e < 24; ++e) ss += f[e] * f[e];
        ss += __shfl_xor(ss, 1); ss += __shfl_xor(ss, 2);
        const float rstd = rsqrtf(ss * (1.f / 96.f) + EPS);
#pragma unroll
        for (int e = 0; e < 16; ++e) f[e] *= rstd * g[part * 16 + e];
#pragma unroll
        for (int e = 0; e < 8; ++e) f[16 + e] *= rstd * g[64 + part * 8 + e];
        if (lat) {
            const int pos = qp_ * 256 + q; const float prow = (float)(pos >> 6), pcol = (float)(pos & 63);
#pragma unroll
            for (int pr = 0; pr < 4; ++pr) {
                const int i = part * 4 + pr;
                const float ang = (i < 8 ? prow : pcol) * rope_inv(i);
                const float rev = ang * 0.15915494309f;
                const float cs = __builtin_amdgcn_cosf(rev), sn = __builtin_amdgcn_sinf(rev);
                const float x1 = f[16 + 2 * pr], x2 = f[16 + 2 * pr + 1];
                f[16 + 2 * pr] = x1 * cs - x2 * sn; f[16 + 2 * pr + 1] = x1 * sn + x2 * cs;
            }
        }
        const float sc = 0.10206207262f * 1.44269504089f;
        u32x4 w0, w1, w2;
#pragma unroll
        for (int e = 0; e < 4; ++e) { w0[e] = cvt_pk_bf16(f[2 * e] * sc, f[2 * e + 1] * sc); w1[e] = cvt_pk_bf16(f[8 + 2 * e] * sc, f[8 + 2 * e + 1] * sc); w2[e] = cvt_pk_bf16(f[16 + 2 * e] * sc, f[16 + 2 * e + 1] * sc); }
        *(LAS u32x4*)(sQ + q * 104 + part * 16) = w0; *(LAS u32x4*)(sQ + q * 104 + part * 16 + 8) = w1; *(LAS u32x4*)(sQ + q * 104 + 64 + part * 8) = w2;
    }
    __syncthreads();
    bf16x8 bQ[2][3];
#pragma unroll
    for (int gq = 0; gq < 2; ++gq)
#pragma unroll
        for (int kk = 0; kk < 3; ++kk) bQ[gq][kk] = *(const LAS bf16x8*)(sQ + (wid * 32 + gq * 16 + fr) * 104 + kk * 32 + fq * 8);
    float m_run[2] = {-1e30f, -1e30f}, l_run[2] = {0.f, 0.f};
    f32x4 oacc[2][4];
#pragma unroll
    for (int gq = 0; gq < 2; ++gq)
#pragma unroll
        for (int dt = 0; dt < 4; ++dt) oacc[gq][dt] = (f32x4){0.f, 0.f, 0.f, 0.f};
    const bf16_t* KN = (const bf16_t*)(p.ws + OFF_KN);
    const bf16_t* VTg = (const bf16_t*)(p.ws + OFF_VT) + (lat ? VT_LAT + (size_t)(b * 8 + h) * 64 * 1280 : (size_t)(b * 8 + h) * 64 * 256);
    const int NK = lat ? 1280 : 256;
    u32x4 pf_k0, pf_k1, pf_v;
    const int kc0 = tid, kc1 = tid + 512;
    const int key0_ = kc0 / 12, pc0_ = kc0 % 12, key1_ = kc1 / 12, pc1_ = kc1 % 12;
#define ATT_ROW(KB, KEY) (!lat ? (b * 256 + (KB) * 64 + (KEY)) : ((KB) < 4 ? (T_ALL + b * 256 + (KB) * 64 + (KEY)) : (T_CTX + b * 1024 + ((KB) - 4) * 64 + (KEY))))
#define ATT_LOAD(KB) do { \
        pf_k0 = *(const u32x4*)(KN + ((size_t)ATT_ROW(KB, key0_) * 8 + h) * 96 + pc0_ * 8); \
        if (tid < 256) pf_k1 = *(const u32x4*)(KN + ((size_t)ATT_ROW(KB, key1_) * 8 + h) * 96 + pc1_ * 8); \
        pf_v = *(const u32x4*)(VTg + (size_t)(tid >> 3) * NK + (KB) * 64 + (tid & 7) * 8); } while (0)
    pf_k1 = (u32x4){0u, 0u, 0u, 0u};
    ATT_LOAD(0);
    for (int kb = 0; kb < nkb; ++kb) {
        *(LAS u32x4*)(sK + key0_ * 104 + pc0_ * 8) = pf_k0;
        if (tid < 256) *(LAS u32x4*)(sK + key1_ * 104 + pc1_ * 8) = pf_k1;
        *(LAS u32x4*)(sVT + (tid >> 3) * 72 + (tid & 7) * 8) = pf_v;
        __syncthreads();
        if (kb + 1 < nkb) ATT_LOAD(kb + 1);
        {
            f32x4 s[2][4];
#pragma unroll
            for (int g4 = 0; g4 < 4; ++g4) {
                s[0][g4] = (f32x4){0.f, 0.f, 0.f, 0.f}; s[1][g4] = s[0][g4];
#pragma unroll
                for (int kk = 0; kk < 3; ++kk) {
                    const bf16x8 a = *(const LAS bf16x8*)(sK + (g4 * 16 + fr) * 104 + kk * 32 + fq * 8);
                    s[0][g4] = mfma16(a, bQ[0][kk], s[0][g4]); s[1][g4] = mfma16(a, bQ[1][kk], s[1][g4]);
                }
            }
#pragma unroll
            for (int gq = 0; gq < 2; ++gq) {
                float mx = s[gq][0][0];
#pragma unroll
                for (int g4 = 0; g4 < 4; ++g4)
#pragma unroll
                    for (int reg = 0; reg < 4; ++reg) mx = fmaxf(mx, s[gq][g4][reg]);
                mx = fmaxf(mx, __shfl_xor(mx, 16)); mx = fmaxf(mx, __shfl_xor(mx, 32));
                const float m_new = fmaxf(m_run[gq], mx);
                const float alpha = __builtin_amdgcn_exp2f(m_run[gq] - m_new);
                m_run[gq] = m_new;
                float ls = 0.f;
#pragma unroll
                for (int g4 = 0; g4 < 4; ++g4)
#pragma unroll
                    for (int reg = 0; reg < 4; ++reg) { s[gq][g4][reg] = __builtin_amdgcn_exp2f(s[gq][g4][reg] - m_new); ls += s[gq][g4][reg]; }
                l_run[gq] = l_run[gq] * alpha + ls;
#pragma unroll
                for (int dt = 0; dt < 4; ++dt) oacc[gq][dt] *= alpha;
            }
#pragma unroll
            for (int ks = 0; ks < 2; ++ks) {
                bf16x8 bP[2];
#pragma unroll
                for (int gq = 0; gq < 2; ++gq) {
                    u32x4 pw; pw.x = cvt_pk_bf16(s[gq][2 * ks][0], s[gq][2 * ks][1]); pw.y = cvt_pk_bf16(s[gq][2 * ks][2], s[gq][2 * ks][3]); pw.z = cvt_pk_bf16(s[gq][2 * ks + 1][0], s[gq][2 * ks + 1][1]); pw.w = cvt_pk_bf16(s[gq][2 * ks + 1][2], s[gq][2 * ks + 1][3]);
                    bP[gq] = __builtin_bit_cast(bf16x8, pw);
                }
#pragma unroll
                for (int dt = 0; dt < 4; ++dt) {
                    const u32x2 lo = *(const LAS u32x2*)(sVT + (dt * 16 + fr) * 72 + ks * 32 + fq * 4);
                    const u32x2 hi = *(const LAS u32x2*)(sVT + (dt * 16 + fr) * 72 + ks * 32 + 16 + fq * 4);
                    u32x4 av; av.x = lo.x; av.y = lo.y; av.z = hi.x; av.w = hi.y;
                    const bf16x8 aV = __builtin_bit_cast(bf16x8, av);
                    oacc[0][dt] = mfma16(aV, bP[0], oacc[0][dt]); oacc[1][dt] = mfma16(aV, bP[1], oacc[1][dt]);
                }
            }
        }
        __syncthreads();
    }
#undef ATT_LOAD
#undef ATT_ROW
#pragma unroll
    for (int gq = 0; gq < 2; ++gq) {
        float l = l_run[gq];
        l += __shfl_xor(l, 16); l += __shfl_xor(l, 32);
        const float inv = 1.f / l;
        bf16_t* op = cat + (size_t)(qrow0 + wid * 32 + gq * 16 + fr) * 1024 + 512 + h * 64;
#pragma unroll
        for (int dt = 0; dt < 4; ++dt) { u32x2 w; w.x = cvt_pk_bf16(oacc[gq][dt][0] * inv, oacc[gq][dt][1] * inv); w.y = cvt_pk_bf16(oacc[gq][dt][2] * inv, oacc[gq][dt][3] * inv); *(u32x2*)(op + dt * 16 + fq * 4) = w; }
    }
}

__device__ __forceinline__ void gla_finish_rows(const Params& p, int j) {
    const int tid = otid(), wid = tid >> 6, lane = tid & 63;
    const float* of = (const float*)(p.ws + OFF_OF); const float* ob = (const float*)(p.ws + OFF_OB);
    const bf16_t* proj = (const bf16_t*)(p.ws + OFF_PROJ); bf16_t* cat = (bf16_t*)(p.ws + OFF_CAT);
    const int e0 = (lane & 15) * 8;
    const float* glag = pin(p, 20);
    for (int row = obid() * 8 + wid; row < T_ALL; row += ogrid() * 8) {
        const float* a = of + (size_t)row * 512 + lane * 8; const float* bb = ob + (size_t)row * 512 + lane * 8;
        f32x4 x0 = *(const f32x4*)a + *(const f32x4*)bb, x1 = *(const f32x4*)(a + 4) + *(const f32x4*)(bb + 4);
        float ss = x0[0] * x0[0] + x0[1] * x0[1] + x0[2] * x0[2] + x0[3] * x0[3] + x1[0] * x1[0] + x1[1] * x1[1] + x1[2] * x1[2] + x1[3] * x1[3];
        ss += __shfl_xor(ss, 1); ss += __shfl_xor(ss, 2); ss += __shfl_xor(ss, 4); ss += __shfl_xor(ss, 8);
        const float rstd = rsqrtf(ss * (1.f / 128.f) + EPS);
        const f32x4 g0 = *(const f32x4*)(glag + j * 128 + e0), g1 = *(const f32x4*)(glag + j * 128 + e0 + 4);
        const u32x4 ogw = *(const u32x4*)(proj + (size_t)row * PROJ_LD + 1024 + lane * 8);
        float y[8];
#pragma unroll
        for (int e = 0; e < 4; ++e) { y[e] = x0[e] * rstd * g0[e]; y[4 + e] = x1[e] * rstd * g1[e]; }
#pragma unroll
        for (int e = 0; e < 4; ++e) { y[2 * e] *= silu_f(bflo(ogw[e])); y[2 * e + 1] *= silu_f(bfhi(ogw[e])); }
        u32x4 w; w.x = cvt_pk_bf16(y[0], y[1]); w.y = cvt_pk_bf16(y[2], y[3]); w.z = cvt_pk_bf16(y[4], y[5]); w.w = cvt_pk_bf16(y[6], y[7]);
        *(u32x4*)(cat + (size_t)row * 1024 + lane * 8) = w;
    }
}


__device__ __forceinline__ void spatial_tile(const Params& p, LAS unsigned char* lds, int j, int tile) {
    const int tid = otid(), wid = tid >> 6, lane = tid & 63, fr = lane & 15, fq = lane >> 4;
    const int chunk = tile >> 4, slab = tile & 15, g = slab >> 2;
    const bf16_t* uv = (const bf16_t*)(p.ws + OFF_UV); bf16_t* gated = (bf16_t*)(p.ws + OFF_GATED);
    const float* ssp = (const float*)(p.ws + OFF_SSP);
    const bf16_t* Ws = (const bf16_t*)(p.ws + OFF_WS) + (size_t)(j * 4 + g) * 128 * 128;
    LAS bf16_t* sW = (LAS bf16_t*)lds;
    LAS bf16_t* sVT = (LAS bf16_t*)(lds + 34816);
    LAS float* sR = (LAS float*)(lds + 69632);
    if (tid < 128) { const float* s = ssp + (size_t)(chunk * 128 + tid) * 32; float a = 0.f;
#pragma unroll
        for (int i = 0; i < 32; i += 4) { const f32x4 v = *(const f32x4*)(s + i); a += v[0] + v[1] + v[2] + v[3]; }
        sR[tid] = rsqrtf(a * (1.f / 2048.f) + EPS); }
#pragma unroll
    for (int i = 0; i < 4; ++i) { const int idx = tid + 512 * i, row = idx >> 4, c8 = idx & 15; *(LAS u32x4*)(sW + row * 136 + c8 * 8) = *(const u32x4*)(Ws + row * 128 + c8 * 8); }
    __syncthreads();
    const float* vgp = pin(p, 28);
#pragma unroll
    for (int i = 0; i < 4; ++i) {
        const int idx = tid + 512 * i, q = idx >> 4, c8 = idx & 15;
        const u32x4 vv = *(const u32x4*)(uv + (size_t)(chunk * 128 + q) * 4096 + 2048 + slab * 128 + c8 * 8);
        const float rs = sR[q]; const float* vg = vgp + j * 2048 + slab * 128 + c8 * 8;
#pragma unroll
        for (int e = 0; e < 4; ++e) {
            sVT[(c8 * 8 + 2 * e) * 136 + (q ^ (c8 << 3))] = f2bf(bflo(vv[e]) * rs * vg[2 * e]);
            sVT[(c8 * 8 + 2 * e + 1) * 136 + (q ^ (c8 << 3))] = f2bf(bfhi(vv[e]) * rs * vg[2 * e + 1]);
        }
    }
    __syncthreads();
    bf16x8 aV[4];
#pragma unroll
    for (int kk = 0; kk < 4; ++kk) aV[kk] = *(const LAS bf16x8*)(sVT + (wid * 16 + fr) * 136 + (((kk * 4 + fq) ^ (wid * 2 + (fr >> 3))) << 3));
    const float* bs = pin(p, 30) + (size_t)(j * 4 + g) * 128;
#pragma unroll
    for (int pt = 0; pt < 8; ++pt) {
        f32x4 acc = (f32x4){0.f, 0.f, 0.f, 0.f};
#pragma unroll
        for (int kk = 0; kk < 4; ++kk) { const bf16x8 bw = *(const LAS bf16x8*)(sW + (pt * 16 + fr) * 136 + kk * 32 + fq * 8); acc = mfma16(aV[kk], bw, acc); }
        const int prow = pt * 16 + fr; const float bias = bs[prow];
        const size_t row = (size_t)chunk * 128 + prow; const int col = slab * 128 + wid * 16 + fq * 4;
        const u32x2 uw = *(const u32x2*)(uv + row * 4096 + col);
        u32x2 w; w.x = cvt_pk_bf16(bflo(uw.x) * (acc[0] + bias), bfhi(uw.x) * (acc[1] + bias)); w.y = cvt_pk_bf16(bflo(uw.y) * (acc[2] + bias), bfhi(uw.y) * (acc[3] + bias));
        *(u32x2*)(gated + row * 2048 + col) = w;
    }
    __syncthreads();
}

#define XB_TMO      128
#define XB_XCNT(j)  (256  + 64 * (j))
#define XB_XSUB(j)  (1280 + 64 * (j))
#define XB_XGEN(j)  (2304 + 64 * (j))
#define XB_TOP      3328
#define XB_TOPGEN   3392
#define XCD_BAR_WORDS 3456
#define XB_SPIN_CAP (1u << 18)

__device__ __forceinline__ unsigned xb_ld(unsigned* p)              { return __hip_atomic_load(p, __ATOMIC_RELAXED, __HIP_MEMORY_SCOPE_AGENT); }
__device__ __forceinline__ unsigned xb_add(unsigned* p, unsigned v) { return __hip_atomic_fetch_add(p, v, __ATOMIC_RELAXED, __HIP_MEMORY_SCOPE_AGENT); }
__device__ __forceinline__ unsigned xb_xcc_id() { return (unsigned)__builtin_amdgcn_s_getreg((3 << 11) | 20) & 0xFu; }
#define XB_SPIN(cond, bar) do { unsigned _sp = 0; while (cond) { __builtin_amdgcn_s_sleep(1); \
    if ((++_sp & 255u) == 0u) { if (xb_ld(&(bar)[XB_TMO])) break; if (_sp > XB_SPIN_CAP) { atomicAdd(&(bar)[XB_TMO], 1u); break; } } } } while (0)

struct XcdBarrier {
    unsigned* bar; unsigned x;
    volatile LAS unsigned* st;
};

__device__ __forceinline__ XcdBarrier xcd_barrier_post(unsigned* bar, volatile LAS unsigned* st) {
    XcdBarrier b; b.bar = bar; b.x = xb_xcc_id(); b.st = st;
    if (threadIdx.x == 0) (void)xb_add(&bar[XB_XCNT(b.x)], 1u);
    return b;
}
__device__ __forceinline__ void xcd_barrier_complete(unsigned* bar, unsigned x, unsigned& nloc, unsigned& nx) {
    const unsigned G = gridDim.x * gridDim.y * gridDim.z;
    unsigned sum, cnt, mine, sp = 0u;
    for (;;) {
        sum = 0u; cnt = 0u; mine = 0u;
#pragma unroll
        for (unsigned j = 0; j < 16; ++j) { const unsigned c = xb_ld(&bar[XB_XCNT(j)]); sum += c; cnt += (c > 0u) ? 1u : 0u; mine = (j == x) ? c : mine; }
        if (sum == G) break;
        __builtin_amdgcn_s_sleep(1);
        if ((++sp & 255u) == 0u) { if (xb_ld(&bar[XB_TMO])) break; if (sp > XB_SPIN_CAP) { atomicAdd(&bar[XB_TMO], 1u); break; } }
    }
    nloc = mine > 0u ? mine : 1u; nx = cnt > 0u ? cnt : 1u;
}

__device__ __forceinline__ void xcd_barrier(const XcdBarrier& b) {
    asm volatile("s_waitcnt vmcnt(0)" ::: "memory");
    __syncthreads();
    if (threadIdx.x == 0) {
        unsigned* bar = b.bar;
        __builtin_amdgcn_s_waitcnt(0);
        unsigned nloc = b.st[0], nx = b.st[1];
        if (nloc == 0u) { xcd_barrier_complete(bar, b.x, nloc, nx); b.st[0] = nloc; b.st[1] = nx; }
        const unsigned old = xb_add(&bar[XB_XSUB(b.x)], 1u);
        const unsigned gen = old / nloc;
        if (old + 1u == (gen + 1u) * nloc) {
            __builtin_amdgcn_fence(__ATOMIC_RELEASE, "agent");
            asm volatile("s_waitcnt vmcnt(0)" ::: "memory");
            const unsigned og = xb_add(&bar[XB_TOP], 1u);
            const unsigned tg = og / nx;
            if (og + 1u == (tg + 1u) * nx) xb_add(&bar[XB_TOPGEN], 1u);
            else XB_SPIN(xb_ld(&bar[XB_TOPGEN]) == tg, bar);
            __builtin_amdgcn_fence(__ATOMIC_ACQUIRE, "agent");
            xb_add(&bar[XB_XGEN(b.x)], 1u);
            asm volatile("s_waitcnt vmcnt(0)" ::: "memory");
        } else {
            XB_SPIN(xb_ld(&bar[XB_XGEN(b.x)]) == gen, bar);
            __builtin_amdgcn_fence(__ATOMIC_ACQUIRE, "agent");
            asm volatile("s_waitcnt vmcnt(0)" ::: "memory");
        }
    }
    __syncthreads();
}

constexpr size_t OFF_BAR = (size_t)520 << 20;

constexpr int STEPS = 13, NPH = 1 + 4 * STEPS;

__global__ void __launch_bounds__(512, 2) mega(Params p) {
    extern __shared__ __attribute__((aligned(16))) unsigned char shm[];
    LAS unsigned char* lds = (LAS unsigned char*)shm;
    cg::grid_group grid = cg::this_grid();
    __shared__ uint4 xb_words;
    if (threadIdx.x == 0) xb_words = make_uint4(0u, 0u, 0u, 0u);
    __syncthreads();
    if (p.ph_end - p.ph_begin > 1) (void)xcd_barrier_post((unsigned*)(p.ws + OFF_BAR), (volatile LAS unsigned*)&xb_words);
    bf16_t* hbuf = (bf16_t*)(p.ws + OFF_H);
    float* mod = (float*)(p.ws + OFF_MOD);
    bool first = true;
    for (int ph = p.ph_begin; ph < p.ph_end; ++ph) {
        int l = 0, s = -1;
        if (ph > 0) { l = (ph - 1) / STEPS; s = (ph - 1) % STEPS; }
        const bool odd = (l & 1) != 0; const int j = l >> 1;
        if (odd && (s == 7 || s == 8 || s == 9)) continue;
        if (s == 3 || s == 7 || s == 10 || (s == 0 && l > 0)) continue;
        if (!first) { if (ph == 1) grid.sync(); else { XcdBarrier xb; xb.bar = (unsigned*)(p.ws + OFF_BAR); xb.x = xb_xcc_id(); xb.st = (volatile LAS unsigned*)&xb_words; xcd_barrier(xb); } }
        first = false;
        const int bid = obid(), G = ogrid();
        if (ph == 0) { prologue_phase(p, lds); continue; }
        switch (s) {
            case 0: prologue_b(p, lds); break;
            case 1: {
                pg8::Gemm g{hbuf, (const bf16_t*)(p.ws + OFF_WGU1) + (size_t)l * 5632 * 1024, T_ALL, 5632, 1024};
                pg8::StaticOrder S; S.init(g.M, g.N, G, bid);
                EpiSwiGLU E{(bf16_t*)(p.ws + OFF_ACT), (const float*)(p.ws + OFF_RSP), (const float*)(p.ws + OFF_BIAS) + (size_t)(l * 3 + 0) * 9 * 5632};
                pg8::gemm_phase(lds, g, S, E);
            } break;
            case 11: {
                pg8::Gemm g{hbuf, (const bf16_t*)(p.ws + OFF_WGU2) + (size_t)l * 5632 * 1024, T_ALL, 5632, 1024};
                pg8::StaticOrder S; S.init(g.M, g.N, G, bid);
                EpiSwiGLU E{(bf16_t*)(p.ws + OFF_ACT), (const float*)(p.ws + OFF_RSP), (const float*)(p.ws + OFF_BIAS) + (size_t)(l * 3 + 2) * 9 * 5632};
                pg8::gemm_phase(lds, g, S, E);
            } break;
            case 2: {
                pg8::Gemm g{(const bf16_t*)(p.ws + OFF_ACT), (const bf16_t*)(p.ws + OFF_WD1) + (size_t)l * 1024 * 2816, T_ALL, 1024, 2816};
                EpiResid E{p, l, 2};
                pg8::StaticOrder S; S.init(g.M, g.N, G, bid);
                pg8::gemm_phase(lds, g, S, E);
            } break;
            case 12: {
                pg8::Gemm g{(const bf16_t*)(p.ws + OFF_ACT), (const bf16_t*)(p.ws + OFF_WD2) + (size_t)l * 1024 * 2816, T_ALL, 1024, 2816};
                EpiResid E{p, l, 11};
                pg8::StaticOrder S; S.init(g.M, g.N, G, bid);
                pg8::gemm_phase(lds, g, S, E);
            } break;
            case 6: {
                if (!odd) {
                    {
                        pg8::Gemm g{(const bf16_t*)(p.ws + OFF_CQN), (const bf16_t*)(p.ws + OFF_WQB) + (size_t)j * 768 * 384, T_ALL, 768, 384};
                        EpiBf16 E{(bf16_t*)(p.ws + OFF_QRAW), 768, nullptr, nullptr};
                        pg8::StaticOrder S; S.init(g.M, g.N, G, bid);
                        pg8::gemm_phase(lds, g, S, E);
                    }
                    {
                        pg8::Gemm g{(const bf16_t*)(p.ws + OFF_CKVN), (const bf16_t*)(p.ws + OFF_WKVB) + (size_t)j * 1024 * 256, T_KV, 1024, 256};
                        EpiBf16 E{(bf16_t*)(p.ws + OFF_KVRAW), 1024, nullptr, nullptr};
                        pg8::StaticOrder S; S.init(g.M, g.N, G, (bid + G - (192 % G)) % G);
                        pg8::gemm_phase(lds, g, S, E);
                        Unit uu;
                        for (int i = 0; S.next(i, uu); ++i)
                            for (int q = 0; q < 8; ++q) kprep_tile(p, lds, j, ((uu.pm * 4 + (q >> 1)) << 3) | (uu.pn * 2 + (q & 1)));
                    }
                } else {
                    pg8::Gemm g{(const bf16_t*)(p.ws + OFF_GATED), (const bf16_t*)(p.ws + OFF_WOUTO) + (size_t)j * 1024 * 2048, T_ALL, 1024, 2048};
                    EpiResid E{p, l, 6};
                    pg8::StaticOrder S; S.init(g.M, g.N, G, bid);
                    pg8::gemm_phase(lds, g, S, E);
                }
            } break;
            case 9: {
                pg8::Gemm g{(const bf16_t*)(p.ws + OFF_CAT), (const bf16_t*)(p.ws + OFF_WOUTE) + (size_t)j * 1024 * 1024, T_ALL, 1024, 1024};
                EpiResid E{p, l, 8};
                pg8::StaticOrder S; S.init(g.M, g.N, G, bid);
                pg8::gemm_phase(lds, g, S, E);
            } break;
            case 4: {
                if (!odd) {
                    pg8::Gemm g{hbuf, (const bf16_t*)(p.ws + OFF_WINE) + (size_t)j * 2304 * 1024, T_ALL, 2304, 1024};
                    pg8::StaticOrder S; S.init(g.M, g.N, G, bid);
                    EpiBf16 E{(bf16_t*)(p.ws + OFF_PROJ), PROJ_LD, (const float*)(p.ws + OFF_RSP), (const float*)(p.ws + OFF_BIAS) + (size_t)(l * 3 + 1) * 9 * 5632};
                    pg8::gemm_phase(lds, g, S, E);
                } else {
                    pg8::Gemm g{hbuf, (const bf16_t*)(p.ws + OFF_WINO) + (size_t)j * 4096 * 1024, T_ALL, 4096, 1024};
                    pg8::StaticOrder S; S.init(g.M, g.N, G, bid);
                    EpiGeluUV E{(bf16_t*)(p.ws + OFF_UV), (float*)(p.ws + OFF_SSP), (const float*)(p.ws + OFF_RSP), (const float*)(p.ws + OFF_BIAS) + (size_t)(l * 3 + 1) * 9 * 5632};
                    pg8::gemm_phase(lds, g, S, E);
                }
            } break;
            case 5: {
                if (!odd) even2_phase(p, lds, j);
                else for (int t = bid; t < 2048; t += G) spatial_tile(p, lds, j, t);
            } break;
            case 7: {
                for (int t = bid; t < 2304; t += G) kprep_tile(p, lds, j, t);
            } break;
            case 8: {
                if (G == 256) {
                    const int xcd = bid & 7, slot = bid >> 3;
                    attn_tile(p, lds, j, (xcd * 8 + (slot >> 2)) * 4 + (slot & 3)); __syncthreads();
                    attn_tile(p, lds, j, 256 + xcd * 32 + slot); __syncthreads();
                } else {
                    for (int t = bid; t < 512; t += G) { attn_tile(p, lds, j, t); __syncthreads(); }
                }
                gla_finish_rows(p, j);
            } break;
            default: break;
        }
    }
}


extern "C" void kernel_launch(void* const* d_in, const int* in_sizes, int n_in, void* d_out, int out_size, void* d_ws, size_t ws_size, hipStream_t stream) {
    constexpr size_t kDynLds = 131072;
    static int grid_blocks = 0;
    if (!grid_blocks) {
        hipFuncSetAttribute((const void*)mega, hipFuncAttributeMaxDynamicSharedMemorySize, (int)kDynLds);
        int dev = 0, cus = 0, per_cu = 0;
        hipGetDevice(&dev);
        hipDeviceGetAttribute(&cus, hipDeviceAttributeMultiprocessorCount, dev);
        hipOccupancyMaxActiveBlocksPerMultiprocessor(&per_cu, mega, 512, kDynLds);
        if (per_cu < 1) per_cu = 1;
        if (per_cu > 1) per_cu = 1;
        grid_blocks = cus * per_cu;
    }
    Params p{};
    for (int i = 0; i < 32; ++i) p.in[i] = (const float*)d_in[i];
    p.out = (float*)d_out; p.ws = (unsigned char*)d_ws; p.ph_begin = 0; p.ph_end = NPH;
    hipMemsetAsync((unsigned char*)d_ws + OFF_BAR, 0, XCD_BAR_WORDS * sizeof(unsigned), stream);
    void* args[] = {&p};
    hipError_t e = hipLaunchCooperativeKernel((void*)mega, dim3(grid_blocks), dim3(512), args, kDynLds, stream);
    if (e != hipSuccess) fprintf(stderr, "cooperative launch failed: %s (grid %d)\n", hipGetErrorString(e), grid_blocks);
}
```

```cpp
#include <hip/hip_runtime.h>
#include <hip/hip_cooperative_groups.h>
#include <cstdio>
namespace cg = cooperative_groups;

#define LAS __attribute__((address_space(3)))
typedef unsigned short bf16_t;
typedef short bf16x8 __attribute__((ext_vector_type(8)));
typedef short bf16x4 __attribute__((ext_vector_type(4)));
typedef float f32x4 __attribute__((ext_vector_type(4)));
typedef float f32x2 __attribute__((ext_vector_type(2)));
typedef unsigned u32x4 __attribute__((ext_vector_type(4)));
typedef unsigned u32x2 __attribute__((ext_vector_type(2)));

constexpr int T_CTX = 8192, T_ALL = 16384, T_KV = 18432;
constexpr int PROJ_LD = 2304;
constexpr float EPS = 1e-6f;


constexpr size_t SZ_WGU = (size_t)4 * 5632 * 1024 * 2, SZ_WD = (size_t)4 * 1024 * 2816 * 2;
constexpr size_t OFF_WGU1 = 0;
constexpr size_t OFF_WD1 = OFF_WGU1 + SZ_WGU;
constexpr size_t OFF_WGU2 = OFF_WD1 + SZ_WD;
constexpr size_t OFF_WD2 = OFF_WGU2 + SZ_WGU;
constexpr size_t OFF_WINE = OFF_WD2 + SZ_WD;
constexpr size_t OFF_WOUTE = OFF_WINE + (size_t)2 * 2304 * 1024 * 2;
constexpr size_t OFF_WQB = OFF_WOUTE + (size_t)2 * 1024 * 1024 * 2;
constexpr size_t OFF_WKVB = OFF_WQB + (size_t)2 * 768 * 384 * 2;
constexpr size_t OFF_WINO = OFF_WKVB + (size_t)2 * 1024 * 256 * 2;
constexpr size_t OFF_WOUTO = OFF_WINO + (size_t)2 * 4096 * 1024 * 2;
constexpr size_t OFF_WS = OFF_WOUTO + (size_t)2 * 1024 * 2048 * 2;
constexpr size_t OFF_MOD = OFF_WS + (size_t)2 * 4 * 128 * 128 * 2;
constexpr size_t OFF_H = OFF_MOD + (size_t)4 * 9 * 9216 * 4;
constexpr size_t OFF_U = OFF_H + (size_t)T_ALL * 1024 * 2;
constexpr size_t OFF_ACT = OFF_U;
constexpr size_t OFF_PROJ = OFF_U;
constexpr size_t OFF_CQN = OFF_PROJ + (size_t)T_ALL * PROJ_LD * 2;
constexpr size_t OFF_CKVN = OFF_CQN + (size_t)T_ALL * 384 * 2;
constexpr size_t OFF_QRAW = OFF_CKVN + (size_t)T_KV * 256 * 2;
constexpr size_t OFF_KVRAW = OFF_QRAW + (size_t)T_ALL * 768 * 2;
constexpr size_t OFF_OF = OFF_KVRAW + (size_t)T_KV * 1024 * 2;
constexpr size_t OFF_OB = OFF_OF + (size_t)T_ALL * 512 * 4;
constexpr size_t OFF_CAT = OFF_OB + (size_t)T_ALL * 512 * 4;
constexpr size_t OFF_UV = OFF_U;
constexpr size_t OFF_GATED = OFF_UV + (size_t)T_ALL * 4096 * 2;
constexpr size_t OFF_SSP = OFF_GATED + (size_t)T_ALL * 2048 * 2;

constexpr size_t OFF_BIAS = (size_t)522 << 20;
constexpr size_t OFF_RSP = (size_t)526 << 20;
constexpr size_t OFF_KN = (size_t)456 << 20;
constexpr size_t OFF_VT = (size_t)484 << 20;
constexpr size_t VT_LAT = (size_t)32 * 8 * 64 * 256;
constexpr size_t OUT_CKV = 16777216, OUT_KROPE = 20971520, OUT_GLA = 21495808;

struct Params {
    const float* in[32];
    float* out;
    unsigned char* ws;
    int ph_begin, ph_end;
};

__device__ __forceinline__ int otid() { int t = threadIdx.x; asm volatile("" : "+v"(t)); return t; }
__device__ __forceinline__ int obid() { int t = blockIdx.x; asm volatile("" : "+s"(t)); return t; }
__device__ __forceinline__ int ogrid() { int t = gridDim.x; asm volatile("" : "+s"(t)); return t; }
__device__ __forceinline__ const float* pin(const Params& p, int i) { asm volatile("" : "+s"(i)); return p.in[i]; }
typedef __bf16 bf16x2_t __attribute__((ext_vector_type(2)));
__device__ __forceinline__ unsigned cvt_pk_bf16(float lo, float hi) { const f32x2 v = {lo, hi}; return __builtin_bit_cast(unsigned, __builtin_convertvector(v, bf16x2_t)); }
__device__ __forceinline__ unsigned pack_bf16_sw(float lo, float hi) {
    unsigned a = __float_as_uint(lo), b = __float_as_uint(hi);
    a += 0x7fffu + ((a >> 16) & 1u); b += 0x7fffu + ((b >> 16) & 1u);
    return (a >> 16) | (b & 0xffff0000u);
}
__device__ __forceinline__ bf16_t f2bf(float f) { return (bf16_t)(cvt_pk_bf16(f, 0.f) & 0xffffu); }
__device__ __forceinline__ float bf2f(bf16_t b) { return __uint_as_float(((unsigned)b) << 16); }
__device__ __forceinline__ float bflo(unsigned w) { return __uint_as_float(w << 16); }
__device__ __forceinline__ float bfhi(unsigned w) { return __uint_as_float(w & 0xffff0000u); }
__device__ __forceinline__ float silu_f(float x) { return x * __builtin_amdgcn_rcpf(1.f + __expf(-x)); }
__device__ __forceinline__ float gelu_tanh_f(float x) { const float u = 1.5957691216f * (x + 0.044715f * x * x * x); return x * __builtin_amdgcn_rcpf(1.f + __expf(-u)); }
__device__ __forceinline__ float wave_sum(float v) {
    v += __shfl_xor(v, 1); v += __shfl_xor(v, 2); v += __shfl_xor(v, 4); v += __shfl_xor(v, 8); v += __shfl_xor(v, 16); v += __shfl_xor(v, 32); return v; }

namespace pg8 {
constexpr int BM = 256, BK = 64, HALF = 128, HTB = HALF * BK * 2, STAGE_BYTES = 8 * HTB, NXCD = 8, WGM = 8;
__device__ __forceinline__ int lds_byte(int r, int c) { const int st = (r >> 4) * 2 + (c >> 5), rr = r & 15, cc = c & 31, ob = rr * 64 + cc * 2; return st * 1024 + (ob ^ (((ob >> 9) & 1) << 5)); }
__device__ __forceinline__ void stage_rc(int b, int& R, int& C) { const int st = b / 1024, sb = b % 1024, swz = sb ^ (((sb >> 9) & 1) << 5); R = (st >> 1) * 16 + swz / 64; C = (st & 1) * 32 + (swz % 64) / 2; }
__device__ __forceinline__ int perm32(int rho) { const int n = rho >> 4, i = rho & 15; return 8 * (i >> 2) + 4 * n + (i & 3); }
struct Unit { int pm, pn; };
struct Gemm { const bf16_t* A; const bf16_t* Bt; int M, N, K; };
struct StaticOrder {
    int nM, nN, nwg, G, c;
    __device__ void init(int M, int N, int G_, int c_) { nM = M / BM; nN = N / BM; nwg = nM * nN; G = G_; c = c_; }
    __device__ bool next(int i, Unit& u) const {
        const long L = (long)i * G + c; if (L >= nwg) return false;
        int wgid = (int)L; { const int q = nwg / NXCD, r = nwg % NXCD, xcd = wgid % NXCD, off = wgid / NXCD; wgid = (xcd < r ? xcd * (q + 1) : r * (q + 1) + (xcd - r) * q) + off; }
        const int nig = WGM * nN, gid = wgid / nig, fm = gid * WGM, gsz = (nM - fm) < WGM ? (nM - fm) : WGM;
        u.pm = fm + ((wgid % nig) % gsz); u.pn = (wgid % nig) / gsz; return true;
    }
};

template <class Epi>
__device__ __forceinline__ void gemm_phase(LAS unsigned char* lds, const Gemm g, const StaticOrder& S, const Epi& E) {
    const int tid = otid(), wid = __builtin_amdgcn_readfirstlane(tid >> 6), lane = tid & 63, wr = wid >> 2, wc = wid & 3, fr = lane & 15, fq = lane >> 4;
    const int K = g.K, nt = K / BK;
    unsigned voffA[2], voffB[2];
#pragma unroll
    for (int i = 0; i < 2; ++i) { int R, C; stage_rc(tid * 16 + i * 8192, R, C); const int Rb = Epi::PERM ? ((R & ~31) + perm32(R & 31)) : R;
        voffA[i] = (unsigned)(R * K + C) * 2u; voffB[i] = (unsigned)(Rb * K + C) * 2u; }
    const size_t kstep = (size_t)(BK * 2);
    const size_t hstep = (size_t)HALF * K * 2;
    const size_t tstep = 2 * hstep;
    const unsigned ldsw = (unsigned)wid * 1024u;
    const int aoff = lds_byte(wr * 64 + fr, fq * 8), boff = lds_byte(wc * 32 + fr, fq * 8);
#define PG8_SA(b, h) (((b) * 2 + (h)) * HTB)
#define PG8_SB(b, h) ((4 + (b) * 2 + (h)) * HTB)
#define PG8_STAGE(bufoff, gbase, voff) do { _Pragma("unroll") for (int _i = 0; _i < 2; ++_i) \
        __builtin_amdgcn_global_load_lds((const unsigned*)((const char*)(gbase) + (voff)[_i]), (LAS unsigned*)(lds + (bufoff) + ldsw + _i * 8192), 16, 0, 0); } while (0)
#define PG8_LDA(dst, b, h) do { _Pragma("unroll") for (int m = 0; m < 4; ++m) _Pragma("unroll") for (int k = 0; k < 2; ++k) dst[m][k] = *(const LAS bf16x8*)(lds + PG8_SA(b, h) + aoff + m * 2048 + k * 1024); } while (0)
#define PG8_LDB(dst, b, h) do { _Pragma("unroll") for (int n = 0; n < 2; ++n) _Pragma("unroll") for (int k = 0; k < 2; ++k) dst[n][k] = *(const LAS bf16x8*)(lds + PG8_SB(b, h) + boff + n * 2048 + k * 1024); } while (0)
#define PG8_MMA(ai, bj, At, Bt) do { __builtin_amdgcn_s_setprio(1); _Pragma("unroll") for (int m = 0; m < 4; ++m) _Pragma("unroll") for (int n = 0; n < 2; ++n) _Pragma("unroll") for (int k = 0; k < 2; ++k) \
        acc[ai][bj][m][n] = __builtin_amdgcn_mfma_f32_16x16x32_bf16(Bt[n][k], At[m][k], acc[ai][bj][m][n], 0, 0, 0); __builtin_amdgcn_s_setprio(0); } while (0)
#define PG8_WAIT_V(n) asm volatile("s_waitcnt vmcnt(" #n ")" ::: "memory")
#define PG8_WAIT_L(n) asm volatile("s_waitcnt lgkmcnt(" #n ")" ::: "memory")
#define PG8_BAR __builtin_amdgcn_s_barrier()
#define PG8_SCHED __builtin_amdgcn_sched_barrier(0)
    Unit cur, nxt; int ui = 0;
    if (!S.next(0, cur)) return;
    f32x4 acc[2][2][4][2];
#pragma unroll
    for (int a = 0; a < 2; ++a)
#pragma unroll
        for (int b = 0; b < 2; ++b)
#pragma unroll
            for (int m = 0; m < 4; ++m)
#pragma unroll
                for (int n = 0; n < 2; ++n) acc[a][b][m][n] = (f32x4){0.f, 0.f, 0.f, 0.f};
    bf16x8 At[4][2], B0[2][2], B1[2][2];
    const char* cA = (const char*)g.A + (size_t)cur.pm * tstep; const char* cB = (const char*)g.Bt + (size_t)cur.pn * tstep;
    PG8_STAGE(PG8_SB(0, 0), cB, voffB); PG8_STAGE(PG8_SA(0, 0), cA, voffA); PG8_STAGE(PG8_SB(0, 1), cB + hstep, voffB); PG8_STAGE(PG8_SA(0, 1), cA + hstep, voffA);
    if (wr == 1) PG8_BAR;
    PG8_WAIT_V(4); PG8_BAR;
    PG8_STAGE(PG8_SB(1, 0), cB + kstep, voffB); PG8_STAGE(PG8_SA(1, 0), cA + kstep, voffA); PG8_STAGE(PG8_SB(1, 1), cB + hstep + kstep, voffB);
    PG8_WAIT_V(6); PG8_BAR;
    for (;;) {
        const bool has_next = S.next(ui + 1, nxt);
        const char* nA = has_next ? (const char*)g.A + (size_t)nxt.pm * tstep : cA; const char* nB = has_next ? (const char*)g.Bt + (size_t)nxt.pn * tstep : cB;
        for (int t = 0; t < nt; t += 2) {
            const bool last = (t == nt - 2);
            const char* a1 = cA + (size_t)(t + 1) * kstep;
            const char* a2 = last ? nA : cA + (size_t)(t + 2) * kstep; const char* b2 = last ? nB : cB + (size_t)(t + 2) * kstep;
            const char* a3 = a2 + kstep; const char* b3 = b2 + kstep;
            PG8_LDB(B0, 0, 0); PG8_SCHED; PG8_LDA(At, 0, 0); PG8_STAGE(PG8_SA(1, 1), a1 + hstep, voffA);
            PG8_WAIT_L(8); PG8_BAR; PG8_WAIT_L(0); PG8_MMA(0, 0, At, B0); PG8_BAR; PG8_SCHED;
            PG8_LDB(B1, 0, 1); PG8_STAGE(PG8_SB(0, 0), b2, voffB);
            PG8_BAR; PG8_WAIT_L(0); PG8_MMA(0, 1, At, B1); PG8_BAR;
            PG8_LDA(At, 0, 1); PG8_STAGE(PG8_SA(0, 0), a2, voffA);
            PG8_BAR; PG8_WAIT_L(0); PG8_MMA(1, 0, At, B0); PG8_BAR; PG8_SCHED;
            PG8_STAGE(PG8_SB(0, 1), b2 + hstep, voffB);
            PG8_WAIT_V(6); PG8_BAR; PG8_MMA(1, 1, At, B1); PG8_BAR;
            PG8_LDB(B0, 1, 0); PG8_SCHED; PG8_LDA(At, 1, 0); PG8_STAGE(PG8_SA(0, 1), a2 + hstep, voffA);
            PG8_WAIT_L(8); PG8_BAR; PG8_WAIT_L(0); PG8_MMA(0, 0, At, B0); PG8_BAR; PG8_SCHED;
            PG8_LDB(B1, 1, 1); PG8_STAGE(PG8_SB(1, 0), b3, voffB);
            PG8_BAR; PG8_WAIT_L(0); PG8_MMA(0, 1, At, B1); PG8_BAR;
            PG8_LDA(At, 1, 1); PG8_STAGE(PG8_SA(1, 0), a3, voffA);
            PG8_BAR; PG8_WAIT_L(0); PG8_MMA(1, 0, At, B0); PG8_BAR; PG8_SCHED;
            PG8_STAGE(PG8_SB(1, 1), b3 + hstep, voffB);
            PG8_WAIT_V(6); PG8_BAR; PG8_MMA(1, 1, At, B1); PG8_BAR;
        }
        E(acc, cur, wr, wc, fr, fq);
        if (!has_next) break;
#pragma unroll
        for (int a = 0; a < 2; ++a)
#pragma unroll
            for (int b = 0; b < 2; ++b)
#pragma unroll
                for (int m = 0; m < 4; ++m)
#pragma unroll
                    for (int n = 0; n < 2; ++n) acc[a][b][m][n] = (f32x4){0.f, 0.f, 0.f, 0.f};
        cur = nxt; cA = nA; cB = nB; ++ui;
    }
    PG8_WAIT_V(0);
    if (wr == 0) PG8_BAR;
    PG8_BAR;
#undef PG8_SA
#undef PG8_SB
#undef PG8_STAGE
#undef PG8_LDA
#undef PG8_LDB
#undef PG8_MMA
#undef PG8_WAIT_V
#undef PG8_WAIT_L
#undef PG8_BAR
#undef PG8_SCHED
}
}
using pg8::Unit;


struct Rstd8 { float v[2][4]; };
__device__ __forceinline__ Rstd8 load_rstd8(const float* rsp, int row0, int fq) {
    f32x4 pv[2][4]; Rstd8 r;
#pragma unroll
    for (int ai = 0; ai < 2; ++ai)
#pragma unroll
        for (int m = 0; m < 4; ++m) pv[ai][m] = *(const f32x4*)(rsp + (size_t)(row0 + ai * 128 + m * 16) * 16 + fq * 4);
#pragma unroll
    for (int ai = 0; ai < 2; ++ai)
#pragma unroll
        for (int m = 0; m < 4; ++m) {
            float t = pv[ai][m][0] + pv[ai][m][1] + pv[ai][m][2] + pv[ai][m][3];
            t += __shfl_xor(t, 16); t += __shfl_xor(t, 32);
            r.v[ai][m] = rsqrtf(t * (1.f / 1024.f) + EPS);
        }
    return r;
}
struct EpiSwiGLU {
    static constexpr bool PERM = true;
    bf16_t* O; const float* rsp; const float* bias;
    __device__ __forceinline__ void operator()(const f32x4 (&acc)[2][2][4][2], const Unit& u, int wr, int wc, int fr, int fq) const {
        const int cond = u.pm < 32 ? 0 : 1 + ((u.pm - 32) >> 2);
        const int row0 = u.pm * 256 + wr * 64 + fr, col0 = u.pn * 128 + wc * 32 + 8 * fq;
        const Rstd8 R = load_rstd8(rsp, row0, fq);
        const float* bp = bias + (size_t)cond * 5632 + u.pn * 256 + wc * 32 + 8 * fq;
        const f32x4 bg0 = *(const f32x4*)bp, bg1 = *(const f32x4*)(bp + 4), bu0 = *(const f32x4*)(bp + 128), bu1 = *(const f32x4*)(bp + 132);
#pragma unroll
        for (int ai = 0; ai < 2; ++ai)
#pragma unroll
            for (int m = 0; m < 4; ++m) {
                bf16_t* rowp = O + (size_t)(row0 + ai * 128 + m * 16) * 2816 + col0;
                const float rs = R.v[ai][m];
                f32x4 v0, v1;
#pragma unroll
                for (int j = 0; j < 4; ++j) {
                    v0[j] = silu_f(acc[ai][0][m][0][j] * rs + bg0[j]) * (acc[ai][1][m][0][j] * rs + bu0[j]);
                    v1[j] = silu_f(acc[ai][0][m][1][j] * rs + bg1[j]) * (acc[ai][1][m][1][j] * rs + bu1[j]);
                }
                u32x4 w; w.x = cvt_pk_bf16(v0[0], v0[1]); w.y = cvt_pk_bf16(v0[2], v0[3]); w.z = cvt_pk_bf16(v1[0], v1[1]); w.w = cvt_pk_bf16(v1[2], v1[3]);
                *(u32x4*)rowp = w;
            }
    }
};
struct EpiResid {
    static constexpr bool PERM = false;
    const Params& p; int l; int kind;
    __device__ __forceinline__ void operator()(const f32x4 (&acc)[2][2][4][2], const Unit& u, int wr, int wc, int fr, int fq) const {
        float* X = p.out; const float* mod = (const float*)(p.ws + OFF_MOD);
        const int gidx = kind == 2 ? 2 : (kind == 11 ? 8 : 5);
        const float coef = (kind == 2 || kind == 11) ? 0.5f : 1.0f;
        const float* gate = mod + (size_t)l * 9 * 9216 + gidx * 1024;
        const bool nn = !(kind == 11 && l == 3);
        const int nl = kind == 11 ? (l < 3 ? l + 1 : l) : l, ns = kind == 2 ? 1 : (kind == 11 ? 0 : 2);
        const float* ng = pin(p, 9) + (size_t)(nl * 3 + ns) * 1024;
        const float* msc = mod + (size_t)nl * 9 * 9216 + (size_t)(3 * ns + 1) * 1024;
        bf16_t* H = (bf16_t*)(p.ws + OFF_H); float* rsp = (float*)(p.ws + OFF_RSP);
        const int cond = u.pm < 32 ? 0 : 1 + ((u.pm - 32) >> 2);
        const float* gp = gate + (size_t)cond * 9216;
        const int row0 = u.pm * 256 + wr * 64 + fr, col0 = u.pn * 256 + wc * 32 + 4 * fq;
        f32x4 gv[2][2], gs[2][2];
#pragma unroll
        for (int bj = 0; bj < 2; ++bj)
#pragma unroll
            for (int n = 0; n < 2; ++n) {
                gv[bj][n] = *(const f32x4*)(gp + col0 + bj * 128 + n * 16) * coef;
                gs[bj][n] = (f32x4){0.f, 0.f, 0.f, 0.f};
                if (nn) gs[bj][n] = *(const f32x4*)(ng + col0 + bj * 128 + n * 16) * (*(const f32x4*)(msc + (size_t)cond * 9216 + col0 + bj * 128 + n * 16) + 1.f);
            }
#pragma unroll
        for (int ai = 0; ai < 2; ++ai)
#pragma unroll
            for (int mp = 0; mp < 2; ++mp) {
                f32x4 xv[2][2][2];
#pragma unroll
                for (int mi = 0; mi < 2; ++mi)
#pragma unroll
                    for (int bj = 0; bj < 2; ++bj)
#pragma unroll
                        for (int n = 0; n < 2; ++n) xv[mi][bj][n] = *(const f32x4*)(X + (size_t)(row0 + ai * 128 + (mp * 2 + mi) * 16) * 1024 + col0 + bj * 128 + n * 16);
#pragma unroll
                for (int mi = 0; mi < 2; ++mi) {
                    const int m = mp * 2 + mi;
                    const int row = row0 + ai * 128 + m * 16;
                    float* rowp = X + (size_t)row * 1024 + col0;
                    float ss = 0.f;
#pragma unroll
                    for (int bj = 0; bj < 2; ++bj)
#pragma unroll
                        for (int n = 0; n < 2; ++n) {
                            const f32x4 xn = xv[mi][bj][n] + gv[bj][n] * acc[ai][bj][m][n];
                            *(f32x4*)(rowp + bj * 128 + n * 16) = xn;
                            if (nn) {
                                ss += xn[0] * xn[0] + xn[1] * xn[1] + xn[2] * xn[2] + xn[3] * xn[3];
                                const f32x4 hv = xn * gs[bj][n];
                                u32x2 w; w.x = cvt_pk_bf16(hv[0], hv[1]); w.y = cvt_pk_bf16(hv[2], hv[3]);
                                *(u32x2*)(H + (size_t)row * 1024 + col0 + bj * 128 + n * 16) = w;
                            }
                        }
                    if (nn) { ss += __shfl_xor(ss, 16); ss += __shfl_xor(ss, 32); if (fq == 0) rsp[(size_t)row * 16 + u.pn * 4 + wc] = ss; }
                }
            }
    }
};
struct EpiBf16 {
    static constexpr bool PERM = true;
    bf16_t* O; int ldc; const float* rsp; const float* bias;
    __device__ __forceinline__ void operator()(const f32x4 (&acc)[2][2][4][2], const Unit& u, int wr, int wc, int fr, int fq) const {
        const int row0 = u.pm * 256 + wr * 64 + fr, col0 = u.pn * 256 + wc * 32 + 8 * fq;
        const bool nn = rsp != nullptr;
        f32x4 b0[2], b1[2]; Rstd8 R;
#pragma unroll
        for (int bj = 0; bj < 2; ++bj) { b0[bj] = (f32x4){0.f, 0.f, 0.f, 0.f}; b1[bj] = b0[bj]; }
#pragma unroll
        for (int ai = 0; ai < 2; ++ai)
#pragma unroll
            for (int m = 0; m < 4; ++m) R.v[ai][m] = 1.f;
        if (nn) {
            const int cond = u.pm < 32 ? 0 : 1 + ((u.pm - 32) >> 2);
            R = load_rstd8(rsp, row0, fq);
#pragma unroll
            for (int bj = 0; bj < 2; ++bj) { const float* bp = bias + (size_t)cond * 5632 + col0 + bj * 128; b0[bj] = *(const f32x4*)bp; b1[bj] = *(const f32x4*)(bp + 4); }
        }
#pragma unroll
        for (int ai = 0; ai < 2; ++ai)
#pragma unroll
            for (int m = 0; m < 4; ++m) {
                bf16_t* rowp = O + (size_t)(row0 + ai * 128 + m * 16) * ldc + col0;
                const float rs = R.v[ai][m];
#pragma unroll
                for (int bj = 0; bj < 2; ++bj) {
                    const f32x4 v0 = acc[ai][bj][m][0] * rs + b0[bj], v1 = acc[ai][bj][m][1] * rs + b1[bj];
                    u32x4 w; w.x = cvt_pk_bf16(v0[0], v0[1]); w.y = cvt_pk_bf16(v0[2], v0[3]); w.z = cvt_pk_bf16(v1[0], v1[1]); w.w = cvt_pk_bf16(v1[2], v1[3]);
                    *(u32x4*)(rowp + bj * 128) = w;
                }
            }
    }
};
struct EpiGeluUV {
    static constexpr bool PERM = true;
    bf16_t* O; float* ssp; const float* rsp; const float* bias;
    __device__ __forceinline__ void operator()(const f32x4 (&acc)[2][2][4][2], const Unit& u, int wr, int wc, int fr, int fq) const {
        const int cond = u.pm < 32 ? 0 : 1 + ((u.pm - 32) >> 2);
        const int row0 = u.pm * 256 + wr * 64 + fr, col0 = u.pn * 256 + wc * 32 + 8 * fq;
        const Rstd8 R = load_rstd8(rsp, row0, fq);
        f32x4 b0[2], b1[2];
#pragma unroll
        for (int bj = 0; bj < 2; ++bj) { const float* bp = bias + (size_t)cond * 5632 + col0 + bj * 128; b0[bj] = *(const f32x4*)bp; b1[bj] = *(const f32x4*)(bp + 4); }
#pragma unroll
        for (int ai = 0; ai < 2; ++ai)
#pragma unroll
            for (int m = 0; m < 4; ++m) {
                const int row = row0 + ai * 128 + m * 16;
                bf16_t* rowp = O + (size_t)row * 4096 + col0;
                const float rs = R.v[ai][m];
                float ss = 0.f;
#pragma unroll
                for (int bj = 0; bj < 2; ++bj) {
                    f32x4 v0, v1;
#pragma unroll
                    for (int j = 0; j < 4; ++j) { v0[j] = gelu_tanh_f(acc[ai][bj][m][0][j] * rs + b0[bj][j]); v1[j] = gelu_tanh_f(acc[ai][bj][m][1][j] * rs + b1[bj][j]); ss += v0[j] * v0[j] + v1[j] * v1[j]; }
                    u32x4 w; w.x = cvt_pk_bf16(v0[0], v0[1]); w.y = cvt_pk_bf16(v0[2], v0[3]); w.z = cvt_pk_bf16(v1[0], v1[1]); w.w = cvt_pk_bf16(v1[2], v1[3]);
                    *(u32x4*)(rowp + bj * 128) = w;
                }
                if (u.pn >= 8) { ss += __shfl_xor(ss, 16); ss += __shfl_xor(ss, 32); if (fq == 0) ssp[(size_t)row * 32 + (u.pn - 8) * 4 + wc] = ss; }
            }
    }
};

struct TJob { int src; int batch, K, N; unsigned long long dst; int rows_pb, blk, blk_stride, off; };
__device__ const TJob g_jobs[12] = {
    {10, 4, 1024, 2816, OFF_WGU1, 5632, 128, 256, 0},
    {11, 4, 1024, 2816, OFF_WGU1, 5632, 128, 256, 128},
    {12, 4, 2816, 1024, OFF_WD1, 1024, 1024, 1024, 0},
    {13, 4, 1024, 2816, OFF_WGU2, 5632, 128, 256, 0},
    {14, 4, 1024, 2816, OFF_WGU2, 5632, 128, 256, 128},
    {15, 4, 2816, 1024, OFF_WD2, 1024, 1024, 1024, 0},
    {16, 2, 1024, 2240, OFF_WINE, 2304, 4096, 4096, 0},
    {17, 2, 1024, 1024, OFF_WOUTE, 1024, 1024, 1024, 0},
    {22, 2, 384, 768, OFF_WQB, 768, 1024, 1024, 0},
    {24, 2, 256, 1024, OFF_WKVB, 1024, 1024, 1024, 0},
    {27, 2, 1024, 4096, OFF_WINO, 4096, 4096, 4096, 0},
    {31, 2, 2048, 1024, OFF_WOUTO, 1024, 1024, 1024, 0}};
__device__ __forceinline__ TJob get_job(int j) { return g_jobs[j]; }
constexpr int NJOBS = 12;
__device__ __forceinline__ int job_tiles(const TJob& J) { return J.batch * (J.K / 128) * ((J.N + 127) / 128); }

__device__ __forceinline__ void tt_load(const Params& p, const TJob& J, int t, int tid, f32x4 (&va)[4], f32x4 (&vb)[4]) {
    const int nk = J.K / 128, nn = (J.N + 127) / 128;
    const int bt = t / (nk * nn), rem = t % (nk * nn), kt = rem / nn, ntile = rem % nn;
    const float* src = pin(p, J.src) + (size_t)bt * J.K * J.N + (size_t)(kt * 128) * J.N + ntile * 128;
    const int c4 = tid & 31, r0 = tid >> 5;
    const bool colok = (ntile * 128 + c4 * 4) < J.N;
#pragma unroll
    for (int i = 0; i < 4; ++i) {
        const int k = 2 * (r0 + 16 * i);
        if (colok) { va[i] = *(const f32x4*)(src + (size_t)k * J.N + c4 * 4); vb[i] = *(const f32x4*)(src + (size_t)(k + 1) * J.N + c4 * 4); }
        else { va[i] = (f32x4){0.f, 0.f, 0.f, 0.f}; vb[i] = va[i]; }
    }
}
__device__ __forceinline__ void tt_process(const Params& p, LAS unsigned char* lds, const TJob& J, int t, int tid, const f32x4 (&va)[4], const f32x4 (&vb)[4]) {
    const int nk = J.K / 128, nn = (J.N + 127) / 128;
    const int bt = t / (nk * nn), rem = t % (nk * nn), kt = rem / nn, ntile = rem % nn;
    LAS unsigned* sT = (LAS unsigned*)lds;
    const int c4 = tid & 31, r0 = tid >> 5;
#pragma unroll
    for (int i = 0; i < 4; ++i) {
        const int k2 = r0 + 16 * i;
#pragma unroll
        for (int e = 0; e < 4; ++e) sT[(c4 * 4 + e) * 65 + k2] = cvt_pk_bf16(va[i][e], vb[i][e]);
    }
    __syncthreads();
    bf16_t* dstb = (bf16_t*)(p.ws + J.dst) + (size_t)bt * J.rows_pb * J.K + kt * 128;
    const int k8 = tid & 15, nr = tid >> 4;
#pragma unroll
    for (int i = 0; i < 4; ++i) {
        const int nl = nr + 32 * i, n = ntile * 128 + nl;
        if (n < J.N) {
            u32x4 w; w.x = sT[nl * 65 + k8 * 4]; w.y = sT[nl * 65 + k8 * 4 + 1]; w.z = sT[nl * 65 + k8 * 4 + 2]; w.w = sT[nl * 65 + k8 * 4 + 3];
            const int drow = (n / J.blk) * J.blk_stride + (n % J.blk) + J.off;
            *(u32x4*)(dstb + (size_t)drow * J.K + k8 * 8) = w;
        }
    }
    __syncthreads();
}
__device__ __forceinline__ void transpose_job(const Params& p, LAS unsigned char* lds, const TJob& J, int t0, int nt, int G) {
    const int tid = otid();
    for (int t = t0; t < nt; t += 4 * G) {
        f32x4 va[4][4], vb[4][4];
#pragma unroll
        for (int q = 0; q < 4; ++q) if (t + q * G < nt) tt_load(p, J, t + q * G, tid, va[q], vb[q]);
#pragma unroll
        for (int q = 0; q < 4; ++q) if (t + q * G < nt) tt_process(p, lds, J, t + q * G, tid, va[q], vb[q]);
    }
}

__device__ __forceinline__ void mod_tile(const Params& p, LAS unsigned char* lds, int t) {
    const int tid = otid();
    const int l = t / 72, n0 = (t % 72) * 128;
    LAS float* sC = (LAS float*)lds;
    LAS float* sR = (LAS float*)(lds + 36864);
    { const float* cctx = pin(p, 3); const float* cc = pin(p, 2);
      for (int i = tid; i < 9 * 1024; i += 512) { const int c = i >> 10, k = i & 1023; const float v = c == 0 ? cctx[k] : cc[(c - 1) * 1024 + k]; sC[i] = silu_f(v); } }
    __syncthreads();
    const int cgp = tid & 31, ks = tid >> 5;
    const float* w = pin(p, 7) + (size_t)l * 1024 * 9216 + (size_t)(ks * 64) * 9216 + n0 + cgp * 4;
    f32x4 acc[9];
#pragma unroll
    for (int c = 0; c < 9; ++c) acc[c] = (f32x4){0.f, 0.f, 0.f, 0.f};
    for (int k0 = 0; k0 < 64; k0 += 8) {
        f32x4 wv[8];
#pragma unroll
        for (int i = 0; i < 8; ++i) wv[i] = *(const f32x4*)(w + (size_t)(k0 + i) * 9216);
#pragma unroll
        for (int i = 0; i < 8; ++i)
#pragma unroll
            for (int c = 0; c < 9; ++c) acc[c] += wv[i] * sC[c * 1024 + ks * 64 + k0 + i];
    }
#pragma unroll
    for (int c = 0; c < 9; ++c) *(LAS f32x4*)(sR + (ks * 9 + c) * 128 + cgp * 4) = acc[c];
    __syncthreads();
    float* mod = (float*)(p.ws + OFF_MOD);
    const float* adab = pin(p, 8);
    for (int i = tid; i < 9 * 128; i += 512) {
        const int c = i >> 7, col = i & 127;
        float s = adab[l * 9216 + n0 + col];
#pragma unroll
        for (int k = 0; k < 16; ++k) s += sR[(k * 9 + c) * 128 + col];
        mod[((size_t)l * 9 + c) * 9216 + n0 + col] = s;
    }
    __syncthreads();
}

__device__ __forceinline__ void prologue_phase(const Params& p, LAS unsigned char* lds) {
    const int tid = otid(), G = ogrid(), bid = obid();
    for (int t = bid; t < 288; t += G) mod_tile(p, lds, t);
    {
        const float* s = pin(p, 29); bf16_t* d = (bf16_t*)(p.ws + OFF_WS);
        for (int i = bid * 512 + tid; i < 2 * 4 * 128 * 128 / 2; i += G * 512) ((unsigned*)d)[i] = cvt_pk_bf16(s[2 * i], s[2 * i + 1]);
    }
    int base = 0;
    for (int j = 0; j < NJOBS; ++j) {
        const TJob J = get_job(j); const int nt = job_tiles(J);
        transpose_job(p, lds, J, (bid + G - (base % G)) % G, nt, G);
        base += nt;
    }
}


__device__ __forceinline__ void prologue_b(const Params& p, LAS unsigned char* lds) {
    const int tid = otid(), wid = tid >> 6, lane = tid & 63, bid = obid(), G = ogrid();
    const float* mod = (const float*)(p.ws + OFF_MOD);
    {
        const float* g = pin(p, 9); const float* x0 = pin(p, 0); const float* x1 = pin(p, 1);
        bf16_t* h = (bf16_t*)(p.ws + OFF_H); float* rsp = (float*)(p.ws + OFF_RSP);
        for (int row = bid * 8 + wid; row < T_ALL; row += G * 8) {
            const int cond = row < T_CTX ? 0 : 1 + ((row - T_CTX) >> 10);
            const float* src = row < T_CTX ? x0 + (size_t)row * 1024 : x1 + (size_t)(row - T_CTX) * 1024;
            const float* mp = mod + (size_t)cond * 9216 + 1024;
            f32x4 v[4]; float ss = 0.f;
#pragma unroll
            for (int i = 0; i < 4; ++i) { v[i] = *(const f32x4*)(src + i * 256 + lane * 4); ss += v[i][0] * v[i][0] + v[i][1] * v[i][1] + v[i][2] * v[i][2] + v[i][3] * v[i][3]; }
            ss = wave_sum(ss);
#pragma unroll
            for (int i = 0; i < 4; ++i) {
                const int col = i * 256 + lane * 4;
                const f32x4 gs = *(const f32x4*)(g + col) * (*(const f32x4*)(mp + col) + 1.f);
                const f32x4 hv = v[i] * gs;
                u32x2 w; w.x = cvt_pk_bf16(hv[0], hv[1]); w.y = cvt_pk_bf16(hv[2], hv[3]);
                *(u32x2*)(h + (size_t)row * 1024 + col) = w;
                *(f32x4*)(p.out + (size_t)row * 1024 + col) = v[i];
            }
            if (lane < 16) rsp[(size_t)row * 16 + lane] = lane == 0 ? ss : 0.f;
        }
    }
    LAS float* sC = (LAS float*)lds;
    LAS float* sP = (LAS float*)(lds + 36864);
    float* biasb = (float*)(p.ws + OFF_BIAS);
    for (int item = bid; item < 452; item += G) {
        int u = 0, c0 = item;
#pragma unroll 1
        for (;;) { const int s3 = u % 3, lo = u / 3; const int nch = (s3 == 1) ? ((lo & 1) ? 32 : 18) : 44; if (c0 < nch) break; c0 -= nch; ++u; }
        const int l = u / 3, s3 = u % 3, j = l >> 1;
        const bf16_t* Bt = (s3 == 0) ? (const bf16_t*)(p.ws + OFF_WGU1) + (size_t)l * 5632 * 1024
                         : (s3 == 2) ? (const bf16_t*)(p.ws + OFF_WGU2) + (size_t)l * 5632 * 1024
                         : (l & 1)   ? (const bf16_t*)(p.ws + OFF_WINO) + (size_t)j * 4096 * 1024
                                     : (const bf16_t*)(p.ws + OFF_WINE) + (size_t)j * 2304 * 1024;
        __syncthreads();
        {
            float tmp[18];
#pragma unroll
            for (int i = 0; i < 18; ++i) { const int idx = tid + 512 * i, c = idx >> 10, k = idx & 1023; tmp[i] = mod[((size_t)l * 9 + c) * 9216 + (size_t)(3 * s3) * 1024 + k]; }
#pragma unroll
            for (int i = 0; i < 18; ++i) sC[tid + 512 * i] = tmp[i];
        }
        __syncthreads();
        const int rw = (wid & 1) * 64 + lane, ks = wid >> 1;
        const bf16_t* wrow = Bt + (size_t)(c0 * 128 + rw) * 1024 + ks * 256;
        float acc[9];
#pragma unroll
        for (int c = 0; c < 9; ++c) acc[c] = 0.f;
#pragma unroll 4
        for (int kk = 0; kk < 256; kk += 8) {
            const u32x4 ww = *(const u32x4*)(wrow + kk);
            float wv[8];
#pragma unroll
            for (int e = 0; e < 4; ++e) { wv[2 * e] = bflo(ww[e]); wv[2 * e + 1] = bfhi(ww[e]); }
#pragma unroll
            for (int c = 0; c < 9; ++c) {
                const f32x4 s0 = *(const LAS f32x4*)(sC + c * 1024 + ks * 256 + kk), s1 = *(const LAS f32x4*)(sC + c * 1024 + ks * 256 + kk + 4);
                acc[c] += wv[0] * s0[0] + wv[1] * s0[1] + wv[2] * s0[2] + wv[3] * s0[3] + wv[4] * s1[0] + wv[5] * s1[1] + wv[6] * s1[2] + wv[7] * s1[3];
            }
        }
#pragma unroll
        for (int c = 0; c < 9; ++c) sP[(ks * 9 + c) * 128 + rw] = acc[c];
        __syncthreads();
        for (int idx = tid; idx < 9 * 128; idx += 512) {
            const int c = idx >> 7, r = idx & 127;
            const float t = sP[(0 * 9 + c) * 128 + r] + sP[(1 * 9 + c) * 128 + r] + sP[(2 * 9 + c) * 128 + r] + sP[(3 * 9 + c) * 128 + r];
            biasb[((size_t)u * 9 + c) * 5632 + c0 * 128 + r] = t;
        }
    }
    __syncthreads();
}

__device__ __forceinline__ f32x4 mfma16(bf16x8 a, bf16x8 b, f32x4 c) { return __builtin_amdgcn_mfma_f32_16x16x32_bf16(a, b, c, 0, 0, 0); }

__device__ __forceinline__ void gla_unit(const Params& p, LAS unsigned char* lds, int j, int unit) {
    const int tid = otid(), wid = tid >> 6, lane = tid & 63, fr = lane & 15, fq = lane >> 4;
    int b, h, dir, Tn, row0; bool lat;
    if (unit < 64) { lat = true; b = unit >> 3; h = (unit >> 1) & 3; dir = unit & 1; Tn = 1024; row0 = T_CTX + b * 1024; }
    else { const int u2 = unit - 64; lat = false; b = u2 >> 3; h = (u2 >> 1) & 3; dir = u2 & 1; Tn = 256; row0 = b * 256; }
    const bf16_t* proj = (const bf16_t*)(p.ws + OFF_PROJ);
    float* obuf = (float*)(p.ws + (dir ? OFF_OB : OFF_OF));
    LAS bf16_t* sQ = (LAS bf16_t*)lds;
    LAS bf16_t* sK = (LAS bf16_t*)(lds + 9216);
    LAS bf16_t* sKT = (LAS bf16_t*)(lds + 18432);
    LAS bf16_t* sVT = (LAS bf16_t*)(lds + 27648);
    LAS bf16_t* sAtt = (LAS bf16_t*)(lds + 46080);
    LAS bf16_t* sST = (LAS bf16_t*)(lds + 55296);
    LAS float* sCum = (LAS float*)(lds + 73728);
    LAS float* sGl = (LAS float*)(lds + 90112);
    LAS float* sSeg = (LAS float*)(lds + 94208);
    LAS float* sLast = (LAS float*)(lds + 96256);
    const int d_ = tid & 63, seg = tid >> 6;
    float w2r[16];
    const float* w2p = pin(p, 18); const float* stp = pin(p, 6);
#pragma unroll
    for (int r = 0; r < 16; ++r) w2r[r] = w2p[(size_t)((j * 2 + dir) * 16 + r) * 256 + h * 64 + d_];
    const float bz = pin(p, 19)[(j * 2 + dir) * 256 + h * 64 + d_];
    f32x4 Sacc[4];
    const size_t sbase_in = ((((size_t)b * 2 + j) * 2 + dir) * 4 + h) * 64 * 128;
#pragma unroll
    for (int dt = 0; dt < 4; ++dt) {
#pragma unroll
        for (int reg = 0; reg < 4; ++reg) Sacc[dt][reg] = lat ? stp[sbase_in + (size_t)(dt * 16 + fq * 4 + reg) * 128 + wid * 16 + fr] : 0.f;
        u32x2 w; w.x = cvt_pk_bf16(Sacc[dt][0], Sacc[dt][1]); w.y = cvt_pk_bf16(Sacc[dt][2], Sacc[dt][3]);
        *(LAS u32x2*)(sST + (wid * 16 + fr) * 72 + dt * 16 + fq * 4) = w;
    }
    const int nch = Tn / 64;
    const int sig = tid >> 3, part = tid & 7;
    u32x4 pq, pk; bf16x8 pv0, pv1; unsigned pgl;
#define GLA_LOAD(C) do { const int tokl_ = dir ? (Tn - 1 - ((C) * 64 + sig)) : ((C) * 64 + sig); const bf16_t* pr_ = proj + (size_t)(row0 + tokl_) * PROJ_LD; \
        pq = *(const u32x4*)(pr_ + h * 64 + part * 8); pk = *(const u32x4*)(pr_ + 256 + h * 64 + part * 8); \
        pv0 = *(const bf16x8*)(pr_ + 512 + h * 128 + part * 16); pv1 = *(const bf16x8*)(pr_ + 512 + h * 128 + part * 16 + 8); \
        pgl = *(const unsigned*)(pr_ + 1536 + dir * 16 + part * 2); } while (0)
    GLA_LOAD(0);
    for (int c = 0; c < nch; ++c) {
        const u32x4 qv = pq, kv = pk; const bf16x8 v0 = pv0, v1 = pv1; const unsigned glw = pgl;
        if (c + 1 < nch) GLA_LOAD(c + 1);
        sGl[sig * 16 + part * 2] = bflo(glw); sGl[sig * 16 + part * 2 + 1] = bfhi(glw);
        __syncthreads();
        float cumv[8]; float run = 0.f;
#pragma unroll
        for (int i = 0; i < 8; ++i) {
            const int tau = seg * 8 + i; float z = bz;
#pragma unroll
            for (int r = 0; r < 16; ++r) z += sGl[tau * 16 + r] * w2r[r];
            const float la = (fminf(z, 0.f) - __logf(1.f + __expf(-fabsf(z)))) * (1.f / 16.f);
            run += la; cumv[i] = run;
        }
        sSeg[seg * 64 + d_] = run;
        __syncthreads();
        float pre = 0.f;
#pragma unroll
        for (int s = 0; s < 7; ++s) pre += (s < seg) ? sSeg[s * 64 + d_] : 0.f;
#pragma unroll
        for (int i = 0; i < 8; ++i) sCum[(seg * 8 + i) * 64 + d_] = cumv[i] + pre;
        if (seg == 7) sLast[d_] = __expf(cumv[7] + pre);
        __syncthreads();
        {
            float qf[8], kt[8], kh[8];
#pragma unroll
            for (int e2 = 0; e2 < 4; ++e2) {
                const unsigned qw = qv[e2], kw = kv[e2];
#pragma unroll
                for (int hh = 0; hh < 2; ++hh) {
                    const int e = e2 * 2 + hh, d = part * 8 + e;
                    const float cm = sCum[sig * 64 + d], lc = sCum[63 * 64 + d];
                    const float q_ = hh ? bfhi(qw) : bflo(qw), k_ = hh ? bfhi(kw) : bflo(kw);
                    qf[e] = q_ * 0.125f * __expf(cm); kt[e] = k_ * __expf(-cm); kh[e] = k_ * __expf(lc - cm);
                }
            }
            u32x4 wq, wk;
            wq.x = cvt_pk_bf16(qf[0], qf[1]); wq.y = cvt_pk_bf16(qf[2], qf[3]); wq.z = cvt_pk_bf16(qf[4], qf[5]); wq.w = cvt_pk_bf16(qf[6], qf[7]);
            wk.x = cvt_pk_bf16(kt[0], kt[1]); wk.y = cvt_pk_bf16(kt[2], kt[3]); wk.z = cvt_pk_bf16(kt[4], kt[5]); wk.w = cvt_pk_bf16(kt[6], kt[7]);
            *(LAS u32x4*)(sQ + sig * 72 + part * 8) = wq;
            *(LAS u32x4*)(sK + sig * 72 + part * 8) = wk;
#pragma unroll
            for (int e = 0; e < 8; ++e) sKT[(part * 8 + e) * 72 + (sig ^ (part << 3))] = f2bf(kh[e]);
#pragma unroll
            for (int e = 0; e < 8; ++e) { sVT[(part * 16 + e) * 72 + (sig ^ (part << 3))] = (bf16_t)v0[e]; sVT[(part * 16 + 8 + e) * 72 + (sig ^ (part << 3))] = (bf16_t)v1[e]; }
        }
        __syncthreads();
        {
            const int taut = wid >> 1;
#pragma unroll
            for (int s2 = 0; s2 < 2; ++s2) {
                const int sigt = (wid & 1) * 2 + s2;
                f32x4 a4 = (f32x4){0.f, 0.f, 0.f, 0.f};
#pragma unroll
                for (int kk = 0; kk < 2; ++kk) {
                    const bf16x8 a = *(const LAS bf16x8*)(sK + (sigt * 16 + fr) * 72 + kk * 32 + fq * 8);
                    const bf16x8 bq = *(const LAS bf16x8*)(sQ + (taut * 16 + fr) * 72 + kk * 32 + fq * 8);
                    a4 = mfma16(a, bq, a4);
                }
#pragma unroll
                for (int reg = 0; reg < 4; ++reg) a4[reg] = ((sigt * 16 + fq * 4 + reg) <= (taut * 16 + fr)) ? a4[reg] : 0.f;
                u32x2 w; w.x = cvt_pk_bf16(a4[0], a4[1]); w.y = cvt_pk_bf16(a4[2], a4[3]);
                *(LAS u32x2*)(sAtt + (taut * 16 + fr) * 72 + sigt * 16 + fq * 4) = w;
            }
        }
        __syncthreads();
#pragma unroll
        for (int taut = 0; taut < 4; ++taut) {
            f32x4 o4 = (f32x4){0.f, 0.f, 0.f, 0.f};
#pragma unroll
            for (int kk = 0; kk < 2; ++kk) {
                const bf16x8 a = *(const LAS bf16x8*)(sQ + (taut * 16 + fr) * 72 + kk * 32 + fq * 8);
                const u32x4 bbu = *(const LAS u32x4*)(sST + (wid * 16 + fr) * 72 + kk * 32 + fq * 8);
                o4 = mfma16(a, __builtin_bit_cast(bf16x8, bbu), o4);
            }
#pragma unroll
            for (int kk = 0; kk < 2; ++kk) {
                const bf16x8 a = *(const LAS bf16x8*)(sAtt + (taut * 16 + fr) * 72 + kk * 32 + fq * 8);
                const bf16x8 bb = *(const LAS bf16x8*)(sVT + (wid * 16 + fr) * 72 + (((kk * 4 + fq) ^ wid) << 3));
                o4 = mfma16(a, bb, o4);
            }
#pragma unroll
            for (int reg = 0; reg < 4; ++reg) {
                const int tau = taut * 16 + fq * 4 + reg;
                const int tk = dir ? (Tn - 1 - (c * 64 + tau)) : (c * 64 + tau);
                obuf[(size_t)(row0 + tk) * 512 + h * 128 + wid * 16 + fr] = o4[reg];
            }
        }
        __syncthreads();
#pragma unroll
        for (int dt = 0; dt < 4; ++dt) {
#pragma unroll
            for (int reg = 0; reg < 4; ++reg) Sacc[dt][reg] *= sLast[dt * 16 + fq * 4 + reg];
#pragma unroll
            for (int kk = 0; kk < 2; ++kk) {
                const bf16x8 a = *(const LAS bf16x8*)(sKT + (dt * 16 + fr) * 72 + (((kk * 4 + fq) ^ (dt * 2 + (fr >> 3))) << 3));
                const bf16x8 bb = *(const LAS bf16x8*)(sVT + (wid * 16 + fr) * 72 + (((kk * 4 + fq) ^ wid) << 3));
                Sacc[dt] = mfma16(a, bb, Sacc[dt]);
            }
            u32x2 w; w.x = cvt_pk_bf16(Sacc[dt][0], Sacc[dt][1]); w.y = cvt_pk_bf16(Sacc[dt][2], Sacc[dt][3]);
            *(LAS u32x2*)(sST + (wid * 16 + fr) * 72 + dt * 16 + fq * 4) = w;
        }
        __syncthreads();
    }
    if (!lat) {
        float* og = p.out + OUT_GLA + ((((size_t)b * 2 + j) * 2 + dir) * 4 + h) * 64 * 128;
#pragma unroll
        for (int dt = 0; dt < 4; ++dt)
#pragma unroll
            for (int reg = 0; reg < 4; ++reg) og[(size_t)(dt * 16 + fq * 4 + reg) * 128 + wid * 16 + fr] = Sacc[dt][reg];
    }
}

__device__ __forceinline__ void mla_prep_tile(const Params& p, int j, int t) {
    const int tid = otid(), wid = tid >> 6, lane = tid & 63;
    const bf16_t* proj = (const bf16_t*)(p.ws + OFF_PROJ);
    bf16_t* cqn = (bf16_t*)(p.ws + OFF_CQN); bf16_t* ckvn = (bf16_t*)(p.ws + OFF_CKVN);
    const float* qag = pin(p, 21); const float* kvag = pin(p, 23); const float* cckv = pin(p, 4);
    for (int i = 0; i < 8; ++i) {
        const int r = t * 64 + wid * 8 + i;
        if (r < T_ALL) {
            const bf16_t* pr = proj + (size_t)r * PROJ_LD;
            float cq[6]; float ss = 0.f;
#pragma unroll
            for (int k = 0; k < 3; ++k) { const unsigned w = *(const unsigned*)(pr + 1568 + k * 128 + lane * 2); cq[2 * k] = bflo(w); cq[2 * k + 1] = bfhi(w); ss += cq[2 * k] * cq[2 * k] + cq[2 * k + 1] * cq[2 * k + 1]; }
            ss = wave_sum(ss);
            const float rq = rsqrtf(ss * (1.f / 384.f) + EPS);
#pragma unroll
            for (int k = 0; k < 3; ++k) { const int col = k * 128 + lane * 2; const float g0 = qag[j * 384 + col], g1 = qag[j * 384 + col + 1];
                *(unsigned*)(cqn + (size_t)r * 384 + col) = cvt_pk_bf16(cq[2 * k] * rq * g0, cq[2 * k + 1] * rq * g1); }
            const u32x2 kw = *(const u32x2*)(pr + 1952 + lane * 4);
            float kv[4] = {bflo(kw.x), bfhi(kw.x), bflo(kw.y), bfhi(kw.y)};
            float s2 = kv[0] * kv[0] + kv[1] * kv[1] + kv[2] * kv[2] + kv[3] * kv[3];
            s2 = wave_sum(s2);
            const float rk = rsqrtf(s2 * (1.f / 256.f) + EPS);
            const f32x4 gk = *(const f32x4*)(kvag + j * 256 + lane * 4);
            f32x4 y;
#pragma unroll
            for (int e = 0; e < 4; ++e) y[e] = kv[e] * rk * gk[e];
            u32x2 w; w.x = cvt_pk_bf16(y[0], y[1]); w.y = cvt_pk_bf16(y[2], y[3]);
            *(u32x2*)(ckvn + (size_t)r * 256 + lane * 4) = w;
            if (r < T_CTX) {
                const int bb = r >> 8, tt = r & 255;
                *(f32x4*)(p.out + OUT_CKV + (((size_t)bb * 2 + j) * 256 + tt) * 256 + lane * 4) = y;
                if (lane < 32) p.out[OUT_KROPE + (((size_t)bb * 2 + j) * 256 + tt) * 32 + lane] = bf2f(pr[2208 + lane]);
            }
        } else {
            const int rc = r - T_ALL, bb = rc >> 8, m = rc & 255;
            const f32x4 v = *(const f32x4*)(cckv + (((size_t)bb * 2 + j) * 256 + m) * 256 + lane * 4);
            u32x2 w; w.x = cvt_pk_bf16(v[0], v[1]); w.y = cvt_pk_bf16(v[2], v[3]);
            *(u32x2*)(ckvn + (size_t)r * 256 + lane * 4) = w;
        }
    }
}

__device__ __forceinline__ void even2_phase(const Params& p, LAS unsigned char* lds, int j) {
    const int bid = obid(), G = ogrid();
    if (G >= 128) {
        if (bid < 64) { gla_unit(p, lds, j, bid); __syncthreads(); }
        else { for (int it = 64 + (bid - 64); it < 608; it += (G - 64)) { if (it < 320) { gla_unit(p, lds, j, it); __syncthreads(); } else mla_prep_tile(p, j, it - 320); } }
    } else {
        for (int it = bid; it < 608; it += G) { if (it < 320) { gla_unit(p, lds, j, it); __syncthreads(); } else mla_prep_tile(p, j, it - 320); }
    }
}


__device__ __forceinline__ float rope_inv(int i) { return __builtin_amdgcn_exp2f(-(float)(i & 7) * 1.6609640474f); }


__device__ __forceinline__ void kprep_tile(const Params& p, LAS unsigned char* lds, int j, int tile) {
    const int tid = otid();
    const int rt = tile >> 3, h = tile & 7, row0 = rt * 64;
    const bf16_t* proj = (const bf16_t*)(p.ws + OFF_PROJ); const bf16_t* kvraw = (const bf16_t*)(p.ws + OFF_KVRAW);
    bf16_t* KN = (bf16_t*)(p.ws + OFF_KN); bf16_t* VT = (bf16_t*)(p.ws + OFF_VT);
    LAS bf16_t* sVT = (LAS bf16_t*)lds;
    const float* kg = pin(p, 26) + j * 96; const float* ckr = pin(p, 5);
    const int key = tid >> 3, part = tid & 7, row = row0 + key;
    float kr[4]; bool rope = false; int pos = 0;
    if (row < T_ALL) { const u32x2 w = *(const u32x2*)(proj + (size_t)row * PROJ_LD + 2208 + part * 4); kr[0] = bflo(w.x); kr[1] = bfhi(w.x); kr[2] = bflo(w.y); kr[3] = bfhi(w.y);
        if (row >= T_CTX) { rope = true; pos = (row - T_CTX) & 1023; } }
    else { const int rc = row - T_ALL, bb = rc >> 8, m = rc & 255; const f32x4 w = *(const f32x4*)(ckr + (((size_t)bb * 2 + j) * 256 + m) * 32 + part * 4); kr[0] = w[0]; kr[1] = w[1]; kr[2] = w[2]; kr[3] = w[3]; }
    const bf16_t* kp = kvraw + (size_t)row * 1024 + h * 128;
    const u32x4 kn = *(const u32x4*)(kp + part * 8); const bf16x8 vv = *(const bf16x8*)(kp + 64 + part * 8);
    float kf[8];
#pragma unroll
    for (int e = 0; e < 4; ++e) { kf[2 * e] = bflo(kn[e]); kf[2 * e + 1] = bfhi(kn[e]); }
    float ss = kr[0] * kr[0] + kr[1] * kr[1] + kr[2] * kr[2] + kr[3] * kr[3];
#pragma unroll
    for (int e = 0; e < 8; ++e) ss += kf[e] * kf[e];
    ss += __shfl_xor(ss, 1); ss += __shfl_xor(ss, 2); ss += __shfl_xor(ss, 4);
    const float rstd = rsqrtf(ss * (1.f / 96.f) + EPS);
#pragma unroll
    for (int e = 0; e < 8; ++e) kf[e] *= rstd * kg[part * 8 + e];
#pragma unroll
    for (int e = 0; e < 4; ++e) kr[e] *= rstd * kg[64 + part * 4 + e];
    if (rope) {
        const float prow = (float)(pos >> 6), pcol = (float)(pos & 63);
#pragma unroll
        for (int pr = 0; pr < 2; ++pr) {
            const int i = part * 2 + pr;
            const float ang = (i < 8 ? prow : pcol) * rope_inv(i);
            const float rev = ang * 0.15915494309f;
            const float cs = __builtin_amdgcn_cosf(rev), sn = __builtin_amdgcn_sinf(rev);
            const float x1 = kr[2 * pr], x2 = kr[2 * pr + 1];
            kr[2 * pr] = x1 * cs - x2 * sn; kr[2 * pr + 1] = x1 * sn + x2 * cs;
        }
    }
    bf16_t* kd = KN + ((size_t)row * 8 + h) * 96;
    u32x4 w; w.x = cvt_pk_bf16(kf[0], kf[1]); w.y = cvt_pk_bf16(kf[2], kf[3]); w.z = cvt_pk_bf16(kf[4], kf[5]); w.w = cvt_pk_bf16(kf[6], kf[7]);
    *(u32x4*)(kd + part * 8) = w;
    u32x2 w2; w2.x = cvt_pk_bf16(kr[0], kr[1]); w2.y = cvt_pk_bf16(kr[2], kr[3]);
    *(u32x2*)(kd + 64 + part * 4) = w2;
#pragma unroll
    for (int e = 0; e < 8; ++e) sVT[(part * 8 + e) * 72 + key] = (bf16_t)vv[e];
    __syncthreads();
    {
        size_t base; int nk, k0;
        if (row0 < T_CTX) { base = (size_t)((row0 >> 8) * 8 + h) * 64 * 256; nk = 256; k0 = row0 & 255; }
        else if (row0 < T_ALL) { base = VT_LAT + (size_t)(((row0 - T_CTX) >> 10) * 8 + h) * 64 * 1280; nk = 1280; k0 = 256 + ((row0 - T_CTX) & 1023); }
        else { base = VT_LAT + (size_t)(((row0 - T_ALL) >> 8) * 8 + h) * 64 * 1280; nk = 1280; k0 = (row0 - T_ALL) & 255; }
        const int dv = tid >> 3, c8 = tid & 7;
        *(u32x4*)(VT + base + (size_t)dv * nk + k0 + c8 * 8) = *(const LAS u32x4*)(sVT + dv * 72 + c8 * 8);
    }
    __syncthreads();
}

__device__ __forceinline__ void attn_tile(const Params& p, LAS unsigned char* lds, int j, int tile) {
    const int tid = otid(), wid = tid >> 6, lane = tid & 63, fr = lane & 15, fq = lane >> 4;
    bool lat; int b, h, qp_, nkb, qrow0;
    if (tile < 256) { lat = true; b = tile >> 5; h = (tile >> 2) & 7; qp_ = tile & 3; nkb = 20; qrow0 = T_CTX + b * 1024 + qp_ * 256; }
    else { const int t2 = tile - 256; lat = false; b = t2 >> 3; h = t2 & 7; qp_ = 0; nkb = 4; qrow0 = b * 256; }
    const bf16_t* qraw = (const bf16_t*)(p.ws + OFF_QRAW);
    bf16_t* cat = (bf16_t*)(p.ws + OFF_CAT);
    LAS bf16_t* sQ = (LAS bf16_t*)lds;
    LAS bf16_t* sK = (LAS bf16_t*)(lds + 53248);
    LAS bf16_t* sVT = (LAS bf16_t*)(lds + 66560);
    const float* g = pin(p, 25) + j * 96;
#pragma unroll 1
    for (int r = 0; r < 2; ++r) {
        const int q = (tid >> 2) + 128 * r, part = tid & 3;
        const bf16_t* qp = qraw + (size_t)(qrow0 + q) * 768 + h * 96;
        const u32x4 n0 = *(const u32x4*)(qp + part * 16), n1 = *(const u32x4*)(qp + part * 16 + 8), rp = *(const u32x4*)(qp + 64 + part * 8);
        float f[24];
#pragma unroll
        for (int e = 0; e < 4; ++e) { f[2 * e] = bflo(n0[e]); f[2 * e + 1] = bfhi(n0[e]); f[8 + 2 * e] = bflo(n1[e]); f[8 + 2 * e + 1] = bfhi(n1[e]); f[16 + 2 * e] = bflo(rp[e]); f[16 + 2 * e + 1] = bfhi(rp[e]); }
        float ss = 0.f;
#pragma unroll
        for (int e = 0; e < 24; ++e) ss += f[e] * f[e];
        ss += __shfl_xor(ss, 1); ss += __shfl_xor(ss, 2);
        const float rstd = rsqrtf(ss * (1.f / 96.f) + EPS);
#pragma unroll
        for (int e = 0; e < 16; ++e) f[e] *= rstd * g[part * 16 + e];
#pragma unroll
        for (int e = 0; e < 8; ++e) f[16 + e] *= rstd * g[64 + part * 8 + e];
        if (lat) {
            const int pos = qp_ * 256 + q; const float prow = (float)(pos >> 6), pcol = (float)(pos & 63);
#pragma unroll
            for (int pr = 0; pr < 4; ++pr) {
                const int i = part * 4 + pr;
                const float ang = (i < 8 ? prow : pcol) * rope_inv(i);
                const float rev = ang * 0.15915494309f;
                const float cs = __builtin_amdgcn_cosf(rev), sn = __builtin_amdgcn_sinf(rev);
                const float x1 = f[16 + 2 * pr], x2 = f[16 + 2 * pr + 1];
                f[16 + 2 * pr] = x1 * cs - x2 * sn; f[16 + 2 * pr + 1] = x1 * sn + x2 * cs;
            }
        }
        const float sc = 0.10206207262f * 1.44269504089f;
        u32x4 w0, w1, w2;
#pragma unroll
        for (int e = 0; e < 4; ++e) { w0[e] = cvt_pk_bf16(f[2 * e] * sc, f[2 * e + 1] * sc); w1[e] = cvt_pk_bf16(f[8 + 2 * e] * sc, f[8 + 2 * e + 1] * sc); w2[e] = cvt_pk_bf16(f[16 + 2 * e] * sc, f[16 + 2 * e + 1] * sc); }
        *(LAS u32x4*)(sQ + q * 104 + part * 16) = w0; *(LAS u32x4*)(sQ + q * 104 + part * 16 + 8) = w1; *(LAS u32x4*)(sQ + q * 104 + 64 + part * 8) = w2;
    }
    __syncthreads();
    bf16x8 bQ[2][3];
#pragma unroll
    for (int gq = 0; gq < 2; ++gq)
#pragma unroll
        for (int kk = 0; kk < 3; ++kk) bQ[gq][kk] = *(const LAS bf16x8*)(sQ + (wid * 32 + gq * 16 + fr) * 104 + kk * 32 + fq * 8);
    float m_run[2] = {-1e30f, -1e30f}, l_run[2] = {0.f, 0.f};
    f32x4 oacc[2][4];
#pragma unroll
    for (int gq = 0; gq < 2; ++gq)
#pragma unroll
        for (int dt = 0; dt < 4; ++dt) oacc[gq][dt] = (f32x4){0.f, 0.f, 0.f, 0.f};
    const bf16_t* KN = (const bf16_t*)(p.ws + OFF_KN);
    const bf16_t* VTg = (const bf16_t*)(p.ws + OFF_VT) + (lat ? VT_LAT + (size_t)(b * 8 + h) * 64 * 1280 : (size_t)(b * 8 + h) * 64 * 256);
    const int NK = lat ? 1280 : 256;
    u32x4 pf_k0, pf_k1, pf_v;
    const int kc0 = tid, kc1 = tid + 512;
    const int key0_ = kc0 / 12, pc0_ = kc0 % 12, key1_ = kc1 / 12, pc1_ = kc1 % 12;
#define ATT_ROW(KB, KEY) (!lat ? (b * 256 + (KB) * 64 + (KEY)) : ((KB) < 4 ? (T_ALL + b * 256 + (KB) * 64 + (KEY)) : (T_CTX + b * 1024 + ((KB) - 4) * 64 + (KEY))))
#define ATT_LOAD(KB) do { \
        pf_k0 = *(const u32x4*)(KN + ((size_t)ATT_ROW(KB, key0_) * 8 + h) * 96 + pc0_ * 8); \
        if (tid < 256) pf_k1 = *(const u32x4*)(KN + ((size_t)ATT_ROW(KB, key1_) * 8 + h) * 96 + pc1_ * 8); \
        pf_v = *(const u32x4*)(VTg + (size_t)(tid >> 3) * NK + (KB) * 64 + (tid & 7) * 8); } while (0)
    pf_k1 = (u32x4){0u, 0u, 0u, 0u};
    ATT_LOAD(0);
    for (int kb = 0; kb < nkb; ++kb) {
        *(LAS u32x4*)(sK + key0_ * 104 + pc0_ * 8) = pf_k0;
        if (tid < 256) *(LAS u32x4*)(sK + key1_ * 104 + pc1_ * 8) = pf_k1;
        *(LAS u32x4*)(sVT + (tid >> 3) * 72 + (tid & 7) * 8) = pf_v;
        __syncthreads();
        if (kb + 1 < nkb) ATT_LOAD(kb + 1);
        {
            f32x4 s[2][4];
#pragma unroll
            for (int g4 = 0; g4 < 4; ++g4) {
                s[0][g4] = (f32x4){0.f, 0.f, 0.f, 0.f}; s[1][g4] = s[0][g4];
#pragma unroll
                for (int kk = 0; kk < 3; ++kk) {
                    const bf16x8 a = *(const LAS bf16x8*)(sK + (g4 * 16 + fr) * 104 + kk * 32 + fq * 8);
                    s[0][g4] = mfma16(a, bQ[0][kk], s[0][g4]); s[1][g4] = mfma16(a, bQ[1][kk], s[1][g4]);
                }
            }
#pragma unroll
            for (int gq = 0; gq < 2; ++gq) {
                float mx = s[gq][0][0];
#pragma unroll
                for (int g4 = 0; g4 < 4; ++g4)
#pragma unroll
                    for (int reg = 0; reg < 4; ++reg) mx = fmaxf(mx, s[gq][g4][reg]);
                mx = fmaxf(mx, __shfl_xor(mx, 16)); mx = fmaxf(mx, __shfl_xor(mx, 32));
                const float m_new = fmaxf(m_run[gq], mx);
                const float alpha = __builtin_amdgcn_exp2f(m_run[gq] - m_new);
                m_run[gq] = m_new;
                float ls = 0.f;
#pragma unroll
                for (int g4 = 0; g4 < 4; ++g4)
#pragma unroll
                    for (int reg = 0; reg < 4; ++reg) { s[gq][g4][reg] = __builtin_amdgcn_exp2f(s[gq][g4][reg] - m_new); ls += s[gq][g4][reg]; }
                l_run[gq] = l_run[gq] * alpha + ls;
#pragma unroll
                for (int dt = 0; dt < 4; ++dt) oacc[gq][dt] *= alpha;
            }
#pragma unroll
            for (int ks = 0; ks < 2; ++ks) {
                bf16x8 bP[2];
#pragma unroll
                for (int gq = 0; gq < 2; ++gq) {
                    u32x4 pw; pw.x = cvt_pk_bf16(s[gq][2 * ks][0], s[gq][2 * ks][1]); pw.y = cvt_pk_bf16(s[gq][2 * ks][2], s[gq][2 * ks][3]); pw.z = cvt_pk_bf16(s[gq][2 * ks + 1][0], s[gq][2 * ks + 1][1]); pw.w = cvt_pk_bf16(s[gq][2 * ks + 1][2], s[gq][2 * ks + 1][3]);
                    bP[gq] = __builtin_bit_cast(bf16x8, pw);
                }
#pragma unroll
                for (int dt = 0; dt < 4; ++dt) {
                    const u32x2 lo = *(const LAS u32x2*)(sVT + (dt * 16 + fr) * 72 + ks * 32 + fq * 4);
                    const u32x2 hi = *(const LAS u32x2*)(sVT + (dt * 16 + fr) * 72 + ks * 32 + 16 + fq * 4);
                    u32x4 av; av.x = lo.x; av.y = lo.y; av.z = hi.x; av.w = hi.y;
                    const bf16x8 aV = __builtin_bit_cast(bf16x8, av);
                    oacc[0][dt] = mfma16(aV, bP[0], oacc[0][dt]); oacc[1][dt] = mfma16(aV, bP[1], oacc[1][dt]);
                }
            }
        }
        __syncthreads();
    }
#undef ATT_LOAD
#undef ATT_ROW
#pragma unroll
    for (int gq = 0; gq < 2; ++gq) {
        float l = l_run[gq];
        l += __shfl_xor(l, 16); l += __shfl_xor(l, 32);
        const float inv = 1.f / l;
        bf16_t* op = cat + (size_t)(qrow0 + wid * 32 + gq * 16 + fr) * 1024 + 512 + h * 64;
#pragma unroll
        for (int dt = 0; dt < 4; ++dt) { u32x2 w; w.x = cvt_pk_bf16(oacc[gq][dt][0] * inv, oacc[gq][dt][1] * inv); w.y = cvt_pk_bf16(oacc[gq][dt][2] * inv, oacc[gq][dt][3] * inv); *(u32x2*)(op + dt * 16 + fq * 4) = w; }
    }
}

__device__ __forceinline__ void gla_finish_rows(const Params& p, int j) {
    const int tid = otid(), wid = tid >> 6, lane = tid & 63;
    const float* of = (const float*)(p.ws + OFF_OF); const float* ob = (const float*)(p.ws + OFF_OB);
    const bf16_t* proj = (const bf16_t*)(p.ws + OFF_PROJ); bf16_t* cat = (bf16_t*)(p.ws + OFF_CAT);
    const int e0 = (lane & 15) * 8;
    const float* glag = pin(p, 20);
    const f32x4 g0 = *(const f32x4*)(glag + j * 128 + e0), g1 = *(const f32x4*)(glag + j * 128 + e0 + 4);
    for (int row = obid() * 8 + wid; row < T_ALL; row += ogrid() * 16) {
        f32x4 xa[2][2], xb[2][2]; u32x4 ogw[2];
#pragma unroll
        for (int r = 0; r < 2; ++r) {
            const int rw = min(row + r * ogrid() * 8, T_ALL - 1);
            const float* a = of + (size_t)rw * 512 + lane * 8; const float* bb = ob + (size_t)rw * 512 + lane * 8;
            xa[r][0] = *(const f32x4*)a; xa[r][1] = *(const f32x4*)(a + 4); xb[r][0] = *(const f32x4*)bb; xb[r][1] = *(const f32x4*)(bb + 4);
            ogw[r] = *(const u32x4*)(proj + (size_t)rw * PROJ_LD + 1024 + lane * 8);
        }
#pragma unroll
        for (int r = 0; r < 2; ++r) {
            const int rw = min(row + r * ogrid() * 8, T_ALL - 1);
            const f32x4 x0 = xa[r][0] + xb[r][0], x1 = xa[r][1] + xb[r][1];
            float ss = x0[0] * x0[0] + x0[1] * x0[1] + x0[2] * x0[2] + x0[3] * x0[3] + x1[0] * x1[0] + x1[1] * x1[1] + x1[2] * x1[2] + x1[3] * x1[3];
            ss += __shfl_xor(ss, 1); ss += __shfl_xor(ss, 2); ss += __shfl_xor(ss, 4); ss += __shfl_xor(ss, 8);
            const float rstd = rsqrtf(ss * (1.f / 128.f) + EPS);
            float y[8];
#pragma unroll
            for (int e = 0; e < 4; ++e) { y[e] = x0[e] * rstd * g0[e]; y[4 + e] = x1[e] * rstd * g1[e]; }
#pragma unroll
            for (int e = 0; e < 4; ++e) { y[2 * e] *= silu_f(bflo(ogw[r][e])); y[2 * e + 1] *= silu_f(bfhi(ogw[r][e])); }
            u32x4 w; w.x = cvt_pk_bf16(y[0], y[1]); w.y = cvt_pk_bf16(y[2], y[3]); w.z = cvt_pk_bf16(y[4], y[5]); w.w = cvt_pk_bf16(y[6], y[7]);
            *(u32x4*)(cat + (size_t)rw * 1024 + lane * 8) = w;
        }
    }
}

__device__ __forceinline__ void spatial_tile(const Params& p, LAS unsigned char* lds, int j, int tile) {
    const int tid = otid(), wid = tid >> 6, lane = tid & 63, fr = lane & 15, fq = lane >> 4;
    const int chunk = tile >> 4, slab = tile & 15, g = slab >> 2;
    const bf16_t* uv = (const bf16_t*)(p.ws + OFF_UV); bf16_t* gated = (bf16_t*)(p.ws + OFF_GATED);
    const float* ssp = (const float*)(p.ws + OFF_SSP);
    const bf16_t* Ws = (const bf16_t*)(p.ws + OFF_WS) + (size_t)(j * 4 + g) * 128 * 128;
    LAS bf16_t* sW = (LAS bf16_t*)lds;
    LAS bf16_t* sVT = (LAS bf16_t*)(lds + 34816);
    LAS float* sR = (LAS float*)(lds + 69632);
    if (tid < 128) { const float* s = ssp + (size_t)(chunk * 128 + tid) * 32; float a = 0.f;
#pragma unroll
        for (int i = 0; i < 32; i += 4) { const f32x4 v = *(const f32x4*)(s + i); a += v[0] + v[1] + v[2] + v[3]; }
        sR[tid] = rsqrtf(a * (1.f / 2048.f) + EPS); }
#pragma unroll
    for (int i = 0; i < 4; ++i) { const int idx = tid + 512 * i, row = idx >> 4, c8 = idx & 15; *(LAS u32x4*)(sW + row * 136 + c8 * 8) = *(const u32x4*)(Ws + row * 128 + c8 * 8); }
    __syncthreads();
    const float* vgp = pin(p, 28);
#pragma unroll
    for (int i = 0; i < 4; ++i) {
        const int idx = tid + 512 * i, q = idx >> 4, c8 = idx & 15;
        const u32x4 vv = *(const u32x4*)(uv + (size_t)(chunk * 128 + q) * 4096 + 2048 + slab * 128 + c8 * 8);
        const float rs = sR[q]; const float* vg = vgp + j * 2048 + slab * 128 + c8 * 8;
#pragma unroll
        for (int e = 0; e < 4; ++e) {
            sVT[(c8 * 8 + 2 * e) * 136 + (q ^ (c8 << 3))] = f2bf(bflo(vv[e]) * rs * vg[2 * e]);
            sVT[(c8 * 8 + 2 * e + 1) * 136 + (q ^ (c8 << 3))] = f2bf(bfhi(vv[e]) * rs * vg[2 * e + 1]);
        }
    }
    __syncthreads();
    bf16x8 aV[4];
#pragma unroll
    for (int kk = 0; kk < 4; ++kk) aV[kk] = *(const LAS bf16x8*)(sVT + (wid * 16 + fr) * 136 + (((kk * 4 + fq) ^ (wid * 2 + (fr >> 3))) << 3));
    const float* bs = pin(p, 30) + (size_t)(j * 4 + g) * 128;
#pragma unroll
    for (int pt = 0; pt < 8; ++pt) {
        f32x4 acc = (f32x4){0.f, 0.f, 0.f, 0.f};
#pragma unroll
        for (int kk = 0; kk < 4; ++kk) { const bf16x8 bw = *(const LAS bf16x8*)(sW + (pt * 16 + fr) * 136 + kk * 32 + fq * 8); acc = mfma16(aV[kk], bw, acc); }
        const int prow = pt * 16 + fr; const float bias = bs[prow];
        const size_t row = (size_t)chunk * 128 + prow; const int col = slab * 128 + wid * 16 + fq * 4;
        const u32x2 uw = *(const u32x2*)(uv + row * 4096 + col);
        u32x2 w; w.x = cvt_pk_bf16(bflo(uw.x) * (acc[0] + bias), bfhi(uw.x) * (acc[1] + bias)); w.y = cvt_pk_bf16(bflo(uw.y) * (acc[2] + bias), bfhi(uw.y) * (acc[3] + bias));
        *(u32x2*)(gated + row * 2048 + col) = w;
    }
    __syncthreads();
}

#define XB_TMO      128
#define XB_XCNT(j)  (256  + 64 * (j))
#define XB_XSUB(j)  (1280 + 64 * (j))
#define XB_XGEN(j)  (2304 + 64 * (j))
#define XB_TOP      3328
#define XB_TOPGEN   3392
#define XCD_BAR_WORDS 3456
#define XB_SPIN_CAP (1u << 18)

__device__ __forceinline__ unsigned xb_ld(unsigned* p)              { return __hip_atomic_load(p, __ATOMIC_RELAXED, __HIP_MEMORY_SCOPE_AGENT); }
__device__ __forceinline__ unsigned xb_add(unsigned* p, unsigned v) { return __hip_atomic_fetch_add(p, v, __ATOMIC_RELAXED, __HIP_MEMORY_SCOPE_AGENT); }
__device__ __forceinline__ unsigned xb_xcc_id() { return (unsigned)__builtin_amdgcn_s_getreg((3 << 11) | 20) & 0xFu; }
#define XB_SPIN(cond, bar) do { unsigned _sp = 0; while (cond) { __builtin_amdgcn_s_sleep(1); \
    if ((++_sp & 255u) == 0u) { if (xb_ld(&(bar)[XB_TMO])) break; if (_sp > XB_SPIN_CAP) { atomicAdd(&(bar)[XB_TMO], 1u); break; } } } } while (0)

struct XcdBarrier {
    unsigned* bar; unsigned x;
    volatile LAS unsigned* st;
};

__device__ __forceinline__ XcdBarrier xcd_barrier_post(unsigned* bar, volatile LAS unsigned* st) {
    XcdBarrier b; b.bar = bar; b.x = xb_xcc_id(); b.st = st;
    if (threadIdx.x == 0) (void)xb_add(&bar[XB_XCNT(b.x)], 1u);
    return b;
}
__device__ __forceinline__ void xcd_barrier_complete(unsigned* bar, unsigned x, unsigned& nloc, unsigned& nx) {
    const unsigned G = gridDim.x * gridDim.y * gridDim.z;
    unsigned sum, cnt, mine, sp = 0u;
    for (;;) {
        sum = 0u; cnt = 0u; mine = 0u;
#pragma unroll
        for (unsigned j = 0; j < 16; ++j) { const unsigned c = xb_ld(&bar[XB_XCNT(j)]); sum += c; cnt += (c > 0u) ? 1u : 0u; mine = (j == x) ? c : mine; }
        if (sum == G) break;
        __builtin_amdgcn_s_sleep(1);
        if ((++sp & 255u) == 0u) { if (xb_ld(&bar[XB_TMO])) break; if (sp > XB_SPIN_CAP) { atomicAdd(&bar[XB_TMO], 1u); break; } }
    }
    nloc = mine > 0u ? mine : 1u; nx = cnt > 0u ? cnt : 1u;
}

__device__ __forceinline__ void xcd_barrier(const XcdBarrier& b) {
    asm volatile("s_waitcnt vmcnt(0)" ::: "memory");
    __syncthreads();
    if (threadIdx.x == 0) {
        unsigned* bar = b.bar;
        __builtin_amdgcn_s_waitcnt(0);
        unsigned nloc = b.st[0], nx = b.st[1];
        if (nloc == 0u) { xcd_barrier_complete(bar, b.x, nloc, nx); b.st[0] = nloc; b.st[1] = nx; }
        const unsigned old = xb_add(&bar[XB_XSUB(b.x)], 1u);
        const unsigned gen = old / nloc;
        if (old + 1u == (gen + 1u) * nloc) {
            __builtin_amdgcn_fence(__ATOMIC_RELEASE, "agent");
            asm volatile("s_waitcnt vmcnt(0)" ::: "memory");
            const unsigned og = xb_add(&bar[XB_TOP], 1u);
            const unsigned tg = og / nx;
            if (og + 1u == (tg + 1u) * nx) xb_add(&bar[XB_TOPGEN], 1u);
            else XB_SPIN(xb_ld(&bar[XB_TOPGEN]) == tg, bar);
            __builtin_amdgcn_fence(__ATOMIC_ACQUIRE, "agent");
            xb_add(&bar[XB_XGEN(b.x)], 1u);
            asm volatile("s_waitcnt vmcnt(0)" ::: "memory");
        } else {
            XB_SPIN(xb_ld(&bar[XB_XGEN(b.x)]) == gen, bar);
            __builtin_amdgcn_fence(__ATOMIC_ACQUIRE, "agent");
            asm volatile("s_waitcnt vmcnt(0)" ::: "memory");
        }
    }
    __syncthreads();
}

constexpr size_t OFF_BAR = (size_t)520 << 20;

constexpr int STEPS = 13, NPH = 1 + 4 * STEPS;

__global__ void __launch_bounds__(512, 2) mega(Params p) {
    extern __shared__ __attribute__((aligned(16))) unsigned char shm[];
    LAS unsigned char* lds = (LAS unsigned char*)shm;
    cg::grid_group grid = cg::this_grid();
    __shared__ uint4 xb_words;
    if (threadIdx.x == 0) xb_words = make_uint4(0u, 0u, 0u, 0u);
    __syncthreads();
    if (p.ph_end - p.ph_begin > 1) (void)xcd_barrier_post((unsigned*)(p.ws + OFF_BAR), (volatile LAS unsigned*)&xb_words);
    bf16_t* hbuf = (bf16_t*)(p.ws + OFF_H);
    float* mod = (float*)(p.ws + OFF_MOD);
    bool first = true;
    for (int ph = p.ph_begin; ph < p.ph_end; ++ph) {
        int l = 0, s = -1;
        if (ph > 0) { l = (ph - 1) / STEPS; s = (ph - 1) % STEPS; }
        const bool odd = (l & 1) != 0; const int j = l >> 1;
        if (odd && (s == 7 || s == 8 || s == 9)) continue;
        if (s == 3 || s == 7 || s == 10 || (s == 0 && l > 0)) continue;
        if (!first) { if (p.ph_begin < 0) grid.sync(); else { XcdBarrier xb; xb.bar = (unsigned*)(p.ws + OFF_BAR); xb.x = xb_xcc_id(); xb.st = (volatile LAS unsigned*)&xb_words; xcd_barrier(xb); } }
        first = false;
        const int bid = obid(), G = ogrid();
        if (ph == 0) { prologue_phase(p, lds); continue; }
        switch (s) {
            case 0: prologue_b(p, lds); break;
            case 1: {
                pg8::Gemm g{hbuf, (const bf16_t*)(p.ws + OFF_WGU1) + (size_t)l * 5632 * 1024, T_ALL, 5632, 1024};
                pg8::StaticOrder S; S.init(g.M, g.N, G, bid);
                EpiSwiGLU E{(bf16_t*)(p.ws + OFF_ACT), (const float*)(p.ws + OFF_RSP), (const float*)(p.ws + OFF_BIAS) + (size_t)(l * 3 + 0) * 9 * 5632};
                pg8::gemm_phase(lds, g, S, E);
            } break;
            case 11: {
                pg8::Gemm g{hbuf, (const bf16_t*)(p.ws + OFF_WGU2) + (size_t)l * 5632 * 1024, T_ALL, 5632, 1024};
                pg8::StaticOrder S; S.init(g.M, g.N, G, bid);
                EpiSwiGLU E{(bf16_t*)(p.ws + OFF_ACT), (const float*)(p.ws + OFF_RSP), (const float*)(p.ws + OFF_BIAS) + (size_t)(l * 3 + 2) * 9 * 5632};
                pg8::gemm_phase(lds, g, S, E);
            } break;
            case 2: {
                pg8::Gemm g{(const bf16_t*)(p.ws + OFF_ACT), (const bf16_t*)(p.ws + OFF_WD1) + (size_t)l * 1024 * 2816, T_ALL, 1024, 2816};
                EpiResid E{p, l, 2};
                pg8::StaticOrder S; S.init(g.M, g.N, G, bid);
                pg8::gemm_phase(lds, g, S, E);
            } break;
            case 12: {
                pg8::Gemm g{(const bf16_t*)(p.ws + OFF_ACT), (const bf16_t*)(p.ws + OFF_WD2) + (size_t)l * 1024 * 2816, T_ALL, 1024, 2816};
                EpiResid E{p, l, 11};
                pg8::StaticOrder S; S.init(g.M, g.N, G, bid);
                pg8::gemm_phase(lds, g, S, E);
            } break;
            case 6: {
                if (!odd) {
                    {
                        pg8::Gemm g{(const bf16_t*)(p.ws + OFF_CQN), (const bf16_t*)(p.ws + OFF_WQB) + (size_t)j * 768 * 384, T_ALL, 768, 384};
                        EpiBf16 E{(bf16_t*)(p.ws + OFF_QRAW), 768, nullptr, nullptr};
                        pg8::StaticOrder S; S.init(g.M, g.N, G, bid);
                        pg8::gemm_phase(lds, g, S, E);
                    }
                    {
                        pg8::Gemm g{(const bf16_t*)(p.ws + OFF_CKVN), (const bf16_t*)(p.ws + OFF_WKVB) + (size_t)j * 1024 * 256, T_KV, 1024, 256};
                        EpiBf16 E{(bf16_t*)(p.ws + OFF_KVRAW), 1024, nullptr, nullptr};
                        pg8::StaticOrder S; S.init(g.M, g.N, G, (bid + G - (192 % G)) % G);
                        pg8::gemm_phase(lds, g, S, E);
                        Unit uu;
                        for (int i = 0; S.next(i, uu); ++i)
                            for (int q = 0; q < 8; ++q) kprep_tile(p, lds, j, ((uu.pm * 4 + (q >> 1)) << 3) | (uu.pn * 2 + (q & 1)));
                    }
                } else {
                    pg8::Gemm g{(const bf16_t*)(p.ws + OFF_GATED), (const bf16_t*)(p.ws + OFF_WOUTO) + (size_t)j * 1024 * 2048, T_ALL, 1024, 2048};
                    EpiResid E{p, l, 6};
                    pg8::StaticOrder S; S.init(g.M, g.N, G, bid);
                    pg8::gemm_phase(lds, g, S, E);
                }
            } break;
            case 9: {
                pg8::Gemm g{(const bf16_t*)(p.ws + OFF_CAT), (const bf16_t*)(p.ws + OFF_WOUTE) + (size_t)j * 1024 * 1024, T_ALL, 1024, 1024};
                EpiResid E{p, l, 8};
                pg8::StaticOrder S; S.init(g.M, g.N, G, bid);
                pg8::gemm_phase(lds, g, S, E);
            } break;
            case 4: {
                if (!odd) {
                    pg8::Gemm g{hbuf, (const bf16_t*)(p.ws + OFF_WINE) + (size_t)j * 2304 * 1024, T_ALL, 2304, 1024};
                    pg8::StaticOrder S; S.init(g.M, g.N, G, bid);
                    EpiBf16 E{(bf16_t*)(p.ws + OFF_PROJ), PROJ_LD, (const float*)(p.ws + OFF_RSP), (const float*)(p.ws + OFF_BIAS) + (size_t)(l * 3 + 1) * 9 * 5632};
                    pg8::gemm_phase(lds, g, S, E);
                } else {
                    pg8::Gemm g{hbuf, (const bf16_t*)(p.ws + OFF_WINO) + (size_t)j * 4096 * 1024, T_ALL, 4096, 1024};
                    pg8::StaticOrder S; S.init(g.M, g.N, G, bid);
                    EpiGeluUV E{(bf16_t*)(p.ws + OFF_UV), (float*)(p.ws + OFF_SSP), (const float*)(p.ws + OFF_RSP), (const float*)(p.ws + OFF_BIAS) + (size_t)(l * 3 + 1) * 9 * 5632};
                    pg8::gemm_phase(lds, g, S, E);
                }
            } break;
            case 5: {
                if (!odd) even2_phase(p, lds, j);
                else for (int t = bid; t < 2048; t += G) spatial_tile(p, lds, j, t);
            } break;
            case 7: {
                for (int t = bid; t < 2304; t += G) kprep_tile(p, lds, j, t);
            } break;
            case 8: {
                if (G == 256) {
                    const int xcd = bid & 7, slot = bid >> 3;
                    attn_tile(p, lds, j, (xcd * 8 + (slot >> 2)) * 4 + (slot & 3)); __syncthreads();
                    attn_tile(p, lds, j, 256 + xcd * 32 + slot); __syncthreads();
                } else {
                    for (int t = bid; t < 512; t += G) { attn_tile(p, lds, j, t); __syncthreads(); }
                }
                gla_finish_rows(p, j);
            } break;
            default: break;
        }
    }
}


extern "C" void kernel_launch(void* const* d_in, const int* in_sizes, int n_in, void* d_out, int out_size, void* d_ws, size_t ws_size, hipStream_t stream) {
    constexpr size_t kDynLds = 131072;
    static int grid_blocks = 0;
    if (!grid_blocks) {
        hipFuncSetAttribute((const void*)mega, hipFuncAttributeMaxDynamicSharedMemorySize, (int)kDynLds);
        int dev = 0, cus = 0, per_cu = 0;
        hipGetDevice(&dev);
        hipDeviceGetAttribute(&cus, hipDeviceAttributeMultiprocessorCount, dev);
        hipOccupancyMaxActiveBlocksPerMultiprocessor(&per_cu, mega, 512, kDynLds);
        if (per_cu < 1) per_cu = 1;
        if (per_cu > 1) per_cu = 1;
        grid_blocks = cus * per_cu;
    }
    Params p{};
    for (int i = 0; i < 32; ++i) p.in[i] = (const float*)d_in[i];
    p.out = (float*)d_out; p.ws = (unsigned char*)d_ws; p.ph_begin = 0; p.ph_end = NPH;
    hipMemsetAsync((unsigned char*)d_ws + OFF_BAR, 0, XCD_BAR_WORDS * sizeof(unsigned), stream);
    void* args[] = {&p};
    hipError_t e = hipLaunchCooperativeKernel((void*)mega, dim3(grid_blocks), dim3(512), args, kDynLds, stream);
    if (e != hipSuccess) fprintf(stderr, "cooperative launch failed: %s (grid %d)\n", hipGetErrorString(e), grid_blocks);
}
```

```cpp
#include <hip/hip_runtime.h>
#include <hip/hip_cooperative_groups.h>
#include <cstdio>
namespace cg = cooperative_groups;

#define LAS __attribute__((address_space(3)))
typedef unsigned short bf16_t;
typedef short bf16x8 __attribute__((ext_vector_type(8)));
typedef short bf16x4 __attribute__((ext_vector_type(4)));
typedef float f32x4 __attribute__((ext_vector_type(4)));
typedef float f32x2 __attribute__((ext_vector_type(2)));
typedef unsigned u32x4 __attribute__((ext_vector_type(4)));
typedef unsigned u32x2 __attribute__((ext_vector_type(2)));

constexpr int T_CTX = 8192, T_ALL = 16384, T_KV = 18432;
constexpr int PROJ_LD = 2304;
constexpr float EPS = 1e-6f;


constexpr size_t SZ_WGU = (size_t)4 * 5632 * 1024 * 2, SZ_WD = (size_t)4 * 1024 * 2816 * 2;
constexpr size_t OFF_WGU1 = 0;
constexpr size_t OFF_WD1 = OFF_WGU1 + SZ_WGU;
constexpr size_t OFF_WGU2 = OFF_WD1 + SZ_WD;
constexpr size_t OFF_WD2 = OFF_WGU2 + SZ_WGU;
constexpr size_t OFF_WINE = OFF_WD2 + SZ_WD;
constexpr size_t OFF_WOUTE = OFF_WINE + (size_t)2 * 2304 * 1024 * 2;
constexpr size_t OFF_WQB = OFF_WOUTE + (size_t)2 * 1024 * 1024 * 2;
constexpr size_t OFF_WKVB = OFF_WQB + (size_t)2 * 768 * 384 * 2;
constexpr size_t OFF_WINO = OFF_WKVB + (size_t)2 * 1024 * 256 * 2;
constexpr size_t OFF_WOUTO = OFF_WINO + (size_t)2 * 4096 * 1024 * 2;
constexpr size_t OFF_WS = OFF_WOUTO + (size_t)2 * 1024 * 2048 * 2;
constexpr size_t OFF_MOD = OFF_WS + (size_t)2 * 4 * 128 * 128 * 2;
constexpr size_t OFF_H = OFF_MOD + (size_t)4 * 9 * 9216 * 4;
constexpr size_t OFF_U = OFF_H + (size_t)T_ALL * 1024 * 2;
constexpr size_t OFF_ACT = OFF_U;
constexpr size_t OFF_PROJ = OFF_U;
constexpr size_t OFF_CQN = OFF_PROJ + (size_t)T_ALL * PROJ_LD * 2;
constexpr size_t OFF_CKVN = OFF_CQN + (size_t)T_ALL * 384 * 2;
constexpr size_t OFF_QRAW = OFF_CKVN + (size_t)T_KV * 256 * 2;
constexpr size_t OFF_KVRAW = OFF_QRAW + (size_t)T_ALL * 768 * 2;
constexpr size_t OFF_OF = OFF_KVRAW + (size_t)T_KV * 1024 * 2;
constexpr size_t OFF_OB = OFF_OF + (size_t)T_ALL * 512 * 4;
constexpr size_t OFF_CAT = OFF_OB + (size_t)T_ALL * 512 * 4;
constexpr size_t OFF_UV = OFF_U;
constexpr size_t OFF_GATED = OFF_UV + (size_t)T_ALL * 4096 * 2;
constexpr size_t OFF_SSP = OFF_GATED + (size_t)T_ALL * 2048 * 2;

constexpr size_t OFF_BIAS = (size_t)522 << 20;
constexpr size_t OFF_RSP = (size_t)526 << 20;
constexpr size_t OFF_KN = (size_t)456 << 20;
constexpr size_t OFF_VT = (size_t)484 << 20;
constexpr size_t VT_LAT = (size_t)32 * 8 * 64 * 256;
constexpr size_t OUT_CKV = 16777216, OUT_KROPE = 20971520, OUT_GLA = 21495808;

struct Params {
    const float* in[32];
    float* out;
    unsigned char* ws;
    int ph_begin, ph_end;
};

__device__ __forceinline__ int otid() { int t = threadIdx.x; asm volatile("" : "+v"(t)); return t; }
__device__ __forceinline__ int obid() { int t = blockIdx.x; asm volatile("" : "+s"(t)); return t; }
__device__ __forceinline__ int ogrid() { int t = gridDim.x; asm volatile("" : "+s"(t)); return t; }
__device__ __forceinline__ const float* pin(const Params& p, int i) { asm volatile("" : "+s"(i)); return p.in[i]; }
typedef __bf16 bf16x2_t __attribute__((ext_vector_type(2)));
__device__ __forceinline__ unsigned cvt_pk_bf16(float lo, float hi) { const f32x2 v = {lo, hi}; return __builtin_bit_cast(unsigned, __builtin_convertvector(v, bf16x2_t)); }
__device__ __forceinline__ unsigned pack_bf16_sw(float lo, float hi) {
    unsigned a = __float_as_uint(lo), b = __float_as_uint(hi);
    a += 0x7fffu + ((a >> 16) & 1u); b += 0x7fffu + ((b >> 16) & 1u);
    return (a >> 16) | (b & 0xffff0000u);
}
__device__ __forceinline__ bf16_t f2bf(float f) { return (bf16_t)(cvt_pk_bf16(f, 0.f) & 0xffffu); }
__device__ __forceinline__ float bf2f(bf16_t b) { return __uint_as_float(((unsigned)b) << 16); }
__device__ __forceinline__ float bflo(unsigned w) { return __uint_as_float(w << 16); }
__device__ __forceinline__ float bfhi(unsigned w) { return __uint_as_float(w & 0xffff0000u); }
__device__ __forceinline__ float silu_f(float x) { return x * __builtin_amdgcn_rcpf(1.f + __expf(-x)); }
__device__ __forceinline__ float gelu_tanh_f(float x) { const float u = 1.5957691216f * (x + 0.044715f * x * x * x); return x * __builtin_amdgcn_rcpf(1.f + __expf(-u)); }
__device__ __forceinline__ float wave_sum(float v) {
    v += __shfl_xor(v, 1); v += __shfl_xor(v, 2); v += __shfl_xor(v, 4); v += __shfl_xor(v, 8); v += __shfl_xor(v, 16); v += __shfl_xor(v, 32); return v; }

namespace pg8 {
constexpr int BM = 256, BK = 64, HALF = 128, HTB = HALF * BK * 2, STAGE_BYTES = 8 * HTB, NXCD = 8, WGM = 8;
__device__ __forceinline__ int lds_byte(int r, int c) { const int st = (r >> 4) * 2 + (c >> 5), rr = r & 15, cc = c & 31, ob = rr * 64 + cc * 2; return st * 1024 + (ob ^ (((ob >> 9) & 1) << 5)); }
__device__ __forceinline__ void stage_rc(int b, int& R, int& C) { const int st = b / 1024, sb = b % 1024, swz = sb ^ (((sb >> 9) & 1) << 5); R = (st >> 1) * 16 + swz / 64; C = (st & 1) * 32 + (swz % 64) / 2; }
__device__ __forceinline__ int perm32(int rho) { const int n = rho >> 4, i = rho & 15; return 8 * (i >> 2) + 4 * n + (i & 3); }
struct Unit { int pm, pn; };
struct Gemm { const bf16_t* A; const bf16_t* Bt; int M, N, K; };
struct StaticOrder {
    int nM, nN, nwg, G, c;
    __device__ void init(int M, int N, int G_, int c_) { nM = M / BM; nN = N / BM; nwg = nM * nN; G = G_; c = c_; }
    __device__ bool next(int i, Unit& u) const {
        const long L = (long)i * G + c; if (L >= nwg) return false;
        int wgid = (int)L; { const int q = nwg / NXCD, r = nwg % NXCD, xcd = wgid % NXCD, off = wgid / NXCD; wgid = (xcd < r ? xcd * (q + 1) : r * (q + 1) + (xcd - r) * q) + off; }
        const int nig = WGM * nN, gid = wgid / nig, fm = gid * WGM, gsz = (nM - fm) < WGM ? (nM - fm) : WGM;
        u.pm = fm + ((wgid % nig) % gsz); u.pn = (wgid % nig) / gsz; return true;
    }
};

template <class Epi>
__device__ __forceinline__ void gemm_phase(LAS unsigned char* lds, const Gemm g, const StaticOrder& S, const Epi& E) {
    const int tid = otid(), wid = __builtin_amdgcn_readfirstlane(tid >> 6), lane = tid & 63, wr = wid >> 2, wc = wid & 3, fr = lane & 15, fq = lane >> 4;
    const int K = g.K, nt = K / BK;
    unsigned voffA[2], voffB[2];
#pragma unroll
    for (int i = 0; i < 2; ++i) { int R, C; stage_rc(tid * 16 + i * 8192, R, C); const int Rb = Epi::PERM ? ((R & ~31) + perm32(R & 31)) : R;
        voffA[i] = (unsigned)(R * K + C) * 2u; voffB[i] = (unsigned)(Rb * K + C) * 2u; }
    const size_t kstep = (size_t)(BK * 2);
    const size_t hstep = (size_t)HALF * K * 2;
    const size_t tstep = 2 * hstep;
    const unsigned ldsw = (unsigned)wid * 1024u;
    const int aoff = lds_byte(wr * 64 + fr, fq * 8), boff = lds_byte(wc * 32 + fr, fq * 8);
#define PG8_SA(b, h) (((b) * 2 + (h)) * HTB)
#define PG8_SB(b, h) ((4 + (b) * 2 + (h)) * HTB)
#define PG8_STAGE(bufoff, gbase, voff) do { _Pragma("unroll") for (int _i = 0; _i < 2; ++_i) \
        __builtin_amdgcn_global_load_lds((const unsigned*)((const char*)(gbase) + (voff)[_i]), (LAS unsigned*)(lds + (bufoff) + ldsw + _i * 8192), 16, 0, 0); } while (0)
#define PG8_LDA(dst, b, h) do { _Pragma("unroll") for (int m = 0; m < 4; ++m) _Pragma("unroll") for (int k = 0; k < 2; ++k) dst[m][k] = *(const LAS bf16x8*)(lds + PG8_SA(b, h) + aoff + m * 2048 + k * 1024); } while (0)
#define PG8_LDB(dst, b, h) do { _Pragma("unroll") for (int n = 0; n < 2; ++n) _Pragma("unroll") for (int k = 0; k < 2; ++k) dst[n][k] = *(const LAS bf16x8*)(lds + PG8_SB(b, h) + boff + n * 2048 + k * 1024); } while (0)
#define PG8_MMA(ai, bj, At, Bt) do { __builtin_amdgcn_s_setprio(1); _Pragma("unroll") for (int m = 0; m < 4; ++m) _Pragma("unroll") for (int n = 0; n < 2; ++n) _Pragma("unroll") for (int k = 0; k < 2; ++k) \
        acc[ai][bj][m][n] = __builtin_amdgcn_mfma_f32_16x16x32_bf16(Bt[n][k], At[m][k], acc[ai][bj][m][n], 0, 0, 0); __builtin_amdgcn_s_setprio(0); } while (0)
#define PG8_WAIT_V(n) asm volatile("s_waitcnt vmcnt(" #n ")" ::: "memory")
#define PG8_WAIT_L(n) asm volatile("s_waitcnt lgkmcnt(" #n ")" ::: "memory")
#define PG8_BAR __builtin_amdgcn_s_barrier()
#define PG8_SCHED __builtin_amdgcn_sched_barrier(0)
    Unit cur, nxt; int ui = 0;
    if (!S.next(0, cur)) return;
    f32x4 acc[2][2][4][2];
#pragma unroll
    for (int a = 0; a < 2; ++a)
#pragma unroll
        for (int b = 0; b < 2; ++b)
#pragma unroll
            for (int m = 0; m < 4; ++m)
#pragma unroll
                for (int n = 0; n < 2; ++n) acc[a][b][m][n] = (f32x4){0.f, 0.f, 0.f, 0.f};
    bf16x8 At[4][2], B0[2][2], B1[2][2];
    const char* cA = (const char*)g.A + (size_t)cur.pm * tstep; const char* cB = (const char*)g.Bt + (size_t)cur.pn * tstep;
    PG8_STAGE(PG8_SB(0, 0), cB, voffB); PG8_STAGE(PG8_SA(0, 0), cA, voffA); PG8_STAGE(PG8_SB(0, 1), cB + hstep, voffB); PG8_STAGE(PG8_SA(0, 1), cA + hstep, voffA);
    if (wr == 1) PG8_BAR;
    PG8_WAIT_V(4); PG8_BAR;
    PG8_STAGE(PG8_SB(1, 0), cB + kstep, voffB); PG8_STAGE(PG8_SA(1, 0), cA + kstep, voffA); PG8_STAGE(PG8_SB(1, 1), cB + hstep + kstep, voffB);
    PG8_WAIT_V(6); PG8_BAR;
    for (;;) {
        const bool has_next = S.next(ui + 1, nxt);
        const char* nA = has_next ? (const char*)g.A + (size_t)nxt.pm * tstep : cA; const char* nB = has_next ? (const char*)g.Bt + (size_t)nxt.pn * tstep : cB;
        for (int t = 0; t < nt; t += 2) {
            const bool last = (t == nt - 2);
            const char* a1 = cA + (size_t)(t + 1) * kstep;
            const char* a2 = last ? nA : cA + (size_t)(t + 2) * kstep; const char* b2 = last ? nB : cB + (size_t)(t + 2) * kstep;
            const char* a3 = a2 + kstep; const char* b3 = b2 + kstep;
            PG8_LDB(B0, 0, 0); PG8_SCHED; PG8_LDA(At, 0, 0); PG8_STAGE(PG8_SA(1, 1), a1 + hstep, voffA);
            PG8_WAIT_L(8); PG8_BAR; PG8_WAIT_L(0); PG8_MMA(0, 0, At, B0); PG8_BAR; PG8_SCHED;
            PG8_LDB(B1, 0, 1); PG8_STAGE(PG8_SB(0, 0), b2, voffB);
            PG8_BAR; PG8_WAIT_L(0); PG8_MMA(0, 1, At, B1); PG8_BAR;
            PG8_LDA(At, 0, 1); PG8_STAGE(PG8_SA(0, 0), a2, voffA);
            PG8_BAR; PG8_WAIT_L(0); PG8_MMA(1, 0, At, B0); PG8_BAR; PG8_SCHED;
            PG8_STAGE(PG8_SB(0, 1), b2 + hstep, voffB);
            PG8_WAIT_V(6); PG8_BAR; PG8_MMA(1, 1, At, B1); PG8_BAR;
            PG8_LDB(B0, 1, 0); PG8_SCHED; PG8_LDA(At, 1, 0); PG8_STAGE(PG8_SA(0, 1), a2 + hstep, voffA);
            PG8_WAIT_L(8); PG8_BAR; PG8_WAIT_L(0); PG8_MMA(0, 0, At, B0); PG8_BAR; PG8_SCHED;
            PG8_LDB(B1, 1, 1); PG8_STAGE(PG8_SB(1, 0), b3, voffB);
            PG8_BAR; PG8_WAIT_L(0); PG8_MMA(0, 1, At, B1); PG8_BAR;
            PG8_LDA(At, 1, 1); PG8_STAGE(PG8_SA(1, 0), a3, voffA);
            PG8_BAR; PG8_WAIT_L(0); PG8_MMA(1, 0, At, B0); PG8_BAR; PG8_SCHED;
            PG8_STAGE(PG8_SB(1, 1), b3 + hstep, voffB);
            PG8_WAIT_V(6); PG8_BAR; PG8_MMA(1, 1, At, B1); PG8_BAR;
        }
        E(acc, cur, wr, wc, fr, fq);
        if (!has_next) break;
#pragma unroll
        for (int a = 0; a < 2; ++a)
#pragma unroll
            for (int b = 0; b < 2; ++b)
#pragma unroll
                for (int m = 0; m < 4; ++m)
#pragma unroll
                    for (int n = 0; n < 2; ++n) acc[a][b][m][n] = (f32x4){0.f, 0.f, 0.f, 0.f};
        cur = nxt; cA = nA; cB = nB; ++ui;
    }
    PG8_WAIT_V(0);
    if (wr == 0) PG8_BAR;
    PG8_BAR;
#undef PG8_SA
#undef PG8_SB
#undef PG8_STAGE
#undef PG8_LDA
#undef PG8_LDB
#undef PG8_MMA
#undef PG8_WAIT_V
#undef PG8_WAIT_L
#undef PG8_BAR
#undef PG8_SCHED
}
}
using pg8::Unit;


struct Rstd8 { float v[2][4]; };
__device__ __forceinline__ Rstd8 load_rstd8(const float* rsp, int row0, int fq) {
    f32x4 pv[2][4]; Rstd8 r;
#pragma unroll
    for (int ai = 0; ai < 2; ++ai)
#pragma unroll
        for (int m = 0; m < 4; ++m) pv[ai][m] = *(const f32x4*)(rsp + (size_t)(row0 + ai * 128 + m * 16) * 16 + fq * 4);
#pragma unroll
    for (int ai = 0; ai < 2; ++ai)
#pragma unroll
        for (int m = 0; m < 4; ++m) {
            float t = pv[ai][m][0] + pv[ai][m][1] + pv[ai][m][2] + pv[ai][m][3];
            t += __shfl_xor(t, 16); t += __shfl_xor(t, 32);
            r.v[ai][m] = rsqrtf(t * (1.f / 1024.f) + EPS);
        }
    return r;
}
struct EpiSwiGLU {
    static constexpr bool PERM = true;
    bf16_t* O; const float* rsp; const float* bias;
    __device__ __forceinline__ void operator()(const f32x4 (&acc)[2][2][4][2], const Unit& u, int wr, int wc, int fr, int fq) const {
        const int cond = u.pm < 32 ? 0 : 1 + ((u.pm - 32) >> 2);
        const int row0 = u.pm * 256 + wr * 64 + fr, col0 = u.pn * 128 + wc * 32 + 8 * fq;
        const Rstd8 R = load_rstd8(rsp, row0, fq);
        const float* bp = bias + (size_t)cond * 5632 + u.pn * 256 + wc * 32 + 8 * fq;
        const f32x4 bg0 = *(const f32x4*)bp, bg1 = *(const f32x4*)(bp + 4), bu0 = *(const f32x4*)(bp + 128), bu1 = *(const f32x4*)(bp + 132);
#pragma unroll
        for (int ai = 0; ai < 2; ++ai)
#pragma unroll
            for (int m = 0; m < 4; ++m) {
                bf16_t* rowp = O + (size_t)(row0 + ai * 128 + m * 16) * 2816 + col0;
                const float rs = R.v[ai][m];
                f32x4 v0, v1;
#pragma unroll
                for (int j = 0; j < 4; ++j) {
                    v0[j] = silu_f(acc[ai][0][m][0][j] * rs + bg0[j]) * (acc[ai][1][m][0][j] * rs + bu0[j]);
                    v1[j] = silu_f(acc[ai][0][m][1][j] * rs + bg1[j]) * (acc[ai][1][m][1][j] * rs + bu1[j]);
                }
                u32x4 w; w.x = cvt_pk_bf16(v0[0], v0[1]); w.y = cvt_pk_bf16(v0[2], v0[3]); w.z = cvt_pk_bf16(v1[0], v1[1]); w.w = cvt_pk_bf16(v1[2], v1[3]);
                *(u32x4*)rowp = w;
            }
    }
};
struct EpiResid {
    static constexpr bool PERM = false;
    const Params& p; int l; int kind;
    __device__ __forceinline__ void operator()(const f32x4 (&acc)[2][2][4][2], const Unit& u, int wr, int wc, int fr, int fq) const {
        float* X = p.out; const float* mod = (const float*)(p.ws + OFF_MOD);
        const int gidx = kind == 2 ? 2 : (kind == 11 ? 8 : 5);
        const float coef = (kind == 2 || kind == 11) ? 0.5f : 1.0f;
        const float* gate = mod + (size_t)l * 9 * 9216 + gidx * 1024;
        const bool nn = !(kind == 11 && l == 3);
        const int nl = kind == 11 ? (l < 3 ? l + 1 : l) : l, ns = kind == 2 ? 1 : (kind == 11 ? 0 : 2);
        const float* ng = pin(p, 9) + (size_t)(nl * 3 + ns) * 1024;
        const float* msc = mod + (size_t)nl * 9 * 9216 + (size_t)(3 * ns + 1) * 1024;
        bf16_t* H = (bf16_t*)(p.ws + OFF_H); float* rsp = (float*)(p.ws + OFF_RSP);
        const int cond = u.pm < 32 ? 0 : 1 + ((u.pm - 32) >> 2);
        const float* gp = gate + (size_t)cond * 9216;
        const int row0 = u.pm * 256 + wr * 64 + fr, col0 = u.pn * 256 + wc * 32 + 4 * fq;
        f32x4 gv[2][2], gs[2][2];
#pragma unroll
        for (int bj = 0; bj < 2; ++bj)
#pragma unroll
            for (int n = 0; n < 2; ++n) {
                gv[bj][n] = *(const f32x4*)(gp + col0 + bj * 128 + n * 16) * coef;
                gs[bj][n] = (f32x4){0.f, 0.f, 0.f, 0.f};
                if (nn) gs[bj][n] = *(const f32x4*)(ng + col0 + bj * 128 + n * 16) * (*(const f32x4*)(msc + (size_t)cond * 9216 + col0 + bj * 128 + n * 16) + 1.f);
            }
#pragma unroll
        for (int ai = 0; ai < 2; ++ai)
#pragma unroll
            for (int mp = 0; mp < 2; ++mp) {
                f32x4 xv[2][2][2];
#pragma unroll
                for (int mi = 0; mi < 2; ++mi)
#pragma unroll
                    for (int bj = 0; bj < 2; ++bj)
#pragma unroll
                        for (int n = 0; n < 2; ++n) xv[mi][bj][n] = *(const f32x4*)(X + (size_t)(row0 + ai * 128 + (mp * 2 + mi) * 16) * 1024 + col0 + bj * 128 + n * 16);
#pragma unroll
                for (int mi = 0; mi < 2; ++mi) {
                    const int m = mp * 2 + mi;
                    const int row = row0 + ai * 128 + m * 16;
                    float* rowp = X + (size_t)row * 1024 + col0;
                    float ss = 0.f;
#pragma unroll
                    for (int bj = 0; bj < 2; ++bj)
#pragma unroll
                        for (int n = 0; n < 2; ++n) {
                            const f32x4 xn = xv[mi][bj][n] + gv[bj][n] * acc[ai][bj][m][n];
                            *(f32x4*)(rowp + bj * 128 + n * 16) = xn;
                            if (nn) {
                                ss += xn[0] * xn[0] + xn[1] * xn[1] + xn[2] * xn[2] + xn[3] * xn[3];
                                const f32x4 hv = xn * gs[bj][n];
                                u32x2 w; w.x = cvt_pk_bf16(hv[0], hv[1]); w.y = cvt_pk_bf16(hv[2], hv[3]);
                                *(u32x2*)(H + (size_t)row * 1024 + col0 + bj * 128 + n * 16) = w;
                            }
                        }
                    if (nn) { ss += __shfl_xor(ss, 16); ss += __shfl_xor(ss, 32); if (fq == 0) rsp[(size_t)row * 16 + u.pn * 4 + wc] = ss; }
                }
            }
    }
};
struct EpiBf16 {
    static constexpr bool PERM = true;
    bf16_t* O; int ldc; const float* rsp; const float* bias;
    __device__ __forceinline__ void operator()(const f32x4 (&acc)[2][2][4][2], const Unit& u, int wr, int wc, int fr, int fq) const {
        const int row0 = u.pm * 256 + wr * 64 + fr, col0 = u.pn * 256 + wc * 32 + 8 * fq;
        const bool nn = rsp != nullptr;
        f32x4 b0[2], b1[2]; Rstd8 R;
#pragma unroll
        for (int bj = 0; bj < 2; ++bj) { b0[bj] = (f32x4){0.f, 0.f, 0.f, 0.f}; b1[bj] = b0[bj]; }
#pragma unroll
        for (int ai = 0; ai < 2; ++ai)
#pragma unroll
            for (int m = 0; m < 4; ++m) R.v[ai][m] = 1.f;
        if (nn) {
            const int cond = u.pm < 32 ? 0 : 1 + ((u.pm - 32) >> 2);
            R = load_rstd8(rsp, row0, fq);
#pragma unroll
            for (int bj = 0; bj < 2; ++bj) { const float* bp = bias + (size_t)cond * 5632 + col0 + bj * 128; b0[bj] = *(const f32x4*)bp; b1[bj] = *(const f32x4*)(bp + 4); }
        }
#pragma unroll
        for (int ai = 0; ai < 2; ++ai)
#pragma unroll
            for (int m = 0; m < 4; ++m) {
                bf16_t* rowp = O + (size_t)(row0 + ai * 128 + m * 16) * ldc + col0;
                const float rs = R.v[ai][m];
#pragma unroll
                for (int bj = 0; bj < 2; ++bj) {
                    const f32x4 v0 = acc[ai][bj][m][0] * rs + b0[bj], v1 = acc[ai][bj][m][1] * rs + b1[bj];
                    u32x4 w; w.x = cvt_pk_bf16(v0[0], v0[1]); w.y = cvt_pk_bf16(v0[2], v0[3]); w.z = cvt_pk_bf16(v1[0], v1[1]); w.w = cvt_pk_bf16(v1[2], v1[3]);
                    *(u32x4*)(rowp + bj * 128) = w;
                }
            }
    }
};
struct EpiGeluUV {
    static constexpr bool PERM = true;
    bf16_t* O; float* ssp; const float* rsp; const float* bias;
    __device__ __forceinline__ void operator()(const f32x4 (&acc)[2][2][4][2], const Unit& u, int wr, int wc, int fr, int fq) const {
        const int cond = u.pm < 32 ? 0 : 1 + ((u.pm - 32) >> 2);
        const int row0 = u.pm * 256 + wr * 64 + fr, col0 = u.pn * 256 + wc * 32 + 8 * fq;
        const Rstd8 R = load_rstd8(rsp, row0, fq);
        f32x4 b0[2], b1[2];
#pragma unroll
        for (int bj = 0; bj < 2; ++bj) { const float* bp = bias + (size_t)cond * 5632 + col0 + bj * 128; b0[bj] = *(const f32x4*)bp; b1[bj] = *(const f32x4*)(bp + 4); }
#pragma unroll
        for (int ai = 0; ai < 2; ++ai)
#pragma unroll
            for (int m = 0; m < 4; ++m) {
                const int row = row0 + ai * 128 + m * 16;
                bf16_t* rowp = O + (size_t)row * 4096 + col0;
                const float rs = R.v[ai][m];
                float ss = 0.f;
#pragma unroll
                for (int bj = 0; bj < 2; ++bj) {
                    f32x4 v0, v1;
#pragma unroll
                    for (int j = 0; j < 4; ++j) { v0[j] = gelu_tanh_f(acc[ai][bj][m][0][j] * rs + b0[bj][j]); v1[j] = gelu_tanh_f(acc[ai][bj][m][1][j] * rs + b1[bj][j]); ss += v0[j] * v0[j] + v1[j] * v1[j]; }
                    u32x4 w; w.x = cvt_pk_bf16(v0[0], v0[1]); w.y = cvt_pk_bf16(v0[2], v0[3]); w.z = cvt_pk_bf16(v1[0], v1[1]); w.w = cvt_pk_bf16(v1[2], v1[3]);
                    *(u32x4*)(rowp + bj * 128) = w;
                }
                if (u.pn >= 8) { ss += __shfl_xor(ss, 16); ss += __shfl_xor(ss, 32); if (fq == 0) ssp[(size_t)row * 32 + (u.pn - 8) * 4 + wc] = ss; }
            }
    }
};

struct TJob { int src; int batch, K, N; unsigned long long dst; int rows_pb, blk, blk_stride, off; };
__device__ const TJob g_jobs[12] = {
    {10, 4, 1024, 2816, OFF_WGU1, 5632, 128, 256, 0},
    {11, 4, 1024, 2816, OFF_WGU1, 5632, 128, 256, 128},
    {12, 4, 2816, 1024, OFF_WD1, 1024, 1024, 1024, 0},
    {13, 4, 1024, 2816, OFF_WGU2, 5632, 128, 256, 0},
    {14, 4, 1024, 2816, OFF_WGU2, 5632, 128, 256, 128},
    {15, 4, 2816, 1024, OFF_WD2, 1024, 1024, 1024, 0},
    {16, 2, 1024, 2240, OFF_WINE, 2304, 4096, 4096, 0},
    {17, 2, 1024, 1024, OFF_WOUTE, 1024, 1024, 1024, 0},
    {22, 2, 384, 768, OFF_WQB, 768, 1024, 1024, 0},
    {24, 2, 256, 1024, OFF_WKVB, 1024, 1024, 1024, 0},
    {27, 2, 1024, 4096, OFF_WINO, 4096, 4096, 4096, 0},
    {31, 2, 2048, 1024, OFF_WOUTO, 1024, 1024, 1024, 0}};
__device__ __forceinline__ TJob get_job(int j) { return g_jobs[j]; }
constexpr int NJOBS = 12;
__device__ __forceinline__ int job_tiles(const TJob& J) { return J.batch * (J.K / 128) * ((J.N + 127) / 128); }

__device__ __forceinline__ void tt_load(const Params& p, const TJob& J, int t, int tid, f32x4 (&va)[4], f32x4 (&vb)[4]) {
    const int nk = J.K / 128, nn = (J.N + 127) / 128;
    const int bt = t / (nk * nn), rem = t % (nk * nn), kt = rem / nn, ntile = rem % nn;
    const float* src = pin(p, J.src) + (size_t)bt * J.K * J.N + (size_t)(kt * 128) * J.N + ntile * 128;
    const int c4 = tid & 31, r0 = tid >> 5;
    const bool colok = (ntile * 128 + c4 * 4) < J.N;
#pragma unroll
    for (int i = 0; i < 4; ++i) {
        const int k = 2 * (r0 + 16 * i);
        if (colok) { va[i] = *(const f32x4*)(src + (size_t)k * J.N + c4 * 4); vb[i] = *(const f32x4*)(src + (size_t)(k + 1) * J.N + c4 * 4); }
        else { va[i] = (f32x4){0.f, 0.f, 0.f, 0.f}; vb[i] = va[i]; }
    }
}
__device__ __forceinline__ void tt_process(const Params& p, LAS unsigned char* lds, const TJob& J, int t, int tid, const f32x4 (&va)[4], const f32x4 (&vb)[4]) {
    const int nk = J.K / 128, nn = (J.N + 127) / 128;
    const int bt = t / (nk * nn), rem = t % (nk * nn), kt = rem / nn, ntile = rem % nn;
    LAS unsigned* sT = (LAS unsigned*)lds;
    const int c4 = tid & 31, r0 = tid >> 5;
#pragma unroll
    for (int i = 0; i < 4; ++i) {
        const int k2 = r0 + 16 * i;
#pragma unroll
        for (int e = 0; e < 4; ++e) sT[(c4 * 4 + e) * 65 + k2] = cvt_pk_bf16(va[i][e], vb[i][e]);
    }
    __syncthreads();
    bf16_t* dstb = (bf16_t*)(p.ws + J.dst) + (size_t)bt * J.rows_pb * J.K + kt * 128;
    const int k8 = tid & 15, nr = tid >> 4;
#pragma unroll
    for (int i = 0; i < 4; ++i) {
        const int nl = nr + 32 * i, n = ntile * 128 + nl;
        if (n < J.N) {
            u32x4 w; w.x = sT[nl * 65 + k8 * 4]; w.y = sT[nl * 65 + k8 * 4 + 1]; w.z = sT[nl * 65 + k8 * 4 + 2]; w.w = sT[nl * 65 + k8 * 4 + 3];
            const int drow = (n / J.blk) * J.blk_stride + (n % J.blk) + J.off;
            *(u32x4*)(dstb + (size_t)drow * J.K + k8 * 8) = w;
        }
    }
    __syncthreads();
}
__device__ __forceinline__ void transpose_job(const Params& p, LAS unsigned char* lds, const TJob& J, int t0, int nt, int G) {
    const int tid = otid();
    for (int t = t0; t < nt; t += 4 * G) {
        f32x4 va[4][4], vb[4][4];
#pragma unroll
        for (int q = 0; q < 4; ++q) if (t + q * G < nt) tt_load(p, J, t + q * G, tid, va[q], vb[q]);
#pragma unroll
        for (int q = 0; q < 4; ++q) if (t + q * G < nt) tt_process(p, lds, J, t + q * G, tid, va[q], vb[q]);
    }
}

__device__ __forceinline__ void mod_tile(const Params& p, LAS unsigned char* lds, int t) {
    const int tid = otid();
    const int l = t / 72, n0 = (t % 72) * 128;
    LAS float* sC = (LAS float*)lds;
    LAS float* sR = (LAS float*)(lds + 36864);
    { const float* cctx = pin(p, 3); const float* cc = pin(p, 2);
      for (int i = tid; i < 9 * 1024; i += 512) { const int c = i >> 10, k = i & 1023; const float v = c == 0 ? cctx[k] : cc[(c - 1) * 1024 + k]; sC[i] = silu_f(v); } }
    __syncthreads();
    const int cgp = tid & 31, ks = tid >> 5;
    const float* w = pin(p, 7) + (size_t)l * 1024 * 9216 + (size_t)(ks * 64) * 9216 + n0 + cgp * 4;
    f32x4 acc[9];
#pragma unroll
    for (int c = 0; c < 9; ++c) acc[c] = (f32x4){0.f, 0.f, 0.f, 0.f};
    for (int k0 = 0; k0 < 64; k0 += 8) {
        f32x4 wv[8];
#pragma unroll
        for (int i = 0; i < 8; ++i) wv[i] = *(const f32x4*)(w + (size_t)(k0 + i) * 9216);
#pragma unroll
        for (int i = 0; i < 8; ++i)
#pragma unroll
            for (int c = 0; c < 9; ++c) acc[c] += wv[i] * sC[c * 1024 + ks * 64 + k0 + i];
    }
#pragma unroll
    for (int c = 0; c < 9; ++c) *(LAS f32x4*)(sR + (ks * 9 + c) * 128 + cgp * 4) = acc[c];
    __syncthreads();
    float* mod = (float*)(p.ws + OFF_MOD);
    const float* adab = pin(p, 8);
    for (int i = tid; i < 9 * 128; i += 512) {
        const int c = i >> 7, col = i & 127;
        float s = adab[l * 9216 + n0 + col];
#pragma unroll
        for (int k = 0; k < 16; ++k) s += sR[(k * 9 + c) * 128 + col];
        mod[((size_t)l * 9 + c) * 9216 + n0 + col] = s;
    }
    __syncthreads();
}

__device__ __forceinline__ void prologue_phase(const Params& p, LAS unsigned char* lds) {
    const int tid = otid(), G = ogrid(), bid = obid();
    for (int t = bid; t < 288; t += G) mod_tile(p, lds, t);
    {
        const float* s = pin(p, 29); bf16_t* d = (bf16_t*)(p.ws + OFF_WS);
        for (int i = bid * 512 + tid; i < 2 * 4 * 128 * 128 / 2; i += G * 512) ((unsigned*)d)[i] = cvt_pk_bf16(s[2 * i], s[2 * i + 1]);
    }
    int base = 0;
    for (int j = 0; j < NJOBS; ++j) {
        const TJob J = get_job(j); const int nt = job_tiles(J);
        transpose_job(p, lds, J, (bid + G - (base % G)) % G, nt, G);
        base += nt;
    }
}


__device__ __forceinline__ void prologue_b(const Params& p, LAS unsigned char* lds) {
    const int tid = otid(), wid = tid >> 6, lane = tid & 63, bid = obid(), G = ogrid();
    const float* mod = (const float*)(p.ws + OFF_MOD);
    {
        const float* g = pin(p, 9); const float* x0 = pin(p, 0); const float* x1 = pin(p, 1);
        bf16_t* h = (bf16_t*)(p.ws + OFF_H); float* rsp = (float*)(p.ws + OFF_RSP);
        for (int row = bid * 8 + wid; row < T_ALL; row += G * 8) {
            const int cond = row < T_CTX ? 0 : 1 + ((row - T_CTX) >> 10);
            const float* src = row < T_CTX ? x0 + (size_t)row * 1024 : x1 + (size_t)(row - T_CTX) * 1024;
            const float* mp = mod + (size_t)cond * 9216 + 1024;
            f32x4 v[4]; float ss = 0.f;
#pragma unroll
            for (int i = 0; i < 4; ++i) { v[i] = *(const f32x4*)(src + i * 256 + lane * 4); ss += v[i][0] * v[i][0] + v[i][1] * v[i][1] + v[i][2] * v[i][2] + v[i][3] * v[i][3]; }
            ss = wave_sum(ss);
#pragma unroll
            for (int i = 0; i < 4; ++i) {
                const int col = i * 256 + lane * 4;
                const f32x4 gs = *(const f32x4*)(g + col) * (*(const f32x4*)(mp + col) + 1.f);
                const f32x4 hv = v[i] * gs;
                u32x2 w; w.x = cvt_pk_bf16(hv[0], hv[1]); w.y = cvt_pk_bf16(hv[2], hv[3]);
                *(u32x2*)(h + (size_t)row * 1024 + col) = w;
                *(f32x4*)(p.out + (size_t)row * 1024 + col) = v[i];
            }
            if (lane < 16) rsp[(size_t)row * 16 + lane] = lane == 0 ? ss : 0.f;
        }
    }
    LAS float* sC = (LAS float*)lds;
    LAS float* sP = (LAS float*)(lds + 36864);
    float* biasb = (float*)(p.ws + OFF_BIAS);
    for (int item = bid; item < 452; item += G) {
        int u = 0, c0 = item;
#pragma unroll 1
        for (;;) { const int s3 = u % 3, lo = u / 3; const int nch = (s3 == 1) ? ((lo & 1) ? 32 : 18) : 44; if (c0 < nch) break; c0 -= nch; ++u; }
        const int l = u / 3, s3 = u % 3, j = l >> 1;
        const bf16_t* Bt = (s3 == 0) ? (const bf16_t*)(p.ws + OFF_WGU1) + (size_t)l * 5632 * 1024
                         : (s3 == 2) ? (const bf16_t*)(p.ws + OFF_WGU2) + (size_t)l * 5632 * 1024
                         : (l & 1)   ? (const bf16_t*)(p.ws + OFF_WINO) + (size_t)j * 4096 * 1024
                                     : (const bf16_t*)(p.ws + OFF_WINE) + (size_t)j * 2304 * 1024;
        __syncthreads();
        {
            float tmp[18];
#pragma unroll
            for (int i = 0; i < 18; ++i) { const int idx = tid + 512 * i, c = idx >> 10, k = idx & 1023; tmp[i] = mod[((size_t)l * 9 + c) * 9216 + (size_t)(3 * s3) * 1024 + k]; }
#pragma unroll
            for (int i = 0; i < 18; ++i) sC[tid + 512 * i] = tmp[i];
        }
        __syncthreads();
        const int rw = (wid & 1) * 64 + lane, ks = wid >> 1;
        const bf16_t* wrow = Bt + (size_t)(c0 * 128 + rw) * 1024 + ks * 256;
        float acc[9];
#pragma unroll
        for (int c = 0; c < 9; ++c) acc[c] = 0.f;
#pragma unroll 4
        for (int kk = 0; kk < 256; kk += 8) {
            const u32x4 ww = *(const u32x4*)(wrow + kk);
            float wv[8];
#pragma unroll
            for (int e = 0; e < 4; ++e) { wv[2 * e] = bflo(ww[e]); wv[2 * e + 1] = bfhi(ww[e]); }
#pragma unroll
            for (int c = 0; c < 9; ++c) {
                const f32x4 s0 = *(const LAS f32x4*)(sC + c * 1024 + ks * 256 + kk), s1 = *(const LAS f32x4*)(sC + c * 1024 + ks * 256 + kk + 4);
                acc[c] += wv[0] * s0[0] + wv[1] * s0[1] + wv[2] * s0[2] + wv[3] * s0[3] + wv[4] * s1[0] + wv[5] * s1[1] + wv[6] * s1[2] + wv[7] * s1[3];
            }
        }
#pragma unroll
        for (int c = 0; c < 9; ++c) sP[(ks * 9 + c) * 128 + rw] = acc[c];
        __syncthreads();
        for (int idx = tid; idx < 9 * 128; idx += 512) {
            const int c = idx >> 7, r = idx & 127;
            const float t = sP[(0 * 9 + c) * 128 + r] + sP[(1 * 9 + c) * 128 + r] + sP[(2 * 9 + c) * 128 + r] + sP[(3 * 9 + c) * 128 + r];
            biasb[((size_t)u * 9 + c) * 5632 + c0 * 128 + r] = t;
        }
    }
    __syncthreads();
}

__device__ __forceinline__ f32x4 mfma16(bf16x8 a, bf16x8 b, f32x4 c) { return __builtin_amdgcn_mfma_f32_16x16x32_bf16(a, b, c, 0, 0, 0); }

__device__ __forceinline__ void gla_unit(const Params& p, LAS unsigned char* lds, int j, int unit) {
    const int tid = otid(), wid = tid >> 6, lane = tid & 63, fr = lane & 15, fq = lane >> 4;
    int b, h, dir, Tn, row0; bool lat;
    if (unit < 64) { lat = true; b = unit >> 3; h = (unit >> 1) & 3; dir = unit & 1; Tn = 1024; row0 = T_CTX + b * 1024; }
    else { const int u2 = unit - 64; lat = false; b = u2 >> 3; h = (u2 >> 1) & 3; dir = u2 & 1; Tn = 256; row0 = b * 256; }
    const bf16_t* proj = (const bf16_t*)(p.ws + OFF_PROJ);
    float* obuf = (float*)(p.ws + (dir ? OFF_OB : OFF_OF));
    LAS bf16_t* sQ = (LAS bf16_t*)lds;
    LAS bf16_t* sK = (LAS bf16_t*)(lds + 9216);
    LAS bf16_t* sKT = (LAS bf16_t*)(lds + 18432);
    LAS bf16_t* sVT = (LAS bf16_t*)(lds + 27648);
    LAS bf16_t* sAtt = (LAS bf16_t*)(lds + 46080);
    LAS bf16_t* sST = (LAS bf16_t*)(lds + 55296);
    LAS float* sCum = (LAS float*)(lds + 73728);
    LAS float* sGl = (LAS float*)(lds + 90112);
    LAS float* sSeg = (LAS float*)(lds + 94208);
    LAS float* sLast = (LAS float*)(lds + 96256);
    const int d_ = tid & 63, seg = tid >> 6;
    float w2r[16];
    const float* w2p = pin(p, 18); const float* stp = pin(p, 6);
#pragma unroll
    for (int r = 0; r < 16; ++r) w2r[r] = w2p[(size_t)((j * 2 + dir) * 16 + r) * 256 + h * 64 + d_];
    const float bz = pin(p, 19)[(j * 2 + dir) * 256 + h * 64 + d_];
    f32x4 Sacc[4];
    const size_t sbase_in = ((((size_t)b * 2 + j) * 2 + dir) * 4 + h) * 64 * 128;
#pragma unroll
    for (int dt = 0; dt < 4; ++dt) {
#pragma unroll
        for (int reg = 0; reg < 4; ++reg) Sacc[dt][reg] = lat ? stp[sbase_in + (size_t)(dt * 16 + fq * 4 + reg) * 128 + wid * 16 + fr] : 0.f;
        u32x2 w; w.x = cvt_pk_bf16(Sacc[dt][0], Sacc[dt][1]); w.y = cvt_pk_bf16(Sacc[dt][2], Sacc[dt][3]);
        *(LAS u32x2*)(sST + (wid * 16 + fr) * 72 + dt * 16 + fq * 4) = w;
    }
    const int nch = Tn / 64;
    const int sig = tid >> 3, part = tid & 7;
    u32x4 pq, pk; bf16x8 pv0, pv1; unsigned pgl;
#define GLA_LOAD(C) do { const int tokl_ = dir ? (Tn - 1 - ((C) * 64 + sig)) : ((C) * 64 + sig); const bf16_t* pr_ = proj + (size_t)(row0 + tokl_) * PROJ_LD; \
        pq = *(const u32x4*)(pr_ + h * 64 + part * 8); pk = *(const u32x4*)(pr_ + 256 + h * 64 + part * 8); \
        pv0 = *(const bf16x8*)(pr_ + 512 + h * 128 + part * 16); pv1 = *(const bf16x8*)(pr_ + 512 + h * 128 + part * 16 + 8); \
        pgl = *(const unsigned*)(pr_ + 1536 + dir * 16 + part * 2); } while (0)
    GLA_LOAD(0);
    for (int c = 0; c < nch; ++c) {
        const u32x4 qv = pq, kv = pk; const bf16x8 v0 = pv0, v1 = pv1; const unsigned glw = pgl;
        if (c + 1 < nch) GLA_LOAD(c + 1);
        sGl[sig * 16 + part * 2] = bflo(glw); sGl[sig * 16 + part * 2 + 1] = bfhi(glw);
        __syncthreads();
        float cumv[8]; float run = 0.f;
#pragma unroll
        for (int i = 0; i < 8; ++i) {
            const int tau = seg * 8 + i; float z = bz;
#pragma unroll
            for (int r = 0; r < 16; ++r) z += sGl[tau * 16 + r] * w2r[r];
            const float la = (fminf(z, 0.f) - __logf(1.f + __expf(-fabsf(z)))) * (1.f / 16.f);
            run += la; cumv[i] = run;
        }
        sSeg[seg * 64 + d_] = run;
        __syncthreads();
        float pre = 0.f;
#pragma unroll
        for (int s = 0; s < 7; ++s) pre += (s < seg) ? sSeg[s * 64 + d_] : 0.f;
#pragma unroll
        for (int i = 0; i < 8; ++i) sCum[(seg * 8 + i) * 64 + d_] = cumv[i] + pre;
        if (seg == 7) sLast[d_] = __expf(cumv[7] + pre);
        __syncthreads();
        {
            float qf[8], kt[8], kh[8];
#pragma unroll
            for (int e2 = 0; e2 < 4; ++e2) {
                const unsigned qw = qv[e2], kw = kv[e2];
#pragma unroll
                for (int hh = 0; hh < 2; ++hh) {
                    const int e = e2 * 2 + hh, d = part * 8 + e;
                    const float cm = sCum[sig * 64 + d], lc = sCum[63 * 64 + d];
                    const float q_ = hh ? bfhi(qw) : bflo(qw), k_ = hh ? bfhi(kw) : bflo(kw);
                    qf[e] = q_ * 0.125f * __expf(cm); kt[e] = k_ * __expf(-cm); kh[e] = k_ * __expf(lc - cm);
                }
            }
            u32x4 wq, wk;
            wq.x = cvt_pk_bf16(qf[0], qf[1]); wq.y = cvt_pk_bf16(qf[2], qf[3]); wq.z = cvt_pk_bf16(qf[4], qf[5]); wq.w = cvt_pk_bf16(qf[6], qf[7]);
            wk.x = cvt_pk_bf16(kt[0], kt[1]); wk.y = cvt_pk_bf16(kt[2], kt[3]); wk.z = cvt_pk_bf16(kt[4], kt[5]); wk.w = cvt_pk_bf16(kt[6], kt[7]);
            *(LAS u32x4*)(sQ + sig * 72 + part * 8) = wq;
            *(LAS u32x4*)(sK + sig * 72 + part * 8) = wk;
#pragma unroll
            for (int e = 0; e < 8; ++e) sKT[(part * 8 + e) * 72 + (sig ^ (part << 3))] = f2bf(kh[e]);
#pragma unroll
            for (int e = 0; e < 8; ++e) { sVT[(part * 16 + e) * 72 + (sig ^ (part << 3))] = (bf16_t)v0[e]; sVT[(part * 16 + 8 + e) * 72 + (sig ^ (part << 3))] = (bf16_t)v1[e]; }
        }
        __syncthreads();
        {
            const int taut = wid >> 1;
#pragma unroll
            for (int s2 = 0; s2 < 2; ++s2) {
                const int sigt = (wid & 1) * 2 + s2;
                f32x4 a4 = (f32x4){0.f, 0.f, 0.f, 0.f};
#pragma unroll
                for (int kk = 0; kk < 2; ++kk) {
                    const bf16x8 a = *(const LAS bf16x8*)(sK + (sigt * 16 + fr) * 72 + kk * 32 + fq * 8);
                    const bf16x8 bq = *(const LAS bf16x8*)(sQ + (taut * 16 + fr) * 72 + kk * 32 + fq * 8);
                    a4 = mfma16(a, bq, a4);
                }
#pragma unroll
                for (int reg = 0; reg < 4; ++reg) a4[reg] = ((sigt * 16 + fq * 4 + reg) <= (taut * 16 + fr)) ? a4[reg] : 0.f;
                u32x2 w; w.x = cvt_pk_bf16(a4[0], a4[1]); w.y = cvt_pk_bf16(a4[2], a4[3]);
                *(LAS u32x2*)(sAtt + (taut * 16 + fr) * 72 + sigt * 16 + fq * 4) = w;
            }
        }
        __syncthreads();
#pragma unroll
        for (int taut = 0; taut < 4; ++taut) {
            f32x4 o4 = (f32x4){0.f, 0.f, 0.f, 0.f};
#pragma unroll
            for (int kk = 0; kk < 2; ++kk) {
                const bf16x8 a = *(const LAS bf16x8*)(sQ + (taut * 16 + fr) * 72 + kk * 32 + fq * 8);
                const u32x4 bbu = *(const LAS u32x4*)(sST + (wid * 16 + fr) * 72 + kk * 32 + fq * 8);
                o4 = mfma16(a, __builtin_bit_cast(bf16x8, bbu), o4);
            }
#pragma unroll
            for (int kk = 0; kk < 2; ++kk) {
                const bf16x8 a = *(const LAS bf16x8*)(sAtt + (taut * 16 + fr) * 72 + kk * 32 + fq * 8);
                const bf16x8 bb = *(const LAS bf16x8*)(sVT + (wid * 16 + fr) * 72 + (((kk * 4 + fq) ^ wid) << 3));
                o4 = mfma16(a, bb, o4);
            }
#pragma unroll
            for (int reg = 0; reg < 4; ++reg) {
                const int tau = taut * 16 + fq * 4 + reg;
                const int tk = dir ? (Tn - 1 - (c * 64 + tau)) : (c * 64 + tau);
                obuf[(size_t)(row0 + tk) * 512 + h * 128 + wid * 16 + fr] = o4[reg];
            }
        }
        __syncthreads();
#pragma unroll
        for (int dt = 0; dt < 4; ++dt) {
#pragma unroll
            for (int reg = 0; reg < 4; ++reg) Sacc[dt][reg] *= sLast[dt * 16 + fq * 4 + reg];
#pragma unroll
            for (int kk = 0; kk < 2; ++kk) {
                const bf16x8 a = *(const LAS bf16x8*)(sKT + (dt * 16 + fr) * 72 + (((kk * 4 + fq) ^ (dt * 2 + (fr >> 3))) << 3));
                const bf16x8 bb = *(const LAS bf16x8*)(sVT + (wid * 16 + fr) * 72 + (((kk * 4 + fq) ^ wid) << 3));
                Sacc[dt] = mfma16(a, bb, Sacc[dt]);
            }
            u32x2 w; w.x = cvt_pk_bf16(Sacc[dt][0], Sacc[dt][1]); w.y = cvt_pk_bf16(Sacc[dt][2], Sacc[dt][3]);
            *(LAS u32x2*)(sST + (wid * 16 + fr) * 72 + dt * 16 + fq * 4) = w;
        }
        __syncthreads();
    }
    if (!lat) {
        float* og = p.out + OUT_GLA + ((((size_t)b * 2 + j) * 2 + dir) * 4 + h) * 64 * 128;
#pragma unroll
        for (int dt = 0; dt < 4; ++dt)
#pragma unroll
            for (int reg = 0; reg < 4; ++reg) og[(size_t)(dt * 16 + fq * 4 + reg) * 128 + wid * 16 + fr] = Sacc[dt][reg];
    }
}

__device__ __forceinline__ void mla_prep_tile(const Params& p, int j, int t) {
    const int tid = otid(), wid = tid >> 6, lane = tid & 63;
    const bf16_t* proj = (const bf16_t*)(p.ws + OFF_PROJ);
    bf16_t* cqn = (bf16_t*)(p.ws + OFF_CQN); bf16_t* ckvn = (bf16_t*)(p.ws + OFF_CKVN);
    const float* qag = pin(p, 21); const float* kvag = pin(p, 23); const float* cckv = pin(p, 4);
    for (int i = 0; i < 8; ++i) {
        const int r = t * 64 + wid * 8 + i;
        if (r < T_ALL) {
            const bf16_t* pr = proj + (size_t)r * PROJ_LD;
            float cq[6]; float ss = 0.f;
#pragma unroll
            for (int k = 0; k < 3; ++k) { const unsigned w = *(const unsigned*)(pr + 1568 + k * 128 + lane * 2); cq[2 * k] = bflo(w); cq[2 * k + 1] = bfhi(w); ss += cq[2 * k] * cq[2 * k] + cq[2 * k + 1] * cq[2 * k + 1]; }
            ss = wave_sum(ss);
            const float rq = rsqrtf(ss * (1.f / 384.f) + EPS);
#pragma unroll
            for (int k = 0; k < 3; ++k) { const int col = k * 128 + lane * 2; const float g0 = qag[j * 384 + col], g1 = qag[j * 384 + col + 1];
                *(unsigned*)(cqn + (size_t)r * 384 + col) = cvt_pk_bf16(cq[2 * k] * rq * g0, cq[2 * k + 1] * rq * g1); }
            const u32x2 kw = *(const u32x2*)(pr + 1952 + lane * 4);
            float kv[4] = {bflo(kw.x), bfhi(kw.x), bflo(kw.y), bfhi(kw.y)};
            float s2 = kv[0] * kv[0] + kv[1] * kv[1] + kv[2] * kv[2] + kv[3] * kv[3];
            s2 = wave_sum(s2);
            const float rk = rsqrtf(s2 * (1.f / 256.f) + EPS);
            const f32x4 gk = *(const f32x4*)(kvag + j * 256 + lane * 4);
            f32x4 y;
#pragma unroll
            for (int e = 0; e < 4; ++e) y[e] = kv[e] * rk * gk[e];
            u32x2 w; w.x = cvt_pk_bf16(y[0], y[1]); w.y = cvt_pk_bf16(y[2], y[3]);
            *(u32x2*)(ckvn + (size_t)r * 256 + lane * 4) = w;
            if (r < T_CTX) {
                const int bb = r >> 8, tt = r & 255;
                *(f32x4*)(p.out + OUT_CKV + (((size_t)bb * 2 + j) * 256 + tt) * 256 + lane * 4) = y;
                if (lane < 32) p.out[OUT_KROPE + (((size_t)bb * 2 + j) * 256 + tt) * 32 + lane] = bf2f(pr[2208 + lane]);
            }
        } else {
            const int rc = r - T_ALL, bb = rc >> 8, m = rc & 255;
            const f32x4 v = *(const f32x4*)(cckv + (((size_t)bb * 2 + j) * 256 + m) * 256 + lane * 4);
            u32x2 w; w.x = cvt_pk_bf16(v[0], v[1]); w.y = cvt_pk_bf16(v[2], v[3]);
            *(u32x2*)(ckvn + (size_t)r * 256 + lane * 4) = w;
        }
    }
}

__device__ __forceinline__ void even2_phase(const Params& p, LAS unsigned char* lds, int j) {
    const int bid = obid(), G = ogrid();
    if (G >= 128) {
        if (bid < 64) { gla_unit(p, lds, j, bid); __syncthreads(); }
        else { for (int it = 64 + (bid - 64); it < 608; it += (G - 64)) { if (it < 320) { gla_unit(p, lds, j, it); __syncthreads(); } else mla_prep_tile(p, j, it - 320); } }
    } else {
        for (int it = bid; it < 608; it += G) { if (it < 320) { gla_unit(p, lds, j, it); __syncthreads(); } else mla_prep_tile(p, j, it - 320); }
    }
}


__device__ __forceinline__ float rope_inv(int i) { return __builtin_amdgcn_exp2f(-(float)(i & 7) * 1.6609640474f); }


__device__ __forceinline__ void kprep_tile(const Params& p, LAS unsigned char* lds, int j, int tile) {
    const int tid = otid();
    const int rt = tile >> 3, h = tile & 7, row0 = rt * 64;
    const bf16_t* proj = (const bf16_t*)(p.ws + OFF_PROJ); const bf16_t* kvraw = (const bf16_t*)(p.ws + OFF_KVRAW);
    bf16_t* KN = (bf16_t*)(p.ws + OFF_KN); bf16_t* VT = (bf16_t*)(p.ws + OFF_VT);
    LAS bf16_t* sVT = (LAS bf16_t*)lds;
    const float* kg = pin(p, 26) + j * 96; const float* ckr = pin(p, 5);
    const int key = tid >> 3, part = tid & 7, row = row0 + key;
    float kr[4]; bool rope = false; int pos = 0;
    if (row < T_ALL) { const u32x2 w = *(const u32x2*)(proj + (size_t)row * PROJ_LD + 2208 + part * 4); kr[0] = bflo(w.x); kr[1] = bfhi(w.x); kr[2] = bflo(w.y); kr[3] = bfhi(w.y);
        if (row >= T_CTX) { rope = true; pos = (row - T_CTX) & 1023; } }
    else { const int rc = row - T_ALL, bb = rc >> 8, m = rc & 255; const f32x4 w = *(const f32x4*)(ckr + (((size_t)bb * 2 + j) * 256 + m) * 32 + part * 4); kr[0] = w[0]; kr[1] = w[1]; kr[2] = w[2]; kr[3] = w[3]; }
    const bf16_t* kp = kvraw + (size_t)row * 1024 + h * 128;
    const u32x4 kn = *(const u32x4*)(kp + part * 8); const bf16x8 vv = *(const bf16x8*)(kp + 64 + part * 8);
    float kf[8];
#pragma unroll
    for (int e = 0; e < 4; ++e) { kf[2 * e] = bflo(kn[e]); kf[2 * e + 1] = bfhi(kn[e]); }
    float ss = kr[0] * kr[0] + kr[1] * kr[1] + kr[2] * kr[2] + kr[3] * kr[3];
#pragma unroll
    for (int e = 0; e < 8; ++e) ss += kf[e] * kf[e];
    ss += __shfl_xor(ss, 1); ss += __shfl_xor(ss, 2); ss += __shfl_xor(ss, 4);
    const float rstd = rsqrtf(ss * (1.f / 96.f) + EPS);
#pragma unroll
    for (int e = 0; e < 8; ++e) kf[e] *= rstd * kg[part * 8 + e];
#pragma unroll
    for (int e = 0; e < 4; ++e) kr[e] *= rstd * kg[64 + part * 4 + e];
    if (rope) {
        const float prow = (float)(pos >> 6), pcol = (float)(pos & 63);
#pragma unroll
        for (int pr = 0; pr < 2; ++pr) {
            const int i = part * 2 + pr;
            const float ang = (i < 8 ? prow : pcol) * rope_inv(i);
            const float rev = ang * 0.15915494309f;
            const float cs = __builtin_amdgcn_cosf(rev), sn = __builtin_amdgcn_sinf(rev);
            const float x1 = kr[2 * pr], x2 = kr[2 * pr + 1];
            kr[2 * pr] = x1 * cs - x2 * sn; kr[2 * pr + 1] = x1 * sn + x2 * cs;
        }
    }
    bf16_t* kd = KN + ((size_t)row * 8 + h) * 96;
    u32x4 w; w.x = cvt_pk_bf16(kf[0], kf[1]); w.y = cvt_pk_bf16(kf[2], kf[3]); w.z = cvt_pk_bf16(kf[4], kf[5]); w.w = cvt_pk_bf16(kf[6], kf[7]);
    *(u32x4*)(kd + part * 8) = w;
    u32x2 w2; w2.x = cvt_pk_bf16(kr[0], kr[1]); w2.y = cvt_pk_bf16(kr[2], kr[3]);
    *(u32x2*)(kd + 64 + part * 4) = w2;
#pragma unroll
    for (int e = 0; e < 8; ++e) sVT[(part * 8 + e) * 72 + key] = (bf16_t)vv[e];
    __syncthreads();
    {
        size_t base; int nk, k0;
        if (row0 < T_CTX) { base = (size_t)((row0 >> 8) * 8 + h) * 64 * 256; nk = 256; k0 = row0 & 255; }
        else if (row0 < T_ALL) { base = VT_LAT + (size_t)(((row0 - T_CTX) >> 10) * 8 + h) * 64 * 1280; nk = 1280; k0 = 256 + ((row0 - T_CTX) & 1023); }
        else { base = VT_LAT + (size_t)(((row0 - T_ALL) >> 8) * 8 + h) * 64 * 1280; nk = 1280; k0 = (row0 - T_ALL) & 255; }
        const int dv = tid >> 3, c8 = tid & 7;
        *(u32x4*)(VT + base + (size_t)dv * nk + k0 + c8 * 8) = *(const LAS u32x4*)(sVT + dv * 72 + c8 * 8);
    }
    __syncthreads();
}

__device__ __forceinline__ void attn_tile(const Params& p, LAS unsigned char* lds, int j, int tile) {
    const int tid = otid(), wid = tid >> 6, lane = tid & 63, fr = lane & 15, fq = lane >> 4;
    bool lat; int b, h, qp_, nkb, qrow0;
    if (tile < 256) { lat = true; b = tile >> 5; h = (tile >> 2) & 7; qp_ = tile & 3; nkb = 20; qrow0 = T_CTX + b * 1024 + qp_ * 256; }
    else { const int t2 = tile - 256; lat = false; b = t2 >> 3; h = t2 & 7; qp_ = 0; nkb = 4; qrow0 = b * 256; }
    const bf16_t* qraw = (const bf16_t*)(p.ws + OFF_QRAW);
    bf16_t* cat = (bf16_t*)(p.ws + OFF_CAT);
    LAS bf16_t* sQ = (LAS bf16_t*)lds;
    LAS bf16_t* sK = (LAS bf16_t*)(lds + 53248);
    LAS bf16_t* sVT = (LAS bf16_t*)(lds + 66560);
    const float* g = pin(p, 25) + j * 96;
#pragma unroll 1
    for (int r = 0; r < 2; ++r) {
        const int q = (tid >> 2) + 128 * r, part = tid & 3;
        const bf16_t* qp = qraw + (size_t)(qrow0 + q) * 768 + h * 96;
        const u32x4 n0 = *(const u32x4*)(qp + part * 16), n1 = *(const u32x4*)(qp + part * 16 + 8), rp = *(const u32x4*)(qp + 64 + part * 8);
        float f[24];
#pragma unroll
        for (int e = 0; e < 4; ++e) { f[2 * e] = bflo(n0[e]); f[2 * e + 1] = bfhi(n0[e]); f[8 + 2 * e] = bflo(n1[e]); f[8 + 2 * e + 1] = bfhi(n1[e]); f[16 + 2 * e] = bflo(rp[e]); f[16 + 2 * e + 1] = bfhi(rp[e]); }
        float ss = 0.f;
#pragma unroll
        for (int e = 0; e < 24; ++e) ss += f[e] * f[e];
        ss += __shfl_xor(ss, 1); ss += __shfl_xor(ss, 2);
        const float rstd = rsqrtf(ss * (1.f / 96.f) + EPS);
#pragma unroll
        for (int e = 0; e < 16; ++e) f[e] *= rstd * g[part * 16 + e];
#pragma unroll
        for (int e = 0; e < 8; ++e) f[16 + e] *= rstd * g[64 + part * 8 + e];
        if (lat) {
            const int pos = qp_ * 256 + q; const float prow = (float)(pos >> 6), pcol = (float)(pos & 63);
#pragma unroll
            for (int pr = 0; pr < 4; ++pr) {
                const int i = part * 4 + pr;
                const float ang = (i < 8 ? prow : pcol) * rope_inv(i);
                const float rev = ang * 0.15915494309f;
                const float cs = __builtin_amdgcn_cosf(rev), sn = __builtin_amdgcn_sinf(rev);
                const float x1 = f[16 + 2 * pr], x2 = f[16 + 2 * pr + 1];
                f[16 + 2 * pr] = x1 * cs - x2 * sn; f[16 + 2 * pr + 1] = x1 * sn + x2 * cs;
            }
        }
        const float sc = 0.10206207262f * 1.44269504089f;
        u32x4 w0, w1, w2;
#pragma unroll
        for (int e = 0; e < 4; ++e) { w0[e] = cvt_pk_bf16(f[2 * e] * sc, f[2 * e + 1] * sc); w1[e] = cvt_pk_bf16(f[8 + 2 * e] * sc, f[8 + 2 * e + 1] * sc); w2[e] = cvt_pk_bf16(f[16 + 2 * e] * sc, f[16 + 2 * e + 1] * sc); }
        *(LAS u32x4*)(sQ + q * 104 + part * 16) = w0; *(LAS u32x4*)(sQ + q * 104 + part * 16 + 8) = w1; *(LAS u32x4*)(sQ + q * 104 + 64 + part * 8) = w2;
    }
    __syncthreads();
    bf16x8 bQ[2][3];
#pragma unroll
    for (int gq = 0; gq < 2; ++gq)
#pragma unroll
        for (int kk = 0; kk < 3; ++kk) bQ[gq][kk] = *(const LAS bf16x8*)(sQ + (wid * 32 + gq * 16 + fr) * 104 + kk * 32 + fq * 8);
    float m_run[2] = {-1e30f, -1e30f}, l_run[2] = {0.f, 0.f};
    f32x4 oacc[2][4];
#pragma unroll
    for (int gq = 0; gq < 2; ++gq)
#pragma unroll
        for (int dt = 0; dt < 4; ++dt) oacc[gq][dt] = (f32x4){0.f, 0.f, 0.f, 0.f};
    const bf16_t* KN = (const bf16_t*)(p.ws + OFF_KN);
    const bf16_t* VTg = (const bf16_t*)(p.ws + OFF_VT) + (lat ? VT_LAT + (size_t)(b * 8 + h) * 64 * 1280 : (size_t)(b * 8 + h) * 64 * 256);
    const int NK = lat ? 1280 : 256;
    u32x4 pf_k0, pf_k1, pf_v;
    const int kc0 = tid, kc1 = tid + 512;
    const int key0_ = kc0 / 12, pc0_ = kc0 % 12, key1_ = kc1 / 12, pc1_ = kc1 % 12;
#define ATT_ROW(KB, KEY) (!lat ? (b * 256 + (KB) * 64 + (KEY)) : ((KB) < 4 ? (T_ALL + b * 256 + (KB) * 64 + (KEY)) : (T_CTX + b * 1024 + ((KB) - 4) * 64 + (KEY))))
#define ATT_LOAD(KB) do { \
        pf_k0 = *(const u32x4*)(KN + ((size_t)ATT_ROW(KB, key0_) * 8 + h) * 96 + pc0_ * 8); \
        if (tid < 256) pf_k1 = *(const u32x4*)(KN + ((size_t)ATT_ROW(KB, key1_) * 8 + h) * 96 + pc1_ * 8); \
        pf_v = *(const u32x4*)(VTg + (size_t)(tid >> 3) * NK + (KB) * 64 + (tid & 7) * 8); } while (0)
    pf_k1 = (u32x4){0u, 0u, 0u, 0u};
    ATT_LOAD(0);
    for (int kb = 0; kb < nkb; ++kb) {
        *(LAS u32x4*)(sK + key0_ * 104 + pc0_ * 8) = pf_k0;
        if (tid < 256) *(LAS u32x4*)(sK + key1_ * 104 + pc1_ * 8) = pf_k1;
        *(LAS u32x4*)(sVT + (tid >> 3) * 72 + (tid & 7) * 8) = pf_v;
        __syncthreads();
        if (kb + 1 < nkb) ATT_LOAD(kb + 1);
        {
            f32x4 s[2][4];
#pragma unroll
            for (int g4 = 0; g4 < 4; ++g4) {
                s[0][g4] = (f32x4){0.f, 0.f, 0.f, 0.f}; s[1][g4] = s[0][g4];
#pragma unroll
                for (int kk = 0; kk < 3; ++kk) {
                    const bf16x8 a = *(const LAS bf16x8*)(sK + (g4 * 16 + fr) * 104 + kk * 32 + fq * 8);
                    s[0][g4] = mfma16(a, bQ[0][kk], s[0][g4]); s[1][g4] = mfma16(a, bQ[1][kk], s[1][g4]);
                }
            }
#pragma unroll
            for (int gq = 0; gq < 2; ++gq) {
                float mx = s[gq][0][0];
#pragma unroll
                for (int g4 = 0; g4 < 4; ++g4)
#pragma unroll
                    for (int reg = 0; reg < 4; ++reg) mx = fmaxf(mx, s[gq][g4][reg]);
                mx = fmaxf(mx, __shfl_xor(mx, 16)); mx = fmaxf(mx, __shfl_xor(mx, 32));
                const float m_new = fmaxf(m_run[gq], mx);
                const float alpha = __builtin_amdgcn_exp2f(m_run[gq] - m_new);
                m_run[gq] = m_new;
                float ls = 0.f;
#pragma unroll
                for (int g4 = 0; g4 < 4; ++g4)
#pragma unroll
                    for (int reg = 0; reg < 4; ++reg) { s[gq][g4][reg] = __builtin_amdgcn_exp2f(s[gq][g4][reg] - m_new); ls += s[gq][g4][reg]; }
                l_run[gq] = l_run[gq] * alpha + ls;
#pragma unroll
                for (int dt = 0; dt < 4; ++dt) oacc[gq][dt] *= alpha;
            }
#pragma unroll
            for (int ks = 0; ks < 2; ++ks) {
                bf16x8 bP[2];
#pragma unroll
                for (int gq = 0; gq < 2; ++gq) {
                    u32x4 pw; pw.x = cvt_pk_bf16(s[gq][2 * ks][0], s[gq][2 * ks][1]); pw.y = cvt_pk_bf16(s[gq][2 * ks][2], s[gq][2 * ks][3]); pw.z = cvt_pk_bf16(s[gq][2 * ks + 1][0], s[gq][2 * ks + 1][1]); pw.w = cvt_pk_bf16(s[gq][2 * ks + 1][2], s[gq][2 * ks + 1][3]);
                    bP[gq] = __builtin_bit_cast(bf16x8, pw);
                }
#pragma unroll
                for (int dt = 0; dt < 4; ++dt) {
                    const u32x2 lo = *(const LAS u32x2*)(sVT + (dt * 16 + fr) * 72 + ks * 32 + fq * 4);
                    const u32x2 hi = *(const LAS u32x2*)(sVT + (dt * 16 + fr) * 72 + ks * 32 + 16 + fq * 4);
                    u32x4 av; av.x = lo.x; av.y = lo.y; av.z = hi.x; av.w = hi.y;
                    const bf16x8 aV = __builtin_bit_cast(bf16x8, av);
                    oacc[0][dt] = mfma16(aV, bP[0], oacc[0][dt]); oacc[1][dt] = mfma16(aV, bP[1], oacc[1][dt]);
                }
            }
        }
        __syncthreads();
    }
#undef ATT_LOAD
#undef ATT_ROW
#pragma unroll
    for (int gq = 0; gq < 2; ++gq) {
        float l = l_run[gq];
        l += __shfl_xor(l, 16); l += __shfl_xor(l, 32);
        const float inv = 1.f / l;
        bf16_t* op = cat + (size_t)(qrow0 + wid * 32 + gq * 16 + fr) * 1024 + 512 + h * 64;
#pragma unroll
        for (int dt = 0; dt < 4; ++dt) { u32x2 w; w.x = cvt_pk_bf16(oacc[gq][dt][0] * inv, oacc[gq][dt][1] * inv); w.y = cvt_pk_bf16(oacc[gq][dt][2] * inv, oacc[gq][dt][3] * inv); *(u32x2*)(op + dt * 16 + fq * 4) = w; }
    }
}

__device__ __forceinline__ void gla_finish_rows(const Params& p, int j) {
    const int tid = otid(), wid = tid >> 6, lane = tid & 63;
    const float* of = (const float*)(p.ws + OFF_OF); const float* ob = (const float*)(p.ws + OFF_OB);
    const bf16_t* proj = (const bf16_t*)(p.ws + OFF_PROJ); bf16_t* cat = (bf16_t*)(p.ws + OFF_CAT);
    const int e0 = (lane & 15) * 8;
    const float* glag = pin(p, 20);
    const f32x4 g0 = *(const f32x4*)(glag + j * 128 + e0), g1 = *(const f32x4*)(glag + j * 128 + e0 + 4);
    for (int row = obid() * 8 + wid; row < T_ALL; row += ogrid() * 16) {
        f32x4 xa[2][2], xb[2][2]; u32x4 ogw[2];
#pragma unroll
        for (int r = 0; r < 2; ++r) {
            const int rw = min(row + r * ogrid() * 8, T_ALL - 1);
            const float* a = of + (size_t)rw * 512 + lane * 8; const float* bb = ob + (size_t)rw * 512 + lane * 8;
            xa[r][0] = *(const f32x4*)a; xa[r][1] = *(const f32x4*)(a + 4); xb[r][0] = *(const f32x4*)bb; xb[r][1] = *(const f32x4*)(bb + 4);
            ogw[r] = *(const u32x4*)(proj + (size_t)rw * PROJ_LD + 1024 + lane * 8);
        }
#pragma unroll
        for (int r = 0; r < 2; ++r) {
            const int rw = min(row + r * ogrid() * 8, T_ALL - 1);
            const f32x4 x0 = xa[r][0] + xb[r][0], x1 = xa[r][1] + xb[r][1];
            float ss = x0[0] * x0[0] + x0[1] * x0[1] + x0[2] * x0[2] + x0[3] * x0[3] + x1[0] * x1[0] + x1[1] * x1[1] + x1[2] * x1[2] + x1[3] * x1[3];
            ss += __shfl_xor(ss, 1); ss += __shfl_xor(ss, 2); ss += __shfl_xor(ss, 4); ss += __shfl_xor(ss, 8);
            const float rstd = rsqrtf(ss * (1.f / 128.f) + EPS);
            float y[8];
#pragma unroll
            for (int e = 0; e < 4; ++e) { y[e] = x0[e] * rstd * g0[e]; y[4 + e] = x1[e] * rstd * g1[e]; }
#pragma unroll
            for (int e = 0; e < 4; ++e) { y[2 * e] *= silu_f(bflo(ogw[r][e])); y[2 * e + 1] *= silu_f(bfhi(ogw[r][e])); }
            u32x4 w; w.x = cvt_pk_bf16(y[0], y[1]); w.y = cvt_pk_bf16(y[2], y[3]); w.z = cvt_pk_bf16(y[4], y[5]); w.w = cvt_pk_bf16(y[6], y[7]);
            *(u32x4*)(cat + (size_t)rw * 1024 + lane * 8) = w;
        }
    }
}

__device__ __forceinline__ void spatial_tile(const Params& p, LAS unsigned char* lds, int j, int tile) {
    const int tid = otid(), wid = tid >> 6, lane = tid & 63, fr = lane & 15, fq = lane >> 4;
    const int chunk = tile >> 4, slab = tile & 15, g = slab >> 2;
    const bf16_t* uv = (const bf16_t*)(p.ws + OFF_UV); bf16_t* gated = (bf16_t*)(p.ws + OFF_GATED);
    const float* ssp = (const float*)(p.ws + OFF_SSP);
    const bf16_t* Ws = (const bf16_t*)(p.ws + OFF_WS) + (size_t)(j * 4 + g) * 128 * 128;
    LAS bf16_t* sW = (LAS bf16_t*)lds;
    LAS bf16_t* sVT = (LAS bf16_t*)(lds + 34816);
    LAS float* sR = (LAS float*)(lds + 69632);
    if (tid < 128) { const float* s = ssp + (size_t)(chunk * 128 + tid) * 32; float a = 0.f;
#pragma unroll
        for (int i = 0; i < 32; i += 4) { const f32x4 v = *(const f32x4*)(s + i); a += v[0] + v[1] + v[2] + v[3]; }
        sR[tid] = rsqrtf(a * (1.f / 2048.f) + EPS); }
#pragma unroll
    for (int i = 0; i < 4; ++i) { const int idx = tid + 512 * i, row = idx >> 4, c8 = idx & 15; *(LAS u32x4*)(sW + row * 136 + c8 * 8) = *(const u32x4*)(Ws + row * 128 + c8 * 8); }
    __syncthreads();
    const float* vgp = pin(p, 28);
#pragma unroll
    for (int i = 0; i < 4; ++i) {
        const int idx = tid + 512 * i, q = idx >> 4, c8 = idx & 15;
        const u32x4 vv = *(const u32x4*)(uv + (size_t)(chunk * 128 + q) * 4096 + 2048 + slab * 128 + c8 * 8);
        const float rs = sR[q]; const float* vg = vgp + j * 2048 + slab * 128 + c8 * 8;
#pragma unroll
        for (int e = 0; e < 4; ++e) {
            sVT[(c8 * 8 + 2 * e) * 136 + (q ^ (c8 << 3))] = f2bf(bflo(vv[e]) * rs * vg[2 * e]);
            sVT[(c8 * 8 + 2 * e + 1) * 136 + (q ^ (c8 << 3))] = f2bf(bfhi(vv[e]) * rs * vg[2 * e + 1]);
        }
    }
    __syncthreads();
    bf16x8 aV[4];
#pragma unroll
    for (int kk = 0; kk < 4; ++kk) aV[kk] = *(const LAS bf16x8*)(sVT + (wid * 16 + fr) * 136 + (((kk * 4 + fq) ^ (wid * 2 + (fr >> 3))) << 3));
    const float* bs = pin(p, 30) + (size_t)(j * 4 + g) * 128;
#pragma unroll
    for (int pt = 0; pt < 8; ++pt) {
        f32x4 acc = (f32x4){0.f, 0.f, 0.f, 0.f};
#pragma unroll
        for (int kk = 0; kk < 4; ++kk) { const bf16x8 bw = *(const LAS bf16x8*)(sW + (pt * 16 + fr) * 136 + kk * 32 + fq * 8); acc = mfma16(aV[kk], bw, acc); }
        const int prow = pt * 16 + fr; const float bias = bs[prow];
        const size_t row = (size_t)chunk * 128 + prow; const int col = slab * 128 + wid * 16 + fq * 4;
        const u32x2 uw = *(const u32x2*)(uv + row * 4096 + col);
        u32x2 w; w.x = cvt_pk_bf16(bflo(uw.x) * (acc[0] + bias), bfhi(uw.x) * (acc[1] + bias)); w.y = cvt_pk_bf16(bflo(uw.y) * (acc[2] + bias), bfhi(uw.y) * (acc[3] + bias));
        *(u32x2*)(gated + row * 2048 + col) = w;
    }
    __syncthreads();
}

#define XB_TMO      128
#define XB_XCNT(j)  (256  + 64 * (j))
#define XB_XSUB(j)  (1280 + 64 * (j))
#define XB_XGEN(j)  (2304 + 64 * (j))
#define XB_TOP      3328
#define XB_TOPGEN   3392
#define XCD_BAR_WORDS 3456
#define XB_SPIN_CAP (1u << 18)

__device__ __forceinline__ unsigned xb_ld(unsigned* p)              { return __hip_atomic_load(p, __ATOMIC_RELAXED, __HIP_MEMORY_SCOPE_AGENT); }
__device__ __forceinline__ unsigned xb_add(unsigned* p, unsigned v) { return __hip_atomic_fetch_add(p, v, __ATOMIC_RELAXED, __HIP_MEMORY_SCOPE_AGENT); }
__device__ __forceinline__ unsigned xb_xcc_id() { return (unsigned)__builtin_amdgcn_s_getreg((3 << 11) | 20) & 0xFu; }
#define XB_SPIN(cond, bar) do { unsigned _sp = 0; while (cond) { __builtin_amdgcn_s_sleep(1); \
    if ((++_sp & 255u) == 0u) { if (xb_ld(&(bar)[XB_TMO])) break; if (_sp > XB_SPIN_CAP) { atomicAdd(&(bar)[XB_TMO], 1u); break; } } } } while (0)

struct XcdBarrier {
    unsigned* bar; unsigned x;
    volatile LAS unsigned* st;
};

__device__ __forceinline__ XcdBarrier xcd_barrier_post(unsigned* bar, volatile LAS unsigned* st) {
    XcdBarrier b; b.bar = bar; b.x = xb_xcc_id(); b.st = st;
    if (threadIdx.x == 0) (void)xb_add(&bar[XB_XCNT(b.x)], 1u);
    return b;
}
__device__ __forceinline__ void xcd_barrier_complete(unsigned* bar, unsigned x, unsigned& nloc, unsigned& nx) {
    const unsigned G = gridDim.x * gridDim.y * gridDim.z;
    unsigned sum, cnt, mine, sp = 0u;
    for (;;) {
        sum = 0u; cnt = 0u; mine = 0u;
#pragma unroll
        for (unsigned j = 0; j < 16; ++j) { const unsigned c = xb_ld(&bar[XB_XCNT(j)]); sum += c; cnt += (c > 0u) ? 1u : 0u; mine = (j == x) ? c : mine; }
        if (sum == G) break;
        __builtin_amdgcn_s_sleep(1);
        if ((++sp & 255u) == 0u) { if (xb_ld(&bar[XB_TMO])) break; if (sp > XB_SPIN_CAP) { atomicAdd(&bar[XB_TMO], 1u); break; } }
    }
    nloc = mine > 0u ? mine : 1u; nx = cnt > 0u ? cnt : 1u;
}

__device__ __forceinline__ void xcd_barrier(const XcdBarrier& b) {
    asm volatile("s_waitcnt vmcnt(0)" ::: "memory");
    __syncthreads();
    if (threadIdx.x == 0) {
        unsigned* bar = b.bar;
        __builtin_amdgcn_s_waitcnt(0);
        unsigned nloc = b.st[0], nx = b.st[1];
        if (nloc == 0u) { xcd_barrier_complete(bar, b.x, nloc, nx); b.st[0] = nloc; b.st[1] = nx; }
        const unsigned old = xb_add(&bar[XB_XSUB(b.x)], 1u);
        const unsigned gen = old / nloc;
        if (old + 1u == (gen + 1u) * nloc) {
            __builtin_amdgcn_fence(__ATOMIC_RELEASE, "agent");
            asm volatile("s_waitcnt vmcnt(0)" ::: "memory");
            const unsigned og = xb_add(&bar[XB_TOP], 1u);
            const unsigned tg = og / nx;
            if (og + 1u == (tg + 1u) * nx) xb_add(&bar[XB_TOPGEN], 1u);
            else XB_SPIN(xb_ld(&bar[XB_TOPGEN]) == tg, bar);
            __builtin_amdgcn_fence(__ATOMIC_ACQUIRE, "agent");
            xb_add(&bar[XB_XGEN(b.x)], 1u);
            asm volatile("s_waitcnt vmcnt(0)" ::: "memory");
        } else {
            XB_SPIN(xb_ld(&bar[XB_XGEN(b.x)]) == gen, bar);
            __builtin_amdgcn_fence(__ATOMIC_ACQUIRE, "agent");
            asm volatile("s_waitcnt vmcnt(0)" ::: "memory");
        }
    }
    __syncthreads();
}

constexpr size_t OFF_BAR = (size_t)520 << 20;

constexpr int STEPS = 13, NPH = 1 + 4 * STEPS;

__global__ void __launch_bounds__(512, 2) mega(Params p) {
    extern __shared__ __attribute__((aligned(16))) unsigned char shm[];
    LAS unsigned char* lds = (LAS unsigned char*)shm;
    cg::grid_group grid = cg::this_grid();
    __shared__ uint4 xb_words;
    if (threadIdx.x == 0) xb_words = make_uint4(0u, 0u, 0u, 0u);
    __syncthreads();
    if (p.ph_end - p.ph_begin > 1) (void)xcd_barrier_post((unsigned*)(p.ws + OFF_BAR), (volatile LAS unsigned*)&xb_words);
    bf16_t* hbuf = (bf16_t*)(p.ws + OFF_H);
    float* mod = (float*)(p.ws + OFF_MOD);
    bool first = true;
    for (int ph = p.ph_begin; ph < p.ph_end; ++ph) {
        int l = 0, s = -1;
        if (ph > 0) { l = (ph - 1) / STEPS; s = (ph - 1) % STEPS; }
        const bool odd = (l & 1) != 0; const int j = l >> 1;
        if (odd && (s == 7 || s == 8 || s == 9)) continue;
        if (s == 3 || s == 7 || s == 10 || (s == 0 && l > 0)) continue;
        if (!first) { if (p.ph_begin < 0) grid.sync(); else { XcdBarrier xb; xb.bar = (unsigned*)(p.ws + OFF_BAR); xb.x = xb_xcc_id(); xb.st = (volatile LAS unsigned*)&xb_words; xcd_barrier(xb); } }
        first = false;
        const int bid = obid(), G = ogrid();
        if (ph == 0) { prologue_phase(p, lds); continue; }
        switch (s) {
            case 0: prologue_b(p, lds); break;
            case 1: {
                pg8::Gemm g{hbuf, (const bf16_t*)(p.ws + OFF_WGU1) + (size_t)l * 5632 * 1024, T_ALL, 5632, 1024};
                pg8::StaticOrder S; S.init(g.M, g.N, G, bid);
                EpiSwiGLU E{(bf16_t*)(p.ws + OFF_ACT), (const float*)(p.ws + OFF_RSP), (const float*)(p.ws + OFF_BIAS) + (size_t)(l * 3 + 0) * 9 * 5632};
                pg8::gemm_phase(lds, g, S, E);
            } break;
            case 11: {
                pg8::Gemm g{hbuf, (const bf16_t*)(p.ws + OFF_WGU2) + (size_t)l * 5632 * 1024, T_ALL, 5632, 1024};
                pg8::StaticOrder S; S.init(g.M, g.N, G, bid);
                EpiSwiGLU E{(bf16_t*)(p.ws + OFF_ACT), (const float*)(p.ws + OFF_RSP), (const float*)(p.ws + OFF_BIAS) + (size_t)(l * 3 + 2) * 9 * 5632};
                pg8::gemm_phase(lds, g, S, E);
            } break;
            case 2: {
                pg8::Gemm g{(const bf16_t*)(p.ws + OFF_ACT), (const bf16_t*)(p.ws + OFF_WD1) + (size_t)l * 1024 * 2816, T_ALL, 1024, 2816};
                EpiResid E{p, l, 2};
                pg8::StaticOrder S; S.init(g.M, g.N, G, bid);
                pg8::gemm_phase(lds, g, S, E);
            } break;
            case 12: {
                pg8::Gemm g{(const bf16_t*)(p.ws + OFF_ACT), (const bf16_t*)(p.ws + OFF_WD2) + (size_t)l * 1024 * 2816, T_ALL, 1024, 2816};
                EpiResid E{p, l, 11};
                pg8::StaticOrder S; S.init(g.M, g.N, G, bid);
                pg8::gemm_phase(lds, g, S, E);
            } break;
            case 6: {
                if (!odd) {
                    const int nl = (G >= 128) ? 64 : 0, Gg = G - nl, cg = bid - nl;
                    {
                        int it0 = bid, itstep = Gg, itend = 320;
                        if (cg < 0) { itend = 64; itstep = 1 << 20; }
                        for (int it = it0; it < itend; it += itstep) { gla_unit(p, lds, j, it); __syncthreads(); }
                    }
                    if (cg >= 0) {
                        pg8::Gemm g{(const bf16_t*)(p.ws + OFF_CQN), (const bf16_t*)(p.ws + OFF_WQB) + (size_t)j * 768 * 384, T_ALL, 768, 384};
                        EpiBf16 E{(bf16_t*)(p.ws + OFF_QRAW), 768, nullptr, nullptr};
                        pg8::StaticOrder S; S.init(g.M, g.N, Gg, cg);
                        pg8::gemm_phase(lds, g, S, E);
                    }
                    if (cg >= 0) {
                        pg8::Gemm g{(const bf16_t*)(p.ws + OFF_CKVN), (const bf16_t*)(p.ws + OFF_WKVB) + (size_t)j * 1024 * 256, T_KV, 1024, 256};
                        EpiBf16 E{(bf16_t*)(p.ws + OFF_KVRAW), 1024, nullptr, nullptr};
                        pg8::StaticOrder S; S.init(g.M, g.N, Gg, (cg + Gg / 2) % Gg);
                        pg8::gemm_phase(lds, g, S, E);
                    }
                    if (cg >= 0) {
                        pg8::StaticOrder S; S.init(T_KV, 1024, Gg, (cg + Gg / 2) % Gg);
#pragma unroll 1
                        for (int k = 0; ; ++k) {
                            Unit uu; if (!S.next(k >> 3, uu)) break;
                            const int q = k & 7;
                            kprep_tile(p, lds, j, __builtin_amdgcn_readfirstlane(((uu.pm * 4 + (q >> 1)) << 3) | (uu.pn * 2 + (q & 1))));
                        }
                    }
                } else {
                    pg8::Gemm g{(const bf16_t*)(p.ws + OFF_GATED), (const bf16_t*)(p.ws + OFF_WOUTO) + (size_t)j * 1024 * 2048, T_ALL, 1024, 2048};
                    EpiResid E{p, l, 6};
                    pg8::StaticOrder S; S.init(g.M, g.N, G, bid);
                    pg8::gemm_phase(lds, g, S, E);
                }
            } break;
            case 9: {
                pg8::Gemm g{(const bf16_t*)(p.ws + OFF_CAT), (const bf16_t*)(p.ws + OFF_WOUTE) + (size_t)j * 1024 * 1024, T_ALL, 1024, 1024};
                EpiResid E{p, l, 8};
                pg8::StaticOrder S; S.init(g.M, g.N, G, bid);
                pg8::gemm_phase(lds, g, S, E);
            } break;
            case 4: {
                if (!odd) {
                    pg8::Gemm g{hbuf, (const bf16_t*)(p.ws + OFF_WINE) + (size_t)j * 2304 * 1024, T_ALL, 2304, 1024};
                    pg8::StaticOrder S; S.init(g.M, g.N, G, bid);
                    EpiBf16 E{(bf16_t*)(p.ws + OFF_PROJ), PROJ_LD, (const float*)(p.ws + OFF_RSP), (const float*)(p.ws + OFF_BIAS) + (size_t)(l * 3 + 1) * 9 * 5632};
                    pg8::gemm_phase(lds, g, S, E);
                } else {
                    pg8::Gemm g{hbuf, (const bf16_t*)(p.ws + OFF_WINO) + (size_t)j * 4096 * 1024, T_ALL, 4096, 1024};
                    pg8::StaticOrder S; S.init(g.M, g.N, G, bid);
                    EpiGeluUV E{(bf16_t*)(p.ws + OFF_UV), (float*)(p.ws + OFF_SSP), (const float*)(p.ws + OFF_RSP), (const float*)(p.ws + OFF_BIAS) + (size_t)(l * 3 + 1) * 9 * 5632};
                    pg8::gemm_phase(lds, g, S, E);
                }
            } break;
            case 5: {
                if (!odd) { for (int t = bid; t < 288; t += G) mla_prep_tile(p, j, t); }
                else for (int t = bid; t < 2048; t += G) spatial_tile(p, lds, j, t);
            } break;
            case 7: {
                for (int t = bid; t < 2304; t += G) kprep_tile(p, lds, j, t);
            } break;
            case 8: {
                if (G == 256) {
                    const int xcd = bid & 7, slot = bid >> 3;
                    attn_tile(p, lds, j, (xcd * 8 + (slot >> 2)) * 4 + (slot & 3)); __syncthreads();
                    attn_tile(p, lds, j, 256 + xcd * 32 + slot); __syncthreads();
                } else {
                    for (int t = bid; t < 512; t += G) { attn_tile(p, lds, j, t); __syncthreads(); }
                }
                gla_finish_rows(p, j);
            } break;
            default: break;
        }
    }
}


extern "C" void kernel_launch(void* const* d_in, const int* in_sizes, int n_in, void* d_out, int out_size, void* d_ws, size_t ws_size, hipStream_t stream) {
    constexpr size_t kDynLds = 131072;
    static int grid_blocks = 0;
    if (!grid_blocks) {
        hipFuncSetAttribute((const void*)mega, hipFuncAttributeMaxDynamicSharedMemorySize, (int)kDynLds);
        int dev = 0, cus = 0, per_cu = 0;
        hipGetDevice(&dev);
        hipDeviceGetAttribute(&cus, hipDeviceAttributeMultiprocessorCount, dev);
        hipOccupancyMaxActiveBlocksPerMultiprocessor(&per_cu, mega, 512, kDynLds);
        if (per_cu < 1) per_cu = 1;
        if (per_cu > 1) per_cu = 1;
        grid_blocks = cus * per_cu;
    }
    Params p{};
    for (int i = 0; i < 32; ++i) p.in[i] = (const float*)d_in[i];
    p.out = (float*)d_out; p.ws = (unsigned char*)d_ws; p.ph_begin = 0; p.ph_end = NPH;
    hipMemsetAsync((unsigned char*)d_ws + OFF_BAR, 0, XCD_BAR_WORDS * sizeof(unsigned), stream);
    void* args[] = {&p};
    hipError_t e = hipLaunchCooperativeKernel((void*)mega, dim3(grid_blocks), dim3(512), args, kDynLds, stream);
    if (e != hipSuccess) fprintf(stderr, "cooperative launch failed: %s (grid %d)\n", hipGetErrorString(e), grid_blocks);
}
```
